# Optimizing an MI355X kernel written in HIP

```python
import math
import jax, jax.numpy as jnp
from jax import lax
import numpy as np

D_MODEL = 1024
BATCH = 32
SEQ = 2048
DEPTH = 4

N_EVEN = (DEPTH + 1) // 2
N_ODD = DEPTH // 2
NORM_EPS = 1e-6
CHUNK = 64
S5_WIDTH = D_MODEL // 2
S5_GROUP_SIZE = 16
S5_GROUPS = S5_WIDTH // S5_GROUP_SIZE
S5_STATE = 64
DT_MIN = 1e-3
DT_MAX = 1e-1
GLA_HEADS = 4
GLA_VW = D_MODEL // 2
GLA_KW = GLA_VW // 2
GLA_DV_HEAD = GLA_VW // GLA_HEADS
GLA_DK_HEAD = GLA_KW // GLA_HEADS
GLA_RANK = 16
GLA_GATE_TEMP = 16.0
EVEN_MIX_WIDTH = S5_WIDTH + GLA_VW
EVEN_PROJ = S5_WIDTH + 2 * GLA_KW + 2 * GLA_VW + GLA_RANK
MLSTM_INNER = 2 * D_MODEL
MLSTM_HEADS = 4
MLSTM_HEAD_DIM = MLSTM_INNER // MLSTM_HEADS
MLSTM_CONV = 4
MLSTM_QKV_BLOCK = 4
MLSTM_NBLOCKS = MLSTM_INNER // MLSTM_QKV_BLOCK
FFN_DIM = 2816
FFN_CONV = 3

kernel_name = "hybrid_s5_gla_mlstm_trunk"


def rms_norm(x, g):
    xf = x.astype(jnp.float32)
    y = xf * lax.rsqrt(jnp.mean(xf * xf, axis=-1, keepdims=True) + NORM_EPS)
    return (y * g.astype(jnp.float32)).astype(x.dtype)


def head_rms_norm(x, g, n_heads):
    b, l, w = x.shape
    xh = x.astype(jnp.float32).reshape(b, l, n_heads, w // n_heads)
    y = xh * lax.rsqrt(jnp.mean(xh * xh, axis=-1, keepdims=True) + NORM_EPS)
    return y.reshape(b, l, w) * g.astype(jnp.float32)


def causal_dwconv(x, w, b):
    width = w.shape[0]
    seq = x.shape[1]
    xp = jnp.pad(x, ((0, 0), (width - 1, 0), (0, 0)))
    out = b
    for k in range(width):
        out = out + xp[:, k:k + seq] * w[k]
    return out


def to_chunks(t):
    b, l = t.shape[:2]
    return jnp.moveaxis(t.reshape((b, l // CHUNK, CHUNK) + t.shape[2:]), 1, 0)


def from_chunks(t):
    n, b, c = t.shape[:3]
    return jnp.moveaxis(t, 0, 1).reshape((b, n * c) + t.shape[3:])


def _complex_affine_combine(e1, e2):
    a1r, a1i, b1r, b1i = e1
    a2r, a2i, b2r, b2i = e2
    return (a2r * a1r - a2i * a1i,
            a2r * a1i + a2i * a1r,
            a2r * b1r - a2i * b1i + b2r,
            a2r * b1i + a2i * b1r + b2i)


def s5_mixer(u, lam_re, lam_im, b_re, b_im, c_re, c_im, d_skip, log_dt, w_glu, b_glu):
    f32 = jnp.float32
    bsz, seq, _ = u.shape
    ug = u.astype(f32).reshape(bsz, seq, S5_GROUPS, S5_GROUP_SIZE)
    dt = jnp.exp(log_dt.astype(f32))[:, None]
    lr = lam_re.astype(f32)
    li = lam_im.astype(f32)
    mag = jnp.exp(lr * dt)
    lb_re = mag * jnp.cos(li * dt)
    lb_im = mag * jnp.sin(li * dt)
    inv = 1.0 / (lr * lr + li * li)
    zr = ((lb_re - 1.0) * lr + lb_im * li) * inv
    zi = (lb_im * lr - (lb_re - 1.0) * li) * inv
    br = b_re.astype(f32)
    bi = b_im.astype(f32)
    bb_re = zr[..., None] * br - zi[..., None] * bi
    bb_im = zr[..., None] * bi + zi[..., None] * br
    bu_re = jnp.einsum('blgi,gpi->blgp', ug, bb_re)
    bu_im = jnp.einsum('blgi,gpi->blgp', ug, bb_im)
    shape = (1, seq, S5_GROUPS, S5_STATE)
    a_re = jnp.broadcast_to(lb_re, shape)
    a_im = jnp.broadcast_to(lb_im, shape)
    _, _, x_re, x_im = lax.associative_scan(
        _complex_affine_combine, (a_re, a_im, bu_re, bu_im), axis=1)
    y = (jnp.einsum('blgp,gip->blgi', x_re, c_re.astype(f32))
         - jnp.einsum('blgp,gip->blgi', x_im, c_im.astype(f32))
         + d_skip.astype(f32) * ug)
    y = jax.nn.gelu(y.reshape(bsz, seq, S5_WIDTH), approximate=True)
    return y * jax.nn.sigmoid(y @ w_glu.astype(f32) + b_glu.astype(f32))


def gla_mixer(q, k, v, r, a_lr, w_alpha_up, b_alpha, norm_g):
    f32 = jnp.float32
    bsz, seq, _ = q.shape
    q = q.astype(f32).reshape(bsz, seq, GLA_HEADS, GLA_DK_HEAD) * (GLA_DK_HEAD ** -0.5)
    k = k.astype(f32).reshape(bsz, seq, GLA_HEADS, GLA_DK_HEAD)
    v = v.astype(f32).reshape(bsz, seq, GLA_HEADS, GLA_DV_HEAD)
    log_a = jax.nn.log_sigmoid(a_lr.astype(f32) @ w_alpha_up.astype(f32)
                               + b_alpha.astype(f32)) / GLA_GATE_TEMP
    log_a = log_a.reshape(bsz, seq, GLA_HEADS, GLA_DK_HEAD)
    qc, kc, vc = to_chunks(q), to_chunks(k), to_chunks(v)
    gc = jnp.cumsum(to_chunks(log_a), axis=2)
    mask = jnp.tril(jnp.ones((CHUNK, CHUNK), dtype=bool))

    def step(state, inp):
        qi, ki, vi, gi = inp
        g_last = gi[:, -1]
        q_dec = qi * jnp.exp(gi)
        k_dec = ki * jnp.exp(-gi)
        k_upd = ki * jnp.exp(g_last[:, None] - gi)
        scores = jnp.where(mask, jnp.einsum('bihd,bjhd->bhij', q_dec, k_dec), 0.0)
        out = (jnp.einsum('bhij,bjhv->bihv', scores, vi)
               + jnp.einsum('bihd,bhdv->bihv', q_dec, state))
        state = jnp.exp(g_last)[..., None] * state + jnp.einsum('bjhd,bjhv->bhdv', k_upd, vi)
        return state, out

    s0 = jnp.zeros((bsz, GLA_HEADS, GLA_DK_HEAD, GLA_DV_HEAD), f32)
    _, oc = lax.scan(step, s0, (qc, kc, vc, gc))
    o = from_chunks(oc).reshape(bsz, seq, GLA_VW)
    return head_rms_norm(o, norm_g, GLA_HEADS) * jax.nn.silu(r.astype(f32))


def headwise(x, w):
    b, l, _ = x.shape
    xb = x.reshape(b, l, MLSTM_NBLOCKS, MLSTM_QKV_BLOCK)
    return jnp.einsum('blnc,ncd->blnd', xb, w.astype(jnp.float32)).reshape(b, l, MLSTM_INNER)


def mlstm_mixer(x_m, o_pre, conv_w, conv_b, w_q, w_k, w_v, w_gate, b_gate, norm_g, skip):
    f32 = jnp.float32
    bsz, seq, _ = x_m.shape
    H, DH = MLSTM_HEADS, MLSTM_HEAD_DIM
    xm = x_m.astype(f32)
    xc = jax.nn.silu(causal_dwconv(xm, conv_w.astype(f32), conv_b.astype(f32)))
    q = headwise(xc, w_q)
    k = headwise(xc, w_k)
    v = headwise(xm, w_v)
    wg = w_gate.astype(f32)
    gates = (jnp.einsum('bld,dg->blg', q, wg[0]) + jnp.einsum('bld,dg->blg', k, wg[1])
             + jnp.einsum('bld,dg->blg', v, wg[2]) + b_gate.astype(f32))
    log_i = gates[..., :H]
    log_f = jax.nn.log_sigmoid(gates[..., H:])
    qh = q.reshape(bsz, seq, H, DH)
    kh = k.reshape(bsz, seq, H, DH) * (DH ** -0.5)
    vh = v.reshape(bsz, seq, H, DH)
    mask = jnp.tril(jnp.ones((CHUNK, CHUNK), dtype=bool))

    def step(carry, inp):
        c_mat, n_vec, m = carry
        qi, ki, vi, ii, fi = inp
        f_cum = jnp.cumsum(fi, axis=1).transpose(0, 2, 1)
        i_t = ii.transpose(0, 2, 1)
        d_log = jnp.where(mask, f_cum[..., :, None] - f_cum[..., None, :] + i_t[..., None, :],
                          -jnp.inf)
        inter_log = f_cum + m[..., None]
        m_loc = jnp.maximum(inter_log, jnp.max(d_log, axis=-1))
        s = jnp.einsum('bihd,bjhd->bhij', qi, ki) * jnp.exp(d_log - m_loc[..., None])
        w_inter = jnp.exp(inter_log - m_loc)
        num = (jnp.einsum('bhij,bjhe->bihe', s, vi)
               + w_inter.transpose(0, 2, 1)[..., None] * jnp.einsum('bihd,bhed->bihe', qi, c_mat))
        den = jnp.sum(s, axis=-1) + w_inter * jnp.einsum('bihd,bhd->bhi', qi, n_vec)
        denom = jnp.maximum(jnp.abs(den), jnp.exp(-m_loc)).transpose(0, 2, 1)[..., None]
        h = num / denom
        f_last = f_cum[..., -1]
        w_log = f_last[..., None] - f_cum + i_t
        m_new = jnp.maximum(f_last + m, jnp.max(w_log, axis=-1))
        w_upd = jnp.exp(w_log - m_new[..., None]).transpose(0, 2, 1)[..., None]
        decay = jnp.exp(f_last + m - m_new)
        c_mat = decay[..., None, None] * c_mat + jnp.einsum('bjhe,bjhd->bhed', vi * w_upd, ki)
        n_vec = decay[..., None] * n_vec + jnp.sum(ki * w_upd, axis=1)
        return (c_mat, n_vec, m_new), h

    init = (jnp.zeros((bsz, H, DH, DH), f32), jnp.zeros((bsz, H, DH), f32),
            jnp.zeros((bsz, H), f32))
    _, hc = lax.scan(step, init, (to_chunks(qh), to_chunks(kh), to_chunks(vh),
                                  to_chunks(log_i), to_chunks(log_f)))
    h = from_chunks(hc).reshape(bsz, seq, MLSTM_INNER)
    h = head_rms_norm(h, norm_g, H) + skip.astype(f32) * xc
    return jax.nn.sigmoid(o_pre.astype(f32)) * h


def conv_ffn(h, w_up, conv_w, conv_b, w_down):
    g, u = jnp.split(h @ w_up, 2, axis=-1)
    g = causal_dwconv(g, conv_w, conv_b)
    return ((jax.nn.gelu(g, approximate=True) * u) @ w_down).astype(h.dtype)


def setup_inputs(seed: int = 0) -> dict:
    key = jax.random.key(seed)
    ks = jax.random.split(key, 40)
    f32 = jnp.float32

    def nrm(i, shape, scale):
        return scale * jax.random.normal(ks[i], shape, f32)

    def gain(i, shape):
        return 1.0 + 0.01 * jax.random.normal(ks[i], shape, f32)

    NE, NO, G, P, GS = N_EVEN, N_ODD, S5_GROUPS, S5_STATE, S5_GROUP_SIZE
    lam_im = math.pi * jnp.arange(P, dtype=f32) + nrm(7, (NE, G, P), 0.01)
    b_gate = jnp.concatenate(
        [nrm(26, (NO, MLSTM_HEADS), 0.1),
         jnp.linspace(3.0, 6.0, MLSTM_HEADS, dtype=f32) + nrm(27, (NO, MLSTM_HEADS), 0.01)],
        axis=-1)
    return {
        "x": nrm(0, (BATCH, SEQ, D_MODEL), 1.0),
        "ln_mix_pre": gain(1, (DEPTH, D_MODEL)),
        "ln_mix_post": gain(2, (DEPTH, D_MODEL)),
        "ln_ffn_pre": gain(3, (DEPTH, D_MODEL)),
        "ln_ffn_post": gain(4, (DEPTH, D_MODEL)),
        "ev_w_in": nrm(5, (NE, D_MODEL, EVEN_PROJ), D_MODEL ** -0.5),
        "s5_lambda_re": -0.5 + nrm(6, (NE, G, P), 0.01),
        "s5_lambda_im": lam_im,
        "s5_b_re": nrm(8, (NE, G, P, GS), (2 * GS) ** -0.5),
        "s5_b_im": nrm(9, (NE, G, P, GS), (2 * GS) ** -0.5),
        "s5_c_re": nrm(10, (NE, G, GS, P), P ** -0.5),
        "s5_c_im": nrm(11, (NE, G, GS, P), P ** -0.5),
        "s5_d": nrm(12, (NE, G, GS), 1.0),
        "s5_log_dt": jax.random.uniform(ks[13], (NE, G), f32, minval=math.log(DT_MIN),
                                        maxval=math.log(DT_MAX)),
        "s5_w_glu": nrm(14, (NE, S5_WIDTH, S5_WIDTH), S5_WIDTH ** -0.5),
        "s5_b_glu": nrm(15, (NE, S5_WIDTH), 0.01),
        "gla_w_alpha_up": nrm(16, (NE, GLA_RANK, GLA_KW), GLA_RANK ** -0.5),
        "gla_b_alpha": nrm(17, (NE, GLA_KW), 0.1),
        "gla_norm": gain(18, (NE, GLA_VW)),
        "ev_w_out": nrm(19, (NE, EVEN_MIX_WIDTH, D_MODEL), EVEN_MIX_WIDTH ** -0.5),
        "od_w_in": nrm(20, (NO, D_MODEL, 2 * MLSTM_INNER), D_MODEL ** -0.5),
        "ml_conv_w": nrm(21, (NO, MLSTM_CONV, MLSTM_INNER), MLSTM_CONV ** -0.5),
        "ml_conv_b": nrm(22, (NO, MLSTM_INNER), 0.01),
        "ml_w_q": nrm(23, (NO, MLSTM_NBLOCKS, MLSTM_QKV_BLOCK, MLSTM_QKV_BLOCK), MLSTM_QKV_BLOCK ** -0.5),
        "ml_w_k": nrm(24, (NO, MLSTM_NBLOCKS, MLSTM_QKV_BLOCK, MLSTM_QKV_BLOCK), MLSTM_QKV_BLOCK ** -0.5),
        "ml_w_v": nrm(25, (NO, MLSTM_NBLOCKS, MLSTM_QKV_BLOCK, MLSTM_QKV_BLOCK), MLSTM_QKV_BLOCK ** -0.5),
        "ml_w_gate": nrm(28, (NO, 3, MLSTM_INNER, 2 * MLSTM_HEADS), (3 * MLSTM_INNER) ** -0.5),
        "ml_b_gate": b_gate,
        "ml_norm": gain(29, (NO, MLSTM_INNER)),
        "ml_skip": gain(30, (NO, MLSTM_INNER)),
        "od_w_out": nrm(31, (NO, MLSTM_INNER, D_MODEL), MLSTM_INNER ** -0.5),
        "ffn_w_up": nrm(32, (DEPTH, D_MODEL, 2 * FFN_DIM), D_MODEL ** -0.5),
        "ffn_conv_w": nrm(33, (DEPTH, FFN_CONV, FFN_DIM), FFN_CONV ** -0.5),
        "ffn_conv_b": nrm(34, (DEPTH, FFN_DIM), 0.01),
        "ffn_w_down": nrm(35, (DEPTH, FFN_DIM, D_MODEL), FFN_DIM ** -0.5),
    }


def reference(x, ln_mix_pre, ln_mix_post, ln_ffn_pre, ln_ffn_post,
              ev_w_in, s5_lambda_re, s5_lambda_im, s5_b_re, s5_b_im, s5_c_re, s5_c_im,
              s5_d, s5_log_dt, s5_w_glu, s5_b_glu, gla_w_alpha_up, gla_b_alpha, gla_norm,
              ev_w_out, od_w_in, ml_conv_w, ml_conv_b, ml_w_q, ml_w_k, ml_w_v, ml_w_gate,
              ml_b_gate, ml_norm, ml_skip, od_w_out, ffn_w_up, ffn_conv_w, ffn_conv_b,
              ffn_w_down):
    splits = [S5_WIDTH, S5_WIDTH + GLA_KW, S5_WIDTH + 2 * GLA_KW,
              S5_WIDTH + 2 * GLA_KW + GLA_VW, S5_WIDTH + 2 * GLA_KW + 2 * GLA_VW]
    for layer in range(DEPTH):
        h = rms_norm(x, ln_mix_pre[layer])
        if layer % 2 == 0:
            e = layer // 2
            p = h @ ev_w_in[e]
            u, q, k, v, r, a_lr = jnp.split(p, splits, axis=-1)
            a_out = s5_mixer(u, s5_lambda_re[e], s5_lambda_im[e], s5_b_re[e], s5_b_im[e],
                             s5_c_re[e], s5_c_im[e], s5_d[e], s5_log_dt[e], s5_w_glu[e],
                             s5_b_glu[e])
            b_out = gla_mixer(q, k, v, r, a_lr, gla_w_alpha_up[e], gla_b_alpha[e], gla_norm[e])
            mix = (jnp.concatenate([a_out, b_out], axis=-1) @ ev_w_out[e]).astype(h.dtype)
        else:
            o = layer // 2
            x_m, o_pre = jnp.split(h @ od_w_in[o], 2, axis=-1)
            c_out = mlstm_mixer(x_m, o_pre, ml_conv_w[o], ml_conv_b[o], ml_w_q[o], ml_w_k[o],
                                ml_w_v[o], ml_w_gate[o], ml_b_gate[o], ml_norm[o], ml_skip[o])
            mix = (c_out @ od_w_out[o]).astype(h.dtype)
        x = x + rms_norm(mix, ln_mix_post[layer])
        h = rms_norm(x, ln_ffn_pre[layer])
        f = conv_ffn(h, ffn_w_up[layer], ffn_conv_w[layer], ffn_conv_b[layer], ffn_w_down[layer])
        x = x + rms_norm(f, ln_ffn_post[layer])
    return x
```

```cpp
#include <hip/hip_runtime.h>
#include <cstdio>
#include <cstdint>

#ifndef MK_PER_PHASE_LAUNCH
#define MK_PER_PHASE_LAUNCH 0
#endif

template <int CTRL> __device__ __forceinline__ float dpp_mov(float x) { return __builtin_bit_cast(float, __builtin_amdgcn_mov_dpp(__builtin_bit_cast(int, x), CTRL, 0xf, 0xf, true)); }
template <int CTRL> __device__ __forceinline__ float dpp_z(float x) { return __builtin_bit_cast(float, __builtin_amdgcn_update_dpp(0, __builtin_bit_cast(int, x), CTRL, 0xf, 0xf, true)); }
template <int CTRL, int RM> __device__ __forceinline__ float dpp_o(float oldv, float x) { return __builtin_bit_cast(float, __builtin_amdgcn_update_dpp(__builtin_bit_cast(int, oldv), __builtin_bit_cast(int, x), CTRL, RM, 0xf, false)); }
namespace pg8 {
#define PG8_LAS __attribute__((address_space(3)))
typedef unsigned short bf16_t;
typedef short bf16x8 __attribute__((ext_vector_type(8)));
typedef float f32x4 __attribute__((ext_vector_type(4)));
typedef unsigned u32x4 __attribute__((ext_vector_type(4)));
typedef unsigned u32x2 __attribute__((ext_vector_type(2)));
constexpr int BM = 256, BK = 64, HALF = 128, HTB = HALF * BK * 2  , STAGE_BYTES = 8 * HTB, NXCD = 8, WGM = 8;

__host__ __device__ __forceinline__ int lds_byte(int r, int c) { const int st = (r >> 4) * 2 + (c >> 5), rr = r & 15, cc = c & 31, ob = rr * 64 + cc * 2; return st * 1024 + (ob ^ (((ob >> 9) & 1) << 5)); }
__host__ __device__ __forceinline__ void stage_rc(int b, int& R, int& C) { const int st = b / 1024, sb = b % 1024, swz = sb ^ (((sb >> 9) & 1) << 5); R = (st >> 1) * 16 + swz / 64; C = (st & 1) * 32 + (swz % 64) / 2; }
__host__ __device__ __forceinline__ int perm32(int rho) { const int n = rho >> 4, i = rho & 15; return 8 * (i >> 2) + 4 * n + (i & 3); }

struct Unit { int pm, pn; };
struct Gemm { const bf16_t* A; const bf16_t* Bt; int M, N, K, lda, ldb; };

struct StaticOrder {
    int nM, nN, nwg, G, c, wgm;
    __host__ __device__ void init(int M, int N, int G_, int c_, int wgm_ = WGM) { nM = M / BM; nN = N / BM; nwg = nM * nN; G = G_; c = c_; wgm = wgm_; }
    __host__ __device__ bool next(int i, Unit& u) const {
        const long L = (long)i * G + c; if (L >= nwg) return false;
        int wgid = (int)L; { const int q = nwg / NXCD, r = nwg % NXCD, xcd = wgid % NXCD, off = wgid / NXCD; wgid = (xcd < r ? xcd * (q + 1) : r * (q + 1) + (xcd - r) * q) + off; }
        const int nig = wgm * nN, gid = wgid / nig, fm = gid * wgm, gsz = (nM - fm) < wgm ? (nM - fm) : wgm;
        u.pm = fm + ((wgid % nig) % gsz); u.pn = (wgid % nig) / gsz; return true;
    }
    __device__ __forceinline__ void a_ready(const Unit&) const {}
    __device__ __forceinline__ void done(const Unit&) const {}
};

typedef __bf16 bf16x2n __attribute__((ext_vector_type(2)));
__device__ __forceinline__ unsigned cvt_pk_bf16(float lo, float hi) { const bf16x2n v = {(__bf16)lo, (__bf16)hi}; return __builtin_bit_cast(unsigned, v); }
__device__ __forceinline__ float bf_lo(unsigned u) { return __uint_as_float(u << 16); }
__device__ __forceinline__ float bf_hi(unsigned u) { return __uint_as_float(u & 0xffff0000u); }
__device__ __forceinline__ float sigmoidf_(float x) { return __builtin_amdgcn_rcpf(1.0f + __expf(-x)); }
__device__ __forceinline__ float gelu_tanh(float x) { const float p = fmaf(x * x, -0.10294323f, -2.3022082f); return x * __builtin_amdgcn_rcpf(1.0f + __builtin_amdgcn_exp2f(x * p)); }

__device__ __forceinline__ float rs_of(const float* rsp, size_t row) { const f32x4 p = *(const f32x4*)(rsp + 4 * row); return rsqrtf(((p[0] + p[1]) + (p[2] + p[3])) * (1.0f / 1024.0f) + 1e-6f); }
struct EpiBf16P {
    static constexpr bool PERM = true, AFTER_DRAIN = false;
    bf16_t* O; int ldc; const float* rs;
    __device__ __forceinline__ void operator()(const f32x4 (&acc)[2][2][4][2], const Unit& u, int wr, int wc, int fr, int fq) const {
        const int row0 = u.pm * BM + wr * 64 + fr, col0 = u.pn * BM + wc * 32 + 8 * fq;
#pragma unroll
        for (int ai = 0; ai < 2; ++ai)
#pragma unroll
            for (int m = 0; m < 4; ++m) { bf16_t* rowp = O + (size_t)(row0 + ai * HALF + m * 16) * ldc + col0; const float rsc = rs ? rs_of(rs, (size_t)(row0 + ai * HALF + m * 16)) : 1.0f;
#pragma unroll
                for (int bj = 0; bj < 2; ++bj) { const f32x4 v0 = acc[ai][bj][m][0] * rsc, v1 = acc[ai][bj][m][1] * rsc;
                    u32x4 w; w.x = cvt_pk_bf16(v0[0], v0[1]); w.y = cvt_pk_bf16(v0[2], v0[3]); w.z = cvt_pk_bf16(v1[0], v1[1]); w.w = cvt_pk_bf16(v1[2], v1[3]);
                    *(u32x4*)(rowp + bj * HALF) = w; } }
    }
};
struct EpiGlu {
    static constexpr bool PERM = true, AFTER_DRAIN = false;
    const bf16_t* Y; int ldy; const float* bias; bf16_t* O; int ldc;
    __device__ __forceinline__ void operator()(const f32x4 (&acc)[2][2][4][2], const Unit& u, int wr, int wc, int fr, int fq) const {
        const int row0 = u.pm * BM + wr * 64 + fr, col0 = u.pn * BM + wc * 32 + 8 * fq;
        f32x4 bv[2][2];
#pragma unroll
        for (int bj = 0; bj < 2; ++bj)
#pragma unroll
            for (int n = 0; n < 2; ++n) bv[bj][n] = *(const f32x4*)(bias + col0 + bj * HALF + 4 * n);
#pragma unroll
        for (int ai = 0; ai < 2; ++ai)
#pragma unroll
            for (int m = 0; m < 4; ++m) { const size_t row = (size_t)(row0 + ai * HALF + m * 16);
#pragma unroll
                for (int bj = 0; bj < 2; ++bj) { const int col = col0 + bj * HALF;
                    const u32x4 yv = *(const u32x4*)(Y + row * ldy + col);
                    const f32x4 z0 = acc[ai][bj][m][0] + bv[bj][0], z1 = acc[ai][bj][m][1] + bv[bj][1];
                    float o[8];
                    o[0] = bf_lo(yv.x) * sigmoidf_(z0[0]); o[1] = bf_hi(yv.x) * sigmoidf_(z0[1]); o[2] = bf_lo(yv.y) * sigmoidf_(z0[2]); o[3] = bf_hi(yv.y) * sigmoidf_(z0[3]);
                    o[4] = bf_lo(yv.z) * sigmoidf_(z1[0]); o[5] = bf_hi(yv.z) * sigmoidf_(z1[1]); o[6] = bf_lo(yv.w) * sigmoidf_(z1[2]); o[7] = bf_hi(yv.w) * sigmoidf_(z1[3]);
                    u32x4 w; w.x = cvt_pk_bf16(o[0], o[1]); w.y = cvt_pk_bf16(o[2], o[3]); w.z = cvt_pk_bf16(o[4], o[5]); w.w = cvt_pk_bf16(o[6], o[7]);
                    *(u32x4*)(O + row * ldc + col) = w; } }
    }
};
struct EpiOGate {
    static constexpr bool PERM = true, AFTER_DRAIN = false;
    bf16_t* H; const bf16_t* XC; const float* SS; const float* gn; const float* skip; int ld; float eps; const float* rs;
    struct RowIn { f32x4 ss, rp; u32x4 hv[2], xv[2]; };
    __device__ __forceinline__ void operator()(const f32x4 (&acc)[2][2][4][2], const Unit& u, int wr, int wc, int fr_, int fq_) const {
        int tq = threadIdx.x; asm volatile("" : "+v"(tq));
        const int fr = tq & 15, fq = (tq >> 4) & 3; (void)fr_; (void)fq_;
        const int row0 = u.pm * BM + wr * 64 + fr, col0 = u.pn * BM + wc * 32 + 8 * fq, head = u.pn >> 1;
        f32x4 gv[2][2], sv[2][2];
#pragma unroll
        for (int bj = 0; bj < 2; ++bj)
#pragma unroll
            for (int n = 0; n < 2; ++n) { gv[bj][n] = *(const f32x4*)(gn + col0 + bj * HALF + 4 * n); sv[bj][n] = *(const f32x4*)(skip + col0 + bj * HALF + 4 * n); }
        auto load_row = [&](int it, RowIn& R) { const size_t row = (size_t)(row0 + (it >> 2) * HALF + (it & 3) * 16);
            R.ss = *(const f32x4*)(SS + row * 16 + head * 4); R.rp = *(const f32x4*)(rs + 4 * row);
#pragma unroll
            for (int bj = 0; bj < 2; ++bj) { R.hv[bj] = *(const u32x4*)(H + row * ld + col0 + bj * HALF); R.xv[bj] = *(const u32x4*)(XC + row * ld + col0 + bj * HALF); } };
        RowIn cur, nxt;
        load_row(0, cur);
#pragma unroll
        for (int it = 0; it < 8; ++it) { const int ai = it >> 2, m = it & 3;
            const size_t row = (size_t)(row0 + ai * HALF + m * 16);
            if (it < 7) load_row(it + 1, nxt);
            __builtin_amdgcn_sched_barrier(0);
            const float rstd = rsqrtf(((cur.ss[0] + cur.ss[1]) + (cur.ss[2] + cur.ss[3])) * (1.0f / 512.0f) + eps);
            const float rsc = rsqrtf(((cur.rp[0] + cur.rp[1]) + (cur.rp[2] + cur.rp[3])) * (1.0f / 1024.0f) + 1e-6f);
#pragma unroll
            for (int bj = 0; bj < 2; ++bj) { const int col = col0 + bj * HALF;
                const u32x4 hv = cur.hv[bj], xv = cur.xv[bj];
                const f32x4 a0 = acc[ai][bj][m][0] * rsc, a1 = acc[ai][bj][m][1] * rsc; const f32x4 g0 = gv[bj][0] * rstd, g1 = gv[bj][1] * rstd, s0 = sv[bj][0], s1 = sv[bj][1];
                float o[8];
                o[0] = sigmoidf_(a0[0]) * (bf_lo(hv.x) * g0[0] + s0[0] * bf_lo(xv.x)); o[1] = sigmoidf_(a0[1]) * (bf_hi(hv.x) * g0[1] + s0[1] * bf_hi(xv.x));
                o[2] = sigmoidf_(a0[2]) * (bf_lo(hv.y) * g0[2] + s0[2] * bf_lo(xv.y)); o[3] = sigmoidf_(a0[3]) * (bf_hi(hv.y) * g0[3] + s0[3] * bf_hi(xv.y));
                o[4] = sigmoidf_(a1[0]) * (bf_lo(hv.z) * g1[0] + s1[0] * bf_lo(xv.z)); o[5] = sigmoidf_(a1[1]) * (bf_hi(hv.z) * g1[1] + s1[1] * bf_hi(xv.z));
                o[6] = sigmoidf_(a1[2]) * (bf_lo(hv.w) * g1[2] + s1[2] * bf_lo(xv.w)); o[7] = sigmoidf_(a1[3]) * (bf_hi(hv.w) * g1[3] + s1[3] * bf_hi(xv.w));
                u32x4 w; w.x = cvt_pk_bf16(o[0], o[1]); w.y = cvt_pk_bf16(o[2], o[3]); w.z = cvt_pk_bf16(o[4], o[5]); w.w = cvt_pk_bf16(o[6], o[7]);
                *(u32x4*)(H + row * ld + col) = w; }
            __builtin_amdgcn_sched_barrier(0);
            if (it < 7) cur = nxt; }
    }
};
struct EpiFfnUp {
    static constexpr bool PERM = true, AFTER_DRAIN = false;
    bf16_t* ACT; bf16_t* HTG; bf16_t* HTU; bf16_t* HBG; const float* cw; const float* cb; int FFd; const float* rs;
    __device__ __forceinline__ void operator()(const f32x4 (&acc)[2][2][4][2], const Unit& u, int wr, int wc, int fr, int fq) const {
        const int ch = u.pn * HALF + wc * 32 + 8 * fq;
        f32x4 w0[2], w1[2], w2[2], bb[2];
#pragma unroll
        for (int n = 0; n < 2; ++n) { w0[n] = *(const f32x4*)(cw + ch + 4 * n); w1[n] = *(const f32x4*)(cw + FFd + ch + 4 * n); w2[n] = *(const f32x4*)(cw + 2 * FFd + ch + 4 * n); bb[n] = *(const f32x4*)(cb + ch + 4 * n); }
#pragma unroll
        for (int ai = 0; ai < 2; ++ai) {
            const int blk = u.pm * 4 + ai * 2 + wr;
            float rsm[4];
#pragma unroll
            for (int m = 0; m < 4; ++m) rsm[m] = rs_of(rs, (size_t)(u.pm * BM + ai * HALF + wr * 64 + m * 16 + fr));
            f32x4 gpv[2] = {(f32x4){0.f, 0.f, 0.f, 0.f}, (f32x4){0.f, 0.f, 0.f, 0.f}};
#pragma unroll
            for (int m = 0; m < 4; ++m) {
                float o[8];
#pragma unroll
                for (int n = 0; n < 2; ++n)
#pragma unroll
                    for (int j = 0; j < 4; ++j) {
                        const float g = acc[ai][0][m][n][j] * rsm[m], gp = gpv[n][j];
                        float cv = fmaf(w2[n][j], g, bb[n][j]);
                        cv = fmaf(dpp_z<0x111>(g), w1[n][j], cv); cv = fmaf(dpp_z<0x10F>(gp), w1[n][j], cv);
                        cv = fmaf(dpp_z<0x112>(g), w0[n][j], cv); cv = fmaf(dpp_z<0x10E>(gp), w0[n][j], cv);
                        o[4 * n + j] = gelu_tanh(cv) * (acc[ai][1][m][n][j] * rsm[m]);
                        gpv[n][j] = g;
                    }
                const size_t row = (size_t)(u.pm * BM + ai * HALF + wr * 64 + m * 16 + fr);
                if (m == 0 && fr < 2) {
                    const f32x4 ga = acc[ai][0][0][0] * rsm[0], gb = acc[ai][0][0][1] * rsm[0], ua = acc[ai][1][0][0] * rsm[0], ub = acc[ai][1][0][1] * rsm[0];
                    u32x4 wg, wu; wg.x = cvt_pk_bf16(ga[0], ga[1]); wg.y = cvt_pk_bf16(ga[2], ga[3]); wg.z = cvt_pk_bf16(gb[0], gb[1]); wg.w = cvt_pk_bf16(gb[2], gb[3]);
                    wu.x = cvt_pk_bf16(ua[0], ua[1]); wu.y = cvt_pk_bf16(ua[2], ua[3]); wu.z = cvt_pk_bf16(ub[0], ub[1]); wu.w = cvt_pk_bf16(ub[2], ub[3]);
                    *(u32x4*)(HTG + ((size_t)blk * 2 + fr) * FFd + ch) = wg; *(u32x4*)(HTU + ((size_t)blk * 2 + fr) * FFd + ch) = wu;
                } else {
                    u32x4 w; w.x = cvt_pk_bf16(o[0], o[1]); w.y = cvt_pk_bf16(o[2], o[3]); w.z = cvt_pk_bf16(o[4], o[5]); w.w = cvt_pk_bf16(o[6], o[7]);
                    *(u32x4*)(ACT + row * FFd + ch) = w;
                }
                if (m == 3 && fr >= 14) { const f32x4 ga = acc[ai][0][3][0] * rsm[3], gb = acc[ai][0][3][1] * rsm[3];
                    u32x4 wg; wg.x = cvt_pk_bf16(ga[0], ga[1]); wg.y = cvt_pk_bf16(ga[2], ga[3]); wg.z = cvt_pk_bf16(gb[0], gb[1]); wg.w = cvt_pk_bf16(gb[2], gb[3]);
                    *(u32x4*)(HBG + ((size_t)blk * 2 + (fr - 14)) * FFd + ch) = wg; }
                if (m & 1) __builtin_amdgcn_sched_barrier(0);
            }
        }
    }
};

struct EpiNormRes {
    static constexpr bool PERM = true, AFTER_DRAIN = false;
    bf16_t* XS; float* OUT; const float* gpost; unsigned long long* slot; float* RSP; unsigned tag; unsigned* tmo; PG8_LAS unsigned char* tab; bool last;
    __device__ __forceinline__ void operator()(const f32x4 (&acc)[2][2][4][2], const Unit& u, int wr, int wc, int fr_, int fq_) const {
        int tq = threadIdx.x; asm volatile("" : "+v"(tq));
        const int fr = tq & 15, fq = (tq >> 4) & 3; (void)fr_; (void)fq_;
        PG8_LAS float* P = (PG8_LAS float*)tab;
        PG8_LAS float* Sx = (PG8_LAS float*)(tab + 16384);
        const int lane = fq * 16 + fr, prow = wc * 64 + lane;
        const int col0 = u.pn * BM + wc * 32 + 8 * fq;
        u32x4 xv[2][4][2];
#pragma unroll
        for (int ai = 0; ai < 2; ++ai)
#pragma unroll
            for (int m = 0; m < 4; ++m)
#pragma unroll
                for (int bj = 0; bj < 2; ++bj) xv[ai][m][bj] = *(const u32x4*)(XS + (size_t)(u.pm * BM + ai * HALF + wr * 64 + m * 16 + fr) * 1024 + col0 + bj * HALF);
#pragma unroll
        for (int ai = 0; ai < 2; ++ai)
#pragma unroll
            for (int m = 0; m < 4; ++m) { float s = 0.f;
#pragma unroll
                for (int bj = 0; bj < 2; ++bj)
#pragma unroll
                    for (int n = 0; n < 2; ++n) { const f32x4 x = acc[ai][bj][m][n]; s += (x[0] * x[0] + x[1] * x[1]) + (x[2] * x[2] + x[3] * x[3]); }
                P[(ai * HALF + wr * 64 + m * 16 + fr) * 16 + wc * 4 + fq] = s; }
        asm volatile("s_waitcnt lgkmcnt(0)" ::: "memory"); __builtin_amdgcn_s_barrier(); asm volatile("" ::: "memory");
        if (wr == 0) {
            const f32x4 a = *(const PG8_LAS f32x4*)(P + prow * 16), b = *(const PG8_LAS f32x4*)(P + prow * 16 + 4), c = *(const PG8_LAS f32x4*)(P + prow * 16 + 8), d = *(const PG8_LAS f32x4*)(P + prow * 16 + 12);
            const f32x4 t4 = (a + b) + (c + d); const float t = (t4[0] + t4[1]) + (t4[2] + t4[3]);
            unsigned long long* sp4 = slot + (size_t)(u.pm * BM + prow) * 4;
            __hip_atomic_store(sp4 + u.pn, ((unsigned long long)tag << 32) | __float_as_uint(t), __ATOMIC_RELAXED, __HIP_MEMORY_SCOPE_AGENT);
            unsigned long long w0, w1, w2, w3; unsigned sp = 0u;
            for (;;) {
                w0 = __hip_atomic_load(sp4, __ATOMIC_RELAXED, __HIP_MEMORY_SCOPE_AGENT); w1 = __hip_atomic_load(sp4 + 1, __ATOMIC_RELAXED, __HIP_MEMORY_SCOPE_AGENT);
                w2 = __hip_atomic_load(sp4 + 2, __ATOMIC_RELAXED, __HIP_MEMORY_SCOPE_AGENT); w3 = __hip_atomic_load(sp4 + 3, __ATOMIC_RELAXED, __HIP_MEMORY_SCOPE_AGENT);
                const bool ok = (unsigned)(w0 >> 32) == tag && (unsigned)(w1 >> 32) == tag && (unsigned)(w2 >> 32) == tag && (unsigned)(w3 >> 32) == tag;
                if (__builtin_amdgcn_ballot_w64(!ok) == 0ull) break;
                __builtin_amdgcn_s_sleep(1);
                if (++sp > (1u << 19)) { if (lane == 0) __hip_atomic_fetch_add(tmo, 1u, __ATOMIC_RELAXED, __HIP_MEMORY_SCOPE_AGENT); break; }
            }
            const float p0 = __uint_as_float((unsigned)w0), p1 = __uint_as_float((unsigned)w1), p2 = __uint_as_float((unsigned)w2), p3 = __uint_as_float((unsigned)w3);
            Sx[prow] = rsqrtf(((p0 + p1) + (p2 + p3)) * (1.0f / 1024.0f) + 1e-6f);
        }
        asm volatile("s_waitcnt lgkmcnt(0)" ::: "memory"); __builtin_amdgcn_s_barrier(); asm volatile("" ::: "memory");
        f32x4 gv[2][2];
#pragma unroll
        for (int bj = 0; bj < 2; ++bj)
#pragma unroll
            for (int n = 0; n < 2; ++n) gv[bj][n] = *(const f32x4*)(gpost + col0 + bj * HALF + 4 * n);
#pragma unroll
        for (int ai = 0; ai < 2; ++ai)
#pragma unroll
            for (int m = 0; m < 4; ++m) { const int r = ai * HALF + wr * 64 + m * 16 + fr; const size_t off = (size_t)(u.pm * BM + r) * 1024 + col0; const float rstd = Sx[r]; float s2 = 0.f;
#pragma unroll
                for (int bj = 0; bj < 2; ++bj) { const u32x4 xw = xv[ai][m][bj];
                    const f32x4 x0 = (f32x4){bf_lo(xw.x), bf_hi(xw.x), bf_lo(xw.y), bf_hi(xw.y)} + acc[ai][bj][m][0] * rstd * gv[bj][0];
                    const f32x4 x1 = (f32x4){bf_lo(xw.z), bf_hi(xw.z), bf_lo(xw.w), bf_hi(xw.w)} + acc[ai][bj][m][1] * rstd * gv[bj][1];
                    s2 += ((x0[0] * x0[0] + x0[1] * x0[1]) + (x0[2] * x0[2] + x0[3] * x0[3])) + ((x1[0] * x1[0] + x1[1] * x1[1]) + (x1[2] * x1[2] + x1[3] * x1[3]));
                    if (last) { *(f32x4*)(OUT + off + bj * HALF) = x0; *(f32x4*)(OUT + off + bj * HALF + 4) = x1; }
                    else { u32x4 w; w.x = cvt_pk_bf16(x0[0], x0[1]); w.y = cvt_pk_bf16(x0[2], x0[3]); w.z = cvt_pk_bf16(x1[0], x1[1]); w.w = cvt_pk_bf16(x1[2], x1[3]); *(u32x4*)(XS + off + bj * HALF) = w; } }
                P[r * 16 + wc * 4 + fq] = s2; }
        asm volatile("s_waitcnt lgkmcnt(0)" ::: "memory"); __builtin_amdgcn_s_barrier(); asm volatile("" ::: "memory");
        if (wr == 0 && !last) {
            const f32x4 a = *(const PG8_LAS f32x4*)(P + prow * 16), b = *(const PG8_LAS f32x4*)(P + prow * 16 + 4), c = *(const PG8_LAS f32x4*)(P + prow * 16 + 8), d = *(const PG8_LAS f32x4*)(P + prow * 16 + 12);
            const f32x4 t4 = (a + b) + (c + d);
            RSP[(size_t)(u.pm * BM + prow) * 4 + u.pn] = (t4[0] + t4[1]) + (t4[2] + t4[3]); }
    }
};

template <class Epi, class Sched, bool ALIGN_EPI = false, bool SP2 = false>
__device__ __forceinline__ void gemm_phase(PG8_LAS unsigned char* lds, const Gemm g, const Sched& S, const Epi& E) {
    int tid = threadIdx.x; asm volatile("" : "+v"(tid));
    const int wid = __builtin_amdgcn_readfirstlane(tid >> 6), lane = tid & 63, wr = wid >> 2, wc = wid & 3, fr = lane & 15, fq = lane >> 4;
    const int K = g.K, nt = K / BK;
    unsigned voffA[2], voffB[2];
#pragma unroll
    for (int i = 0; i < 2; ++i) { int R, C; stage_rc(tid * 16 + i * 8192, R, C); const int Rb = Epi::PERM ? ((R & ~31) + perm32(R & 31)) : R;
        voffA[i] = (unsigned)(R * g.lda + C) * 2u; voffB[i] = (unsigned)(Rb * g.ldb + C) * 2u; }
    const size_t kstep = (size_t)(BK * 2);
    const size_t hstepA = (size_t)HALF * g.lda * 2, hstepB = (size_t)HALF * g.ldb * 2;
    const size_t tstepA = 2 * hstepA, tstepB = 2 * hstepB;
    const unsigned ldsw = (unsigned)wid * 1024u;
    const int aoff = lds_byte(wr * 64 + fr, fq * 8), boff = lds_byte(wc * 32 + fr, fq * 8);
#define PG8_SA(b, h) (((b) * 2 + (h)) * HTB)
#define PG8_SB(b, h) ((4 + (b) * 2 + (h)) * HTB)
#define PG8_STAGE(bufoff, gbase, voff) do { _Pragma("unroll") for (int _i = 0; _i < 2; ++_i) \
        __builtin_amdgcn_global_load_lds((const unsigned*)((const char*)(gbase) + (voff)[_i]), (PG8_LAS unsigned*)(lds + (bufoff) + ldsw + _i * 8192), 16, 0, 0); } while (0)
#define PG8_LDA(dst, b, h) do { _Pragma("unroll") for (int m = 0; m < 4; ++m) _Pragma("unroll") for (int k = 0; k < 2; ++k) dst[m][k] = *(const PG8_LAS bf16x8*)(lds + PG8_SA(b, h) + aoff + m * 2048 + k * 1024); } while (0)
#define PG8_LDB(dst, b, h) do { _Pragma("unroll") for (int n = 0; n < 2; ++n) _Pragma("unroll") for (int k = 0; k < 2; ++k) dst[n][k] = *(const PG8_LAS bf16x8*)(lds + PG8_SB(b, h) + boff + n * 2048 + k * 1024); } while (0)
#define PG8_MMA(ai, bj, At, Bt) do { __builtin_amdgcn_s_setprio(1); _Pragma("unroll") for (int m = 0; m < 4; ++m) _Pragma("unroll") for (int n = 0; n < 2; ++n) _Pragma("unroll") for (int k = 0; k < 2; ++k) \
        acc[ai][bj][m][n] = __builtin_amdgcn_mfma_f32_16x16x32_bf16(Bt[n][k], At[m][k], acc[ai][bj][m][n], 0, 0, 0); __builtin_amdgcn_s_setprio(0); } while (0)
#define PG8_WAIT_V(n) asm volatile("s_waitcnt vmcnt(" #n ")" ::: "memory")
#define PG8_WAIT_L(n) asm volatile("s_waitcnt lgkmcnt(" #n ")" ::: "memory")
#define PG8_BAR __builtin_amdgcn_s_barrier()
#define PG8_SCHED __builtin_amdgcn_sched_barrier(0)
    Unit cur, nxt; int ui = 0;
    if (!S.next(0, cur)) return;
    f32x4 acc[2][2][4][2];
#pragma unroll
    for (int a = 0; a < 2; ++a)
#pragma unroll
        for (int b = 0; b < 2; ++b)
#pragma unroll
            for (int m = 0; m < 4; ++m)
#pragma unroll
                for (int n = 0; n < 2; ++n) acc[a][b][m][n] = (f32x4){0.f, 0.f, 0.f, 0.f};
    bf16x8 At[4][2], B0[2][2], B1[2][2];
    const char* cA = (const char*)g.A + (size_t)cur.pm * tstepA; const char* cB = (const char*)g.Bt + (size_t)cur.pn * tstepB;
    S.a_ready(cur);
    if constexpr (SP2) {
        PG8_STAGE(PG8_SB(0, 0), cB, voffB); PG8_STAGE(PG8_SB(0, 1), cB + hstepB, voffB); PG8_STAGE(PG8_SA(0, 0), cA, voffA); PG8_STAGE(PG8_SA(0, 1), cA + hstepA, voffA);
        if (wr == 1) PG8_BAR;
        PG8_WAIT_V(2); PG8_BAR;
        PG8_STAGE(PG8_SB(1, 0), cB + kstep, voffB); PG8_STAGE(PG8_SA(1, 0), cA + kstep, voffA); PG8_STAGE(PG8_SB(1, 1), cB + hstepB + kstep, voffB);
        PG8_WAIT_V(6); PG8_BAR;
    } else {
        PG8_STAGE(PG8_SB(0, 0), cB, voffB); PG8_STAGE(PG8_SA(0, 0), cA, voffA); PG8_STAGE(PG8_SB(0, 1), cB + hstepB, voffB); PG8_STAGE(PG8_SA(0, 1), cA + hstepA, voffA);
        if (wr == 1) PG8_BAR;
        PG8_WAIT_V(4); PG8_BAR;
        PG8_STAGE(PG8_SB(1, 0), cB + kstep, voffB); PG8_STAGE(PG8_SA(1, 0), cA + kstep, voffA); PG8_STAGE(PG8_SB(1, 1), cB + hstepB + kstep, voffB);
        PG8_WAIT_V(6); PG8_BAR;
    }
    for (;;) {
        const bool has_next = S.next(ui + 1, nxt);
        const char* nA = has_next ? (const char*)g.A + (size_t)nxt.pm * tstepA : cA; const char* nB = has_next ? (const char*)g.Bt + (size_t)nxt.pn * tstepB : cB;
        for (int t = 0; t < nt; t += 2) {
            const bool last = (t == nt - 2);
            const char* a1 = cA + (size_t)(t + 1) * kstep;
            const char* a2 = last ? nA : cA + (size_t)(t + 2) * kstep; const char* b2 = last ? nB : cB + (size_t)(t + 2) * kstep;
            const char* a3 = a2 + kstep; const char* b3 = b2 + kstep;
            if (last && has_next) S.a_ready(nxt);
            if constexpr (SP2) {
            PG8_LDB(B0, 0, 0); PG8_LDB(B1, 0, 1); PG8_SCHED; PG8_LDA(At, 0, 0); PG8_STAGE(PG8_SA(1, 1), a1 + hstepA, voffA);
            PG8_WAIT_V(8); PG8_WAIT_L(0); PG8_BAR; PG8_MMA(0, 0, At, B0); PG8_MMA(0, 1, At, B1); PG8_BAR; PG8_SCHED;
            PG8_LDA(At, 0, 1); PG8_STAGE(PG8_SB(0, 0), b2, voffB); PG8_STAGE(PG8_SB(0, 1), b2 + hstepB, voffB); PG8_STAGE(PG8_SA(0, 0), a2, voffA);
            PG8_WAIT_V(8); PG8_WAIT_L(0); PG8_BAR; PG8_MMA(1, 0, At, B0); PG8_MMA(1, 1, At, B1); PG8_BAR; PG8_SCHED;
            PG8_LDB(B0, 1, 0); PG8_LDB(B1, 1, 1); PG8_SCHED; PG8_LDA(At, 1, 0); PG8_STAGE(PG8_SA(0, 1), a2 + hstepA, voffA);
            PG8_WAIT_V(8); PG8_WAIT_L(0); PG8_BAR; PG8_MMA(0, 0, At, B0); PG8_MMA(0, 1, At, B1); PG8_BAR; PG8_SCHED;
            PG8_LDA(At, 1, 1); PG8_STAGE(PG8_SB(1, 0), b3, voffB); PG8_STAGE(PG8_SB(1, 1), b3 + hstepB, voffB); PG8_STAGE(PG8_SA(1, 0), a3, voffA);
            PG8_WAIT_V(8); PG8_WAIT_L(0); PG8_BAR; PG8_MMA(1, 0, At, B0); PG8_MMA(1, 1, At, B1); PG8_BAR; PG8_SCHED;
            } else {
            PG8_LDB(B0, 0, 0); PG8_SCHED; PG8_LDA(At, 0, 0); PG8_STAGE(PG8_SA(1, 1), a1 + hstepA, voffA);
            PG8_WAIT_L(8); PG8_BAR; PG8_WAIT_L(0); PG8_MMA(0, 0, At, B0); PG8_BAR; PG8_SCHED;
            PG8_LDB(B1, 0, 1); PG8_STAGE(PG8_SB(0, 0), b2, voffB);
            PG8_BAR; PG8_WAIT_L(0); PG8_MMA(0, 1, At, B1); PG8_BAR;
            PG8_LDA(At, 0, 1); PG8_STAGE(PG8_SA(0, 0), a2, voffA);
            PG8_BAR; PG8_WAIT_L(0); PG8_MMA(1, 0, At, B0); PG8_BAR; PG8_SCHED;
            PG8_STAGE(PG8_SB(0, 1), b2 + hstepB, voffB);
            PG8_WAIT_V(6); PG8_BAR; PG8_MMA(1, 1, At, B1); PG8_BAR;
            PG8_LDB(B0, 1, 0); PG8_SCHED; PG8_LDA(At, 1, 0); PG8_STAGE(PG8_SA(0, 1), a2 + hstepA, voffA);
            PG8_WAIT_L(8); PG8_BAR; PG8_WAIT_L(0); PG8_MMA(0, 0, At, B0); PG8_BAR; PG8_SCHED;
            PG8_LDB(B1, 1, 1); PG8_STAGE(PG8_SB(1, 0), b3, voffB);
            PG8_BAR; PG8_WAIT_L(0); PG8_MMA(0, 1, At, B1); PG8_BAR;
            PG8_LDA(At, 1, 1); PG8_STAGE(PG8_SA(1, 0), a3, voffA);
            PG8_BAR; PG8_WAIT_L(0); PG8_MMA(1, 0, At, B0); PG8_BAR; PG8_SCHED;
            PG8_STAGE(PG8_SB(1, 1), b3 + hstepB, voffB);
            PG8_WAIT_V(6); PG8_BAR; PG8_MMA(1, 1, At, B1); PG8_BAR;
            }
        }
        if constexpr (ALIGN_EPI) { if (wr == 0) PG8_BAR; }
        if constexpr (!Epi::AFTER_DRAIN) { E(acc, cur, wr, wc, fr, fq); S.done(cur); }
        if (!has_next) break;
#pragma unroll
        for (int a = 0; a < 2; ++a)
#pragma unroll
            for (int b = 0; b < 2; ++b)
#pragma unroll
                for (int m = 0; m < 4; ++m)
#pragma unroll
                    for (int n = 0; n < 2; ++n) acc[a][b][m][n] = (f32x4){0.f, 0.f, 0.f, 0.f};
        cur = nxt; cA = nA; cB = nB; ++ui;
        if constexpr (ALIGN_EPI) { if (wr == 1) PG8_BAR; }
    }
    PG8_WAIT_V(0);
    if constexpr (!ALIGN_EPI) { if (wr == 0) PG8_BAR; }
    PG8_BAR;
    if constexpr (Epi::AFTER_DRAIN) { E.fused(acc, cur, wr, wc, fr, fq, lds, wid, lane); S.done(cur); }
#undef PG8_SA
#undef PG8_SB
#undef PG8_STAGE
#undef PG8_LDA
#undef PG8_LDB
#undef PG8_MMA
#undef PG8_WAIT_V
#undef PG8_WAIT_L
#undef PG8_BAR
#undef PG8_SCHED
}
}

constexpr int D = 1024, BATCH = 32, SEQ = 2048, NTOK = BATCH * SEQ, DEPTH = 4;
constexpr int S5G = 32, S5P = 64, S5GS = 16;
constexpr int GH = 4, GDK = 64, GDV = 128;
constexpr int EPROJ = 2064, EPAD = 2304;
constexpr int PC_U = 0, PC_Q = 512, PC_K = 768, PC_V = 1024, PC_R = 1536, PC_A = 2048;
constexpr int MI = 2048, MH = 4, MDH = 512;
constexpr int FF = 2816;
constexpr float EPS = 1e-6f;
constexpr int NWAVES = 8, NTHREADS = 512;
constexpr int NPHASE = 1 + 10 * DEPTH;

constexpr size_t MiB = 1u << 20;
constexpr size_t WS_CTL = 0, CTL_ZERO_BYTES = 1 * MiB;
constexpr size_t WS_W_EVIN = 2 * MiB, SZ_W_EVIN = (size_t)EPAD * D * 2;
constexpr size_t WS_W_GLU = 11 * MiB, SZ_W_GLU = (size_t)512 * 512 * 2;
constexpr size_t WS_W_EVOUT = 12 * MiB, SZ_W_EVOUT = (size_t)D * D * 2;
constexpr size_t WS_W_ODIN = 16 * MiB, SZ_W_ODIN = (size_t)2 * MI * D * 2;
constexpr size_t WS_W_ODOUT = 32 * MiB, SZ_W_ODOUT = (size_t)D * MI * 2;
constexpr size_t WS_W_UP = 40 * MiB, SZ_W_UP = (size_t)2 * FF * D * 2;
constexpr size_t WS_W_DOWN = 84 * MiB, SZ_W_DOWN = (size_t)D * FF * 2;
constexpr size_t WS_HA = 112 * MiB;
constexpr size_t WS_SLOT = WS_HA + 2 * MiB;
constexpr size_t WS_GFR = WS_HA + 8 * MiB;
constexpr size_t WS_MIX = 240 * MiB;
constexpr size_t WS_BIG = 368 * MiB;
constexpr size_t WS_PBUF = WS_BIG;
constexpr size_t WS_YB2 = WS_BIG + 288 * MiB;
constexpr size_t WS_XM = WS_BIG;
constexpr size_t WS_XC = WS_BIG + 256 * MiB;
constexpr size_t WS_GATES = WS_BIG + 512 * MiB;
constexpr size_t WS_SS = WS_BIG + 514 * MiB;
constexpr size_t WS_ACT = WS_BIG;
constexpr size_t WS_HALO = WS_BIG + 352 * MiB, SZ_HALO = (size_t)(NTOK / 64) * 2 * FF * 4;
constexpr size_t WS_XS = WS_BIG + 520 * MiB;
constexpr size_t WS_END = WS_XS + 128 * MiB;
static_assert(WS_W_DOWN + 4 * SZ_W_DOWN <= WS_HA && WS_HALO + 3 * SZ_HALO <= WS_END && WS_SS + (size_t)NTOK * 16 * 4 <= WS_END, "d_ws map");
constexpr int CW_PAN = 16384;
constexpr int CW_BAR = 4096;

constexpr int RING_BYTES = 131072, LDS_BYTES = 163840, LDSCTL_OFF = LDS_BYTES - 2048, MISC_OFF = LDSCTL_OFF + 320, PTAB_OFF = LDSCTL_OFF + 1024;

#define GAS __attribute__((address_space(1)))
#define LAS __attribute__((address_space(3)))
typedef unsigned short bf16;
typedef float f32x4 __attribute__((ext_vector_type(4)));
typedef unsigned u32x4 __attribute__((ext_vector_type(4)));
typedef unsigned u32x2 __attribute__((ext_vector_type(2)));
#define LDS_WAIT() asm volatile("s_waitcnt lgkmcnt(0)" ::: "memory")
__device__ __forceinline__ unsigned f2bf(float f) { unsigned u = __builtin_bit_cast(unsigned, f); return (u + 0x7fffu + ((u >> 16) & 1u)) >> 16; }
__device__ __forceinline__ unsigned pk2(float lo, float hi) { return pg8::cvt_pk_bf16(lo, hi); }
__device__ __forceinline__ float bflo(unsigned u) { return __uint_as_float(u << 16); }
__device__ __forceinline__ float bfhi(unsigned u) { return __uint_as_float(u & 0xffff0000u); }
__device__ __forceinline__ float bf1(bf16 b) { return __uint_as_float(((unsigned)b) << 16); }
__device__ __forceinline__ unsigned short bf_rne(float x) { return __builtin_bit_cast(unsigned short, (__bf16)x); }
__device__ __forceinline__ void half_pair(float x, float& from_lo, float& from_hi) { const auto sw = __builtin_amdgcn_permlane32_swap(__float_as_uint(x), __float_as_uint(x), false, false); from_lo = __uint_as_float(sw[0]); from_hi = __uint_as_float(sw[1]); }
__device__ __forceinline__ float logsigm_fast(float x) { return fminf(x, 0.f) - __logf(1.0f + __expf(-fabsf(x))); }
__device__ __forceinline__ float row16_sum(float x) { x += dpp_mov<0xB1>(x); x += dpp_mov<0x4E>(x); x += dpp_mov<0x141>(x); x += dpp_mov<0x128>(x); return x; }
__device__ __forceinline__ float wave_scan_sum(float v, int) {
    v += dpp_z<0x111>(v); v += dpp_z<0x112>(v); v += dpp_z<0x114>(v); v += dpp_z<0x118>(v);
    v += dpp_o<0x142, 0xa>(0.f, v); v += dpp_o<0x143, 0xc>(0.f, v); return v; }
__device__ __forceinline__ float wave_scan_max(float v, int) {
    v = fmaxf(v, dpp_o<0x111, 0xf>(v, v)); v = fmaxf(v, dpp_o<0x112, 0xf>(v, v)); v = fmaxf(v, dpp_o<0x114, 0xf>(v, v)); v = fmaxf(v, dpp_o<0x118, 0xf>(v, v));
    v = fmaxf(v, dpp_o<0x142, 0xa>(v, v)); v = fmaxf(v, dpp_o<0x143, 0xc>(v, v)); return v; }
__device__ __forceinline__ float wave_sum(float v) { v = wave_scan_sum(v, 0); return __uint_as_float(__builtin_amdgcn_readlane(__float_as_uint(v), 63)); }
__device__ __forceinline__ int opaque_int(int v) { asm volatile("" : "+s"(v)); return v; }
__device__ __forceinline__ float sigm(float x) { return __builtin_amdgcn_rcpf(1.0f + __expf(-x)); }
__device__ __forceinline__ float logsigm(float x) { return fminf(x, 0.f) - log1pf(expf(-fabsf(x))); }
__device__ __forceinline__ float gelu_t(float x) { const float t = 1.5957691216057308f * (x + 0.044715f * x * x * x); return x * __builtin_amdgcn_rcpf(1.0f + __expf(-t)); }

#define XB_TMO      128
#define XB_XCNT(j)  (256  + 64 * (j))
#define XB_XSUB(j)  (1280 + 64 * (j))
#define XB_XGEN(j)  (2304 + 64 * (j))
#define XB_TOP      3328
#define XB_TOPGEN   3392
#define XCD_BAR_WORDS 3456
#define XB_SPIN_CAP (1u << 20)
__device__ __forceinline__ unsigned xb_ld(unsigned* p)              { return __hip_atomic_load(p, __ATOMIC_RELAXED, __HIP_MEMORY_SCOPE_AGENT); }
__device__ __forceinline__ unsigned xb_add(unsigned* p, unsigned v) { return __hip_atomic_fetch_add(p, v, __ATOMIC_RELAXED, __HIP_MEMORY_SCOPE_AGENT); }
__device__ __forceinline__ unsigned xb_xcc_id() { return (unsigned)__builtin_amdgcn_s_getreg((3 << 11) | 20) & 0xFu; }
#define XB_SPIN(cond, bar) do { unsigned _sp = 0; while (cond) { __builtin_amdgcn_s_sleep(1); \
    if ((++_sp & 255u) == 0u) { if (xb_ld(&(bar)[XB_TMO])) break; if (_sp > XB_SPIN_CAP) { atomicAdd(&(bar)[XB_TMO], 1u); break; } } } } while (0)
struct XcdBarrier { unsigned* bar; unsigned x; volatile LAS unsigned* st; };
__device__ __forceinline__ XcdBarrier xcd_barrier_post(unsigned* bar, volatile LAS unsigned* st) {
    XcdBarrier b; b.bar = bar; b.x = xb_xcc_id(); b.st = st;
    if (threadIdx.x == 0) (void)xb_add(&bar[XB_XCNT(b.x)], 1u);
    return b;
}
__device__ __forceinline__ void xcd_barrier_complete(unsigned* bar, unsigned x, unsigned& nloc, unsigned& nx) {
    const unsigned G = gridDim.x * gridDim.y * gridDim.z;
    unsigned sum, cnt, mine, sp = 0u;
    for (;;) {
        sum = 0u; cnt = 0u; mine = 0u;
#pragma unroll
        for (unsigned j = 0; j < 16; ++j) { const unsigned c = xb_ld(&bar[XB_XCNT(j)]); sum += c; cnt += (c > 0u) ? 1u : 0u; mine = (j == x) ? c : mine; }
        if (sum == G) break;
        __builtin_amdgcn_s_sleep(1);
        if ((++sp & 255u) == 0u) { if (xb_ld(&bar[XB_TMO])) break; if (sp > XB_SPIN_CAP) { atomicAdd(&bar[XB_TMO], 1u); break; } }
    }
    nloc = mine > 0u ? mine : 1u; nx = cnt > 0u ? cnt : 1u;
}
__device__ __forceinline__ void xcd_barrier(const XcdBarrier& b) {
    asm volatile("s_waitcnt vmcnt(0)" ::: "memory");
    __syncthreads();
    if (threadIdx.x == 0) {
        unsigned* bar = b.bar;
        __builtin_amdgcn_s_waitcnt(0);
        unsigned nloc = b.st[0], nx = b.st[1];
        if (nloc == 0u) { xcd_barrier_complete(bar, b.x, nloc, nx); b.st[0] = nloc; b.st[1] = nx; }
        const unsigned old = xb_add(&bar[XB_XSUB(b.x)], 1u);
        const unsigned gen = old / nloc;
        if (old + 1u == (gen + 1u) * nloc) {
            __builtin_amdgcn_fence(__ATOMIC_RELEASE, "agent");
            asm volatile("s_waitcnt vmcnt(0)" ::: "memory");
            const unsigned og = xb_add(&bar[XB_TOP], 1u);
            const unsigned tg = og / nx;
            if (og + 1u == (tg + 1u) * nx) xb_add(&bar[XB_TOPGEN], 1u);
            else XB_SPIN(xb_ld(&bar[XB_TOPGEN]) == tg, bar);
            __builtin_amdgcn_fence(__ATOMIC_ACQUIRE, "agent");
            xb_add(&bar[XB_XGEN(b.x)], 1u);
            asm volatile("s_waitcnt vmcnt(0)" ::: "memory");
        } else {
            XB_SPIN(xb_ld(&bar[XB_XGEN(b.x)]) == gen, bar);
            __builtin_amdgcn_fence(__ATOMIC_ACQUIRE, "agent");
            asm volatile("s_waitcnt vmcnt(0)" ::: "memory");
        }
    }
    __syncthreads();
}

struct Args { const float* in[35]; float* out; unsigned char* ws; int ph_lo, ph_hi; };
struct Ctx { const LAS unsigned long long* tab; unsigned char* ws;
    __device__ __forceinline__ const float* in(int i) const { const unsigned long long v = tab[i];
        const unsigned lo = __builtin_amdgcn_readfirstlane((unsigned)v), hi = __builtin_amdgcn_readfirstlane((unsigned)(v >> 32));
        return (const float*)(((unsigned long long)hi << 32) | lo); } };
enum { I_X = 0, I_LN_MIX_PRE, I_LN_MIX_POST, I_LN_FFN_PRE, I_LN_FFN_POST, I_EV_W_IN, I_S5_LRE, I_S5_LIM, I_S5_BRE, I_S5_BIM, I_S5_CRE, I_S5_CIM, I_S5_D, I_S5_LOGDT, I_S5_WGLU, I_S5_BGLU,
       I_GLA_WUP, I_GLA_BALPHA, I_GLA_NORM, I_EV_W_OUT, I_OD_W_IN, I_ML_CONV_W, I_ML_CONV_B, I_ML_WQ, I_ML_WK, I_ML_WV, I_ML_WGATE, I_ML_BGATE, I_ML_NORM, I_ML_SKIP, I_OD_W_OUT,
       I_FFN_W_UP, I_FFN_CONV_W, I_FFN_CONV_B, I_FFN_W_DOWN };

__device__ __forceinline__ void transpose_item(const float* W, int K, int ldw, int sc0, int nvalid, bf16* WT, int n0, int k0, LAS float* scr, int lane, const float* gk = nullptr) {
    { const int c4 = lane & 7, rsub = lane >> 3;
      f32x4 v[8]; float gsc[8];
#pragma unroll
      for (int i = 0; i < 8; ++i) { const int kk = 8 * i + rsub; gsc[i] = gk ? gk[k0 + kk] : 1.0f;
          v[i] = (4 * c4 < nvalid) ? *(const f32x4*)(W + (size_t)(k0 + kk) * ldw + sc0 + 4 * c4) : (f32x4){0.f, 0.f, 0.f, 0.f}; }
#pragma unroll
      for (int i = 0; i < 8; ++i) { const int kk = 8 * i + rsub; LAS float* d = scr + kk * 33 + 4 * c4; const f32x4 t = v[i] * gsc[i]; d[0] = t[0]; d[1] = t[1]; d[2] = t[2]; d[3] = t[3]; } }
    LDS_WAIT(); asm volatile("" ::: "memory");
    const int c8 = lane & 7;
#pragma unroll
    for (int j = 0; j < 4; ++j) { const int n = (lane >> 3) + 8 * j; const LAS float* s = scr + (8 * c8) * 33 + n;
        u32x4 o; o.x = pk2(s[0 * 33], s[1 * 33]); o.y = pk2(s[2 * 33], s[3 * 33]); o.z = pk2(s[4 * 33], s[5 * 33]); o.w = pk2(s[6 * 33], s[7 * 33]);
        *(u32x4*)(WT + (size_t)(n0 + n) * K + k0 + 8 * c8) = o; }
    LDS_WAIT(); asm volatile("" ::: "memory");
}
__device__ __forceinline__ void prologue_weights(const Ctx& a, LAS unsigned char* lds, int gw, int NGW, int wave, int lane) {
    LAS float* scr = (LAS float*)(lds + wave * 16384);
    unsigned char* ws = a.ws;
    constexpr int I_EVIN = (D / 64) * (EPAD / 32), I_GLU = (512 / 64) * (512 / 32), I_EVOUT = (D / 64) * (D / 32), I_ODIN = (D / 64) * (2 * MI / 32), I_ODOUT = (MI / 64) * (D / 32),
                  I_UP = (D / 64) * (2 * FF / 32), I_DOWN = (FF / 64) * (D / 32);
    constexpr int NITEMS = 2 * (I_EVIN + I_GLU + I_EVOUT + I_ODIN + I_ODOUT) + 4 * (I_UP + I_DOWN);
    for (int it = gw; it < NITEMS; it += NGW) {
        int r = it;
        if (r < 2 * I_EVIN) { const int e = r / I_EVIN; r %= I_EVIN; const int nb = r % (EPAD / 32), kb = r / (EPAD / 32), n0 = nb * 32; int nv = EPROJ - n0; nv = nv < 0 ? 0 : (nv > 32 ? 32 : nv);
            transpose_item(a.in(I_EV_W_IN) + (size_t)e * D * EPROJ, D, EPROJ, n0, nv, (bf16*)(ws + WS_W_EVIN + e * SZ_W_EVIN), n0, kb * 64, scr, lane, a.in(I_LN_MIX_PRE) + (2 * e) * D); continue; } r -= 2 * I_EVIN;
        if (r < 2 * I_GLU) { const int e = r / I_GLU; r %= I_GLU; const int nb = r % 16, kb = r / 16;
            transpose_item(a.in(I_S5_WGLU) + (size_t)e * 512 * 512, 512, 512, nb * 32, 32, (bf16*)(ws + WS_W_GLU + e * SZ_W_GLU), nb * 32, kb * 64, scr, lane); continue; } r -= 2 * I_GLU;
        if (r < 2 * I_EVOUT) { const int e = r / I_EVOUT; r %= I_EVOUT; const int nb = r % 32, kb = r / 32;
            transpose_item(a.in(I_EV_W_OUT) + (size_t)e * D * D, D, D, nb * 32, 32, (bf16*)(ws + WS_W_EVOUT + e * SZ_W_EVOUT), nb * 32, kb * 64, scr, lane); continue; } r -= 2 * I_EVOUT;
        if (r < 2 * I_ODIN) { const int e = r / I_ODIN; r %= I_ODIN; const int nb = r % 128, kb = r / 128;
            transpose_item(a.in(I_OD_W_IN) + (size_t)e * D * 2 * MI, D, 2 * MI, nb * 32, 32, (bf16*)(ws + WS_W_ODIN + e * SZ_W_ODIN), nb * 32, kb * 64, scr, lane, a.in(I_LN_MIX_PRE) + (2 * e + 1) * D); continue; } r -= 2 * I_ODIN;
        if (r < 2 * I_ODOUT) { const int e = r / I_ODOUT; r %= I_ODOUT; const int nb = r % 32, kb = r / 32;
            transpose_item(a.in(I_OD_W_OUT) + (size_t)e * MI * D, MI, D, nb * 32, 32, (bf16*)(ws + WS_W_ODOUT + e * SZ_W_ODOUT), nb * 32, kb * 64, scr, lane); continue; } r -= 2 * I_ODOUT;
        if (r < 4 * I_UP) { const int l = r / I_UP; r %= I_UP; const int nb = r % 176, kb = r / 176, n0 = nb * 32;
            const int pn = n0 >> 8, half = (n0 >> 7) & 1, c = n0 & 127, sc0 = half * FF + pn * 128 + c;
            transpose_item(a.in(I_FFN_W_UP) + (size_t)l * D * 2 * FF, D, 2 * FF, sc0, 32, (bf16*)(ws + WS_W_UP + l * SZ_W_UP), n0, kb * 64, scr, lane, a.in(I_LN_FFN_PRE) + l * D); continue; } r -= 4 * I_UP;
        { const int l = r / I_DOWN; r %= I_DOWN; const int nb = r % 32, kb = r / 32;
            transpose_item(a.in(I_FFN_W_DOWN) + (size_t)l * FF * D, FF, D, nb * 32, 32, (bf16*)(ws + WS_W_DOWN + l * SZ_W_DOWN), nb * 32, kb * 64, scr, lane); }
    }
}

template <int XIN, int XOUT>
__device__ __forceinline__ void norm_phase(const bf16* mix, const float* gpost, const void* xin, void* xout, float* rs_out, int gw, int NGW, int lane) {
    f32x4 nv[4]; u32x2 nb[4], nm[4];
    f32x4 gp4[4];
#pragma unroll
    for (int j = 0; j < 4; ++j) gp4[j] = mix ? *((const f32x4*)gpost + lane + 64 * j) : (f32x4){0.f, 0.f, 0.f, 0.f};
    auto load_row = [&](int row) {
        if (XIN == 0) { const f32x4* xr = (const f32x4*)((const float*)xin + (size_t)row * D) + lane;
#pragma unroll
            for (int j = 0; j < 4; ++j) nv[j] = xr[64 * j]; }
        else { const u32x2* xr = (const u32x2*)((const bf16*)xin + (size_t)row * D) + lane;
#pragma unroll
            for (int j = 0; j < 4; ++j) nb[j] = xr[64 * j]; }
        if (mix) { const u32x2* mr = (const u32x2*)(mix + (size_t)row * D) + lane;
#pragma unroll
            for (int j = 0; j < 4; ++j) nm[j] = mr[64 * j]; } };
    load_row(gw < NTOK ? gw : 0);
    for (int row = gw; row < NTOK; row += NGW) {
        f32x4 v[4]; u32x2 mraw[4];
#pragma unroll
        for (int j = 0; j < 4; ++j) { v[j] = (XIN == 0) ? nv[j] : (f32x4){bflo(nb[j].x), bfhi(nb[j].x), bflo(nb[j].y), bfhi(nb[j].y)}; mraw[j] = nm[j]; }
        load_row((row + NGW < NTOK) ? row + NGW : row);
        if (mix) {
            f32x4 mv[4]; float s = 0.f;
#pragma unroll
            for (int j = 0; j < 4; ++j) { const u32x2 t = mraw[j]; mv[j] = (f32x4){bflo(t.x), bfhi(t.x), bflo(t.y), bfhi(t.y)}; s += (mv[j].x * mv[j].x + mv[j].y * mv[j].y) + (mv[j].z * mv[j].z + mv[j].w * mv[j].w); }
            const float rstd = rsqrtf(wave_sum(s) * (1.f / D) + EPS);
#pragma unroll
            for (int j = 0; j < 4; ++j) v[j] = v[j] + mv[j] * rstd * gp4[j];
        }
        if (XOUT == 0) { f32x4* xo = (f32x4*)((float*)xout + (size_t)row * D) + lane;
#pragma unroll
            for (int j = 0; j < 4; ++j) xo[64 * j] = v[j]; }
        else { u32x2* xo = (u32x2*)((bf16*)xout + (size_t)row * D) + lane;
#pragma unroll
            for (int j = 0; j < 4; ++j) { u32x2 o; o.x = pk2(v[j].x, v[j].y); o.y = pk2(v[j].z, v[j].w); xo[64 * j] = o; } }
        if (rs_out) {
            float s2 = 0.f;
#pragma unroll
            for (int j = 0; j < 4; ++j) s2 += (v[j].x * v[j].x + v[j].y * v[j].y) + (v[j].z * v[j].z + v[j].w * v[j].w);
            const float t2 = wave_sum(s2);
            if (lane == 0) *(f32x4*)(rs_out + 4 * (size_t)row) = (f32x4){t2, 0.f, 0.f, 0.f};
        }
    }
}

__device__ __forceinline__ void s5_unit_simple(const Ctx& a, int e, bf16* pbuf, bf16* yout, int ypitch, LAS unsigned char* lds, int wgS, int tid, int wave, int lane) {
    const int g = wgS & 31, b = (wgS >> 5) * 8 + wave, eg = e * S5G + g;
    LAS float* Cc = (LAS float*)lds;
    LAS float* X = (LAS float*)(lds + 16 * 132 * 4) + wave * (16 * 132);
    { const float* cre = a.in(I_S5_CRE) + (size_t)eg * 16 * 64; const float* cim = a.in(I_S5_CIM) + (size_t)eg * 16 * 64;
      for (int idx = tid; idx < 2048; idx += NTHREADS) { const int i = idx >> 7, c = idx & 127; Cc[i * 132 + c] = (c < 64) ? cre[i * 64 + c] : -cim[i * 64 + c - 64]; } }
    const int p = lane;
    const float dt = expf(a.in(I_S5_LOGDT)[eg]);
    const float lr = a.in(I_S5_LRE)[eg * 64 + p], li = a.in(I_S5_LIM)[eg * 64 + p];
    const float mag = expf(lr * dt), lbr = mag * cosf(li * dt), lbi = mag * sinf(li * dt);
    const float inv = 1.0f / (lr * lr + li * li);
    const float zr = ((lbr - 1.0f) * lr + lbi * li) * inv, zi = (lbi * lr - (lbr - 1.0f) * li) * inv;
    float bbr[16], bbi[16];
    { const float* bre = a.in(I_S5_BRE) + ((size_t)eg * 64 + p) * 16; const float* bim = a.in(I_S5_BIM) + ((size_t)eg * 64 + p) * 16;
#pragma unroll
      for (int i = 0; i < 16; ++i) { const float br = bre[i], bi = bim[i]; bbr[i] = zr * br - zi * bi; bbi[i] = zr * bi + zi * br; } }
    const int tt2 = lane >> 2, i0 = (lane & 3) * 4;
    const f32x4 dsk = *(const f32x4*)(a.in(I_S5_D) + eg * 16 + i0);
    __syncthreads();
    float xr = 0.f, xi = 0.f;
    for (int blk = 0; blk < SEQ / 64; ++blk) {
        const size_t tok0 = (size_t)b * SEQ + blk * 64;
        float uf[16];
        { const u32x4* up = (const u32x4*)(pbuf + (tok0 + lane) * EPAD + PC_U + g * 16); const u32x4 u0 = up[0], u1 = up[1];
          uf[0] = bflo(u0.x); uf[1] = bfhi(u0.x); uf[2] = bflo(u0.y); uf[3] = bfhi(u0.y); uf[4] = bflo(u0.z); uf[5] = bfhi(u0.z); uf[6] = bflo(u0.w); uf[7] = bfhi(u0.w);
          uf[8] = bflo(u1.x); uf[9] = bfhi(u1.x); uf[10] = bflo(u1.y); uf[11] = bfhi(u1.y); uf[12] = bflo(u1.z); uf[13] = bfhi(u1.z); uf[14] = bflo(u1.w); uf[15] = bfhi(u1.w); }
        for (int sb = 0; sb < 4; ++sb) {
            for (int tt = 0; tt < 16; ++tt) {
                const int t = sb * 16 + tt;
                float br = 0.f, bi = 0.f;
#pragma unroll
                for (int i = 0; i < 16; ++i) { const float s = __uint_as_float(__builtin_amdgcn_readlane(__float_as_uint(uf[i]), t)); br = fmaf(bbr[i], s, br); bi = fmaf(bbi[i], s, bi); }
                const float nxr = lbr * xr - lbi * xi + br, nxi = lbr * xi + lbi * xr + bi;
                xr = nxr; xi = nxi;
                X[tt * 132 + p] = xr; X[tt * 132 + 64 + p] = xi;
            }
            LDS_WAIT(); asm volatile("" ::: "memory");
            float y0 = 0.f, y1 = 0.f, y2 = 0.f, y3 = 0.f;
#pragma unroll 8
            for (int c4 = 0; c4 < 32; ++c4) {
                const f32x4 xv = *(const LAS f32x4*)(X + tt2 * 132 + 4 * c4);
                const f32x4 c0 = *(const LAS f32x4*)(Cc + (i0 + 0) * 132 + 4 * c4), c1 = *(const LAS f32x4*)(Cc + (i0 + 1) * 132 + 4 * c4);
                const f32x4 c2 = *(const LAS f32x4*)(Cc + (i0 + 2) * 132 + 4 * c4), c3 = *(const LAS f32x4*)(Cc + (i0 + 3) * 132 + 4 * c4);
                y0 += (xv.x * c0.x + xv.y * c0.y) + (xv.z * c0.z + xv.w * c0.w); y1 += (xv.x * c1.x + xv.y * c1.y) + (xv.z * c1.z + xv.w * c1.w);
                y2 += (xv.x * c2.x + xv.y * c2.y) + (xv.z * c2.z + xv.w * c2.w); y3 += (xv.x * c3.x + xv.y * c3.y) + (xv.z * c3.z + xv.w * c3.w);
            }
            { const bf16* up2 = pbuf + (tok0 + sb * 16 + tt2) * EPAD + PC_U + g * 16 + i0; const u32x2 uu = *(const u32x2*)up2; bf16* yp = yout + (tok0 + sb * 16 + tt2) * ypitch + g * 16 + i0;
              y0 += dsk.x * bflo(uu.x); y1 += dsk.y * bfhi(uu.x); y2 += dsk.z * bflo(uu.y); y3 += dsk.w * bfhi(uu.y);
              u32x2 o; o.x = pk2(gelu_t(y0), gelu_t(y1)); o.y = pk2(gelu_t(y2), gelu_t(y3)); *(u32x2*)yp = o; }
            LDS_WAIT(); asm volatile("" ::: "memory");
        }
    }
}

__device__ __forceinline__ void gla_unit_simple(const Ctx& a, int e_, const bf16* pbuf, bf16* yb2, LAS unsigned char* lds, int unit, int tid, int wave, int lane) {
    const int b = unit >> 2, h = unit & 3;
    LAS float* WUP = (LAS float*)lds;
    LAS float* Qs = WUP + 16 * 64;
    LAS float* Ks = Qs + 16 * 64;
    LAS float* As = Ks + 16 * 64;
    LAS float* Vs = As + 16 * 64;
    LAS float* Rs = Vs + 16 * 128;
    LAS float* OP = Rs + 16 * 128;
    { const float* wup = a.in(I_GLA_WUP) + (size_t)e_ * 16 * 256; for (int idx = tid; idx < 1024; idx += NTHREADS) { const int j = idx >> 6, d = idx & 63; WUP[idx] = wup[j * 256 + h * 64 + d]; } }
    const int e = tid & 127, dq = tid >> 7;
    const int st = tid >> 5, sl = tid & 31;
    const float ba0 = a.in(I_GLA_BALPHA)[e_ * 256 + h * 64 + 2 * sl], ba1 = a.in(I_GLA_BALPHA)[e_ * 256 + h * 64 + 2 * sl + 1];
    const int ft = tid >> 5, fe = (tid & 31) * 4;
    const f32x4 gnv = *(const f32x4*)(a.in(I_GLA_NORM) + e_ * 512 + h * 128 + fe);
    float S[16];
#pragma unroll
    for (int i = 0; i < 16; ++i) S[i] = 0.f;
    __syncthreads();
    for (int blk = 0; blk < SEQ / 16; ++blk) {
        const size_t tok0 = (size_t)b * SEQ + blk * 16;
        { const bf16* row = pbuf + (tok0 + st) * EPAD;
          const unsigned qq = *(const unsigned*)(row + PC_Q + h * 64 + 2 * sl), kk = *(const unsigned*)(row + PC_K + h * 64 + 2 * sl);
          const u32x2 vv = *(const u32x2*)(row + PC_V + h * 128 + 4 * sl), rr = *(const u32x2*)(row + PC_R + h * 128 + 4 * sl);
          const u32x4 a0 = *(const u32x4*)(row + PC_A), a1 = *(const u32x4*)(row + PC_A + 8);
          float al[16]; al[0] = bflo(a0.x); al[1] = bfhi(a0.x); al[2] = bflo(a0.y); al[3] = bfhi(a0.y); al[4] = bflo(a0.z); al[5] = bfhi(a0.z); al[6] = bflo(a0.w); al[7] = bfhi(a0.w);
          al[8] = bflo(a1.x); al[9] = bfhi(a1.x); al[10] = bflo(a1.y); al[11] = bfhi(a1.y); al[12] = bflo(a1.z); al[13] = bfhi(a1.z); al[14] = bflo(a1.w); al[15] = bfhi(a1.w);
          float z0 = ba0, z1 = ba1;
#pragma unroll
          for (int j = 0; j < 16; ++j) { z0 = fmaf(al[j], WUP[j * 64 + 2 * sl], z0); z1 = fmaf(al[j], WUP[j * 64 + 2 * sl + 1], z1); }
          Qs[st * 64 + 2 * sl] = bflo(qq) * 0.125f; Qs[st * 64 + 2 * sl + 1] = bfhi(qq) * 0.125f;
          Ks[st * 64 + 2 * sl] = bflo(kk); Ks[st * 64 + 2 * sl + 1] = bfhi(kk);
          As[st * 64 + 2 * sl] = expf(logsigm(z0) * (1.0f / 16.0f)); As[st * 64 + 2 * sl + 1] = expf(logsigm(z1) * (1.0f / 16.0f));
          *(LAS f32x4*)(Vs + st * 128 + 4 * sl) = (f32x4){bflo(vv.x), bfhi(vv.x), bflo(vv.y), bfhi(vv.y)};
          *(LAS f32x4*)(Rs + st * 128 + 4 * sl) = (f32x4){bflo(rr.x), bfhi(rr.x), bflo(rr.y), bfhi(rr.y)}; }
        __syncthreads();
        for (int t = 0; t < 16; ++t) {
            const float v = Vs[t * 128 + e]; float o = 0.f;
#pragma unroll
            for (int d4 = 0; d4 < 4; ++d4) {
                const f32x4 av = *(const LAS f32x4*)(As + t * 64 + dq * 16 + 4 * d4), kv = *(const LAS f32x4*)(Ks + t * 64 + dq * 16 + 4 * d4), qv = *(const LAS f32x4*)(Qs + t * 64 + dq * 16 + 4 * d4);
                S[4 * d4 + 0] = av.x * S[4 * d4 + 0] + kv.x * v; o = fmaf(qv.x, S[4 * d4 + 0], o);
                S[4 * d4 + 1] = av.y * S[4 * d4 + 1] + kv.y * v; o = fmaf(qv.y, S[4 * d4 + 1], o);
                S[4 * d4 + 2] = av.z * S[4 * d4 + 2] + kv.z * v; o = fmaf(qv.z, S[4 * d4 + 2], o);
                S[4 * d4 + 3] = av.w * S[4 * d4 + 3] + kv.w * v; o = fmaf(qv.w, S[4 * d4 + 3], o);
            }
            OP[(dq * 16 + t) * 128 + e] = o;
        }
        __syncthreads();
        { f32x4 o = *(const LAS f32x4*)(OP + (0 * 16 + ft) * 128 + fe);
          o = o + *(const LAS f32x4*)(OP + (1 * 16 + ft) * 128 + fe); o = o + *(const LAS f32x4*)(OP + (2 * 16 + ft) * 128 + fe); o = o + *(const LAS f32x4*)(OP + (3 * 16 + ft) * 128 + fe);
          float s = (o.x * o.x + o.y * o.y) + (o.z * o.z + o.w * o.w);
#pragma unroll
          for (int off = 1; off < 32; off <<= 1) s += __shfl_xor(s, off);
          const float rstd = rsqrtf(s * (1.0f / 128.0f) + EPS);
          const f32x4 r = *(const LAS f32x4*)(Rs + ft * 128 + fe);
          const f32x4 res = o * rstd * gnv * (f32x4){r.x * sigm(r.x), r.y * sigm(r.y), r.z * sigm(r.z), r.w * sigm(r.w)};
          u32x2 w; w.x = pk2(res.x, res.y); w.y = pk2(res.z, res.w);
          *(u32x2*)(yb2 + (tok0 + ft) * D + 512 + h * 128 + fe) = w; }
        __syncthreads();
    }
}

typedef short pp_bf16x8 __attribute__((ext_vector_type(8)));
__device__ __forceinline__ void prepass_frag_table(const Ctx& a, int gtid, int gthreads) {
    u32x4* gt = (u32x4*)(a.ws + WS_GFR);
    for (int i = gtid; i < 2 * 8 * 8 * 64; i += gthreads) {
        const int lane = i & 63, s8 = (i >> 6) & 7, w = (i >> 9) & 7, o_ = i >> 12;
        const int gn = lane & 7, q = lane >> 4; const float gon = ((lane & 15) < 8) ? 1.0f : 0.0f;
        const float* WG = a.in(I_ML_WGATE) + (size_t)o_ * 3 * MI * 8;
        unsigned wc_[4], wm_[4];
#pragma unroll
        for (int bb = 0; bb < 2; ++bb) {
            const int blk = 64 * w + 8 * s8 + 2 * q + bb;
            float g0[4], g1[4], g2[4];
#pragma unroll
            for (int d = 0; d < 4; ++d) { g0[d] = WG[((size_t)0 * MI + 4 * blk + d) * 8 + gn] * gon; g1[d] = WG[((size_t)1 * MI + 4 * blk + d) * 8 + gn] * gon; g2[d] = WG[((size_t)2 * MI + 4 * blk + d) * 8 + gn] * gon; }
            float vc[4], vm[4];
#pragma unroll
            for (int c = 0; c < 4; ++c) {
                const f32x4 wq = *(const f32x4*)(a.in(I_ML_WQ) + ((size_t)o_ * 512 + blk) * 16 + 4 * c), wk = *(const f32x4*)(a.in(I_ML_WK) + ((size_t)o_ * 512 + blk) * 16 + 4 * c),
                            wv = *(const f32x4*)(a.in(I_ML_WV) + ((size_t)o_ * 512 + blk) * 16 + 4 * c);
                float sc = 0.f, sm = 0.f;
#pragma unroll
                for (int d = 0; d < 4; ++d) { sc = fmaf(wq[d], g0[d], sc); sc = fmaf(wk[d], g1[d], sc); sm = fmaf(wv[d], g2[d], sm); }
                vc[c] = sc; vm[c] = sm; }
            wc_[2 * bb] = pk2(vc[0], vc[1]); wc_[2 * bb + 1] = pk2(vc[2], vc[3]); wm_[2 * bb] = pk2(vm[0], vm[1]); wm_[2 * bb + 1] = pk2(vm[2], vm[3]);
        }
        gt[((size_t)(o_ * 8 + w) * 16 + s8) * 64 + lane] = (u32x4){wc_[0], wc_[1], wc_[2], wc_[3]};
        gt[((size_t)(o_ * 8 + w) * 16 + 8 + s8) * 64 + lane] = (u32x4){wm_[0], wm_[1], wm_[2], wm_[3]};
    }
}
constexpr int PP_TP = 1040;
__device__ __forceinline__ void mlstm_prepass(const Ctx& a, int o_, const bf16* xm, bf16* xc, float* gates, LAS unsigned char* lds, int wg, int nwg, int tid, int wave, int lane) {
    LAS float* P = (LAS float*)lds;
    LAS unsigned char* T = lds + 16384 + wave * (16 * PP_TP);
    const int n = tid;
    f32x4 cw[4], cb;
#pragma unroll
    for (int k = 0; k < 4; ++k) cw[k] = *(const f32x4*)(a.in(I_ML_CONV_W) + ((size_t)o_ * 4 + k) * MI + 4 * n);
    cb = *(const f32x4*)(a.in(I_ML_CONV_B) + (size_t)o_ * MI + 4 * n);
    pp_bf16x8 gfr[16];
    { const u32x4* gt = (const u32x4*)(a.ws + WS_GFR) + ((size_t)(o_ * 8 + wave) * 16) * 64 + lane;
#pragma unroll
      for (int s = 0; s < 16; ++s) gfr[s] = __builtin_bit_cast(pp_bf16x8, gt[64 * s]); }
    for (int chunk = wg; chunk < NTOK / 256; chunk += nwg) {
        const size_t tokc = (size_t)chunk * 256;
        const int tpos0 = (int)(tokc % SEQ);
        f32x4 x0 = (f32x4){0.f, 0.f, 0.f, 0.f}, x1 = x0, x2 = x0;
        if (tpos0 > 0) {
            const u32x2 r0 = *(const u32x2*)(xm + (tokc - 3) * MI + 4 * n), r1 = *(const u32x2*)(xm + (tokc - 2) * MI + 4 * n), r2 = *(const u32x2*)(xm + (tokc - 1) * MI + 4 * n);
            x0 = (f32x4){bflo(r0.x), bfhi(r0.x), bflo(r0.y), bfhi(r0.y)}; x1 = (f32x4){bflo(r1.x), bfhi(r1.x), bflo(r1.y), bfhi(r1.y)}; x2 = (f32x4){bflo(r2.x), bfhi(r2.x), bflo(r2.y), bfhi(r2.y)};
        }
        u32x2 nxt[8];
#pragma unroll
        for (int j = 0; j < 8; ++j) nxt[j] = *(const u32x2*)(xm + (tokc + j) * MI + 4 * n);
        for (int sub = 0; sub < 4; ++sub) {
            for (int grp = 0; grp < 8; ++grp) {
                u32x2 cur[8];
#pragma unroll
                for (int j = 0; j < 8; ++j) cur[j] = nxt[j];
                { const size_t tn = tokc + sub * 64 + grp * 8 + 8; const size_t tnc = (tn + 8 <= tokc + 256) ? tn : tokc;
#pragma unroll
                  for (int j = 0; j < 8; ++j) nxt[j] = *(const u32x2*)(xm + (tnc + j) * MI + 4 * n); }
#pragma unroll
                for (int j8 = 0; j8 < 8; ++j8) {
                    const size_t tok = tokc + sub * 64 + grp * 8 + j8;
                    const u32x2 r3 = cur[j8];
                    const f32x4 x3 = (f32x4){bflo(r3.x), bfhi(r3.x), bflo(r3.y), bfhi(r3.y)};
                    f32x4 cv = cb + cw[0] * x0 + cw[1] * x1 + cw[2] * x2 + cw[3] * x3;
                    const f32x4 xcv = (f32x4){cv.x * sigm(cv.x), cv.y * sigm(cv.y), cv.z * sigm(cv.z), cv.w * sigm(cv.w)};
                    u32x2 w; w.x = pk2(xcv.x, xcv.y); w.y = pk2(xcv.z, xcv.w);
                    *(u32x2*)(xc + tok * MI + 4 * n) = w;
                    LAS unsigned char* trow = T + ((grp & 1) * 8 + j8) * PP_TP + 8 * lane;
                    *(LAS u32x2*)trow = w; *(LAS u32x2*)(trow + 512) = r3;
                    x0 = x1; x1 = x2; x2 = x3;
                }
                if (grp & 1) {
                    asm volatile("s_waitcnt lgkmcnt(0)" ::: "memory");
                    f32x4 d0 = (f32x4){0.f, 0.f, 0.f, 0.f}, d1 = d0;
                    const LAS unsigned char* arow = T + (lane & 15) * PP_TP + (lane >> 4) * 16;
#pragma unroll
                    for (int s = 0; s < 16; s += 2) {
                        const pp_bf16x8 a0 = *(const LAS pp_bf16x8*)(arow + (s >> 3) * 512 + (s & 7) * 64), a1 = *(const LAS pp_bf16x8*)(arow + ((s + 1) >> 3) * 512 + ((s + 1) & 7) * 64);
                        d0 = __builtin_amdgcn_mfma_f32_16x16x32_bf16(a0, gfr[s], d0, 0, 0, 0); d1 = __builtin_amdgcn_mfma_f32_16x16x32_bf16(a1, gfr[s + 1], d1, 0, 0, 0); }
                    d0 = d0 + d1;
                    if ((lane & 15) < 8) {
#pragma unroll
                        for (int r = 0; r < 4; ++r) P[(wave * 64 + (grp >> 1) * 16 + 4 * (lane >> 4) + r) * 8 + (lane & 15)] = d0[r]; }
                    asm volatile("" ::: "memory");
                }
            }
            __syncthreads();
            { const int tl = tid >> 3, g8 = tid & 7; float s = a.in(I_ML_BGATE)[o_ * 8 + g8];
#pragma unroll
              for (int w = 0; w < 8; ++w) s += P[(w * 64 + tl) * 8 + g8];
              if (g8 >= 4) s = logsigm(s);
              gates[(tokc + sub * 64 + tl) * 8 + g8] = s; }
            __syncthreads();
        }
    }
}

__device__ __forceinline__ void mlstm_unit_simple(const Ctx& a, int o_, bf16* xm, const bf16* xc, const float* gates, float* SS, LAS unsigned char* lds, int unit, int tid, int wave, int lane) {
    const int es = unit & 3, h = (unit >> 2) & 3, b = unit >> 4;
    LAS float* Qs = (LAS float*)lds;
    LAS float* Ks = Qs + 8 * 512;
    LAS float* Vs = Ks + 8 * 512;
    LAS float* HP = Vs + 8 * 128;
    LAS float* NQ = HP + 4 * 8 * 128;
    LAS float* GI = NQ + 64;
    LAS float* GF = GI + 8;
    LAS float* EM = GF + 8;
    const float kscale = 0.04419417382415922f;
    float C[128];
#pragma unroll
    for (int i = 0; i < 128; ++i) C[i] = 0.f;
    float nst = 0.f, mst = 0.f;
    for (int blk = 0; blk < SEQ / 8; ++blk) {
        const size_t tok0 = (size_t)b * SEQ + blk * 8;
        { int t2 = threadIdx.x; asm volatile("" : "+v"(t2));
          const int stt = t2 >> 6, sl = t2 & 63, nv = h * 128 + es * 32 + (sl >> 1), dv = 2 * (sl & 1);
          const size_t tok = tok0 + stt;
          int zoff = 0; asm volatile("" : "+v"(zoff));
          f32x4 wq0[4], wk0[4], wq1[4], wk1[4];
#pragma unroll
          for (int c = 0; c < 4; ++c) {
              wq0[c] = *(const f32x4*)(a.in(I_ML_WQ) + zoff + (((size_t)o_ * 512 + h * 128 + sl) * 4 + c) * 4); wk0[c] = *(const f32x4*)(a.in(I_ML_WK) + zoff + (((size_t)o_ * 512 + h * 128 + sl) * 4 + c) * 4);
              wq1[c] = *(const f32x4*)(a.in(I_ML_WQ) + zoff + (((size_t)o_ * 512 + h * 128 + sl + 64) * 4 + c) * 4); wk1[c] = *(const f32x4*)(a.in(I_ML_WK) + zoff + (((size_t)o_ * 512 + h * 128 + sl + 64) * 4 + c) * 4);
          }
          const u32x2 c0 = *(const u32x2*)(xc + tok * MI + h * 512 + 4 * sl), c1 = *(const u32x2*)(xc + tok * MI + h * 512 + 4 * (sl + 64));
          const f32x4 a0 = (f32x4){bflo(c0.x), bfhi(c0.x), bflo(c0.y), bfhi(c0.y)}, a1 = (f32x4){bflo(c1.x), bfhi(c1.x), bflo(c1.y), bfhi(c1.y)};
          *(LAS f32x4*)(Qs + stt * 512 + 4 * sl) = wq0[0] * a0.x + wq0[1] * a0.y + wq0[2] * a0.z + wq0[3] * a0.w;
          *(LAS f32x4*)(Ks + stt * 512 + 4 * sl) = (wk0[0] * a0.x + wk0[1] * a0.y + wk0[2] * a0.z + wk0[3] * a0.w) * kscale;
          *(LAS f32x4*)(Qs + stt * 512 + 4 * (sl + 64)) = wq1[0] * a1.x + wq1[1] * a1.y + wq1[2] * a1.z + wq1[3] * a1.w;
          *(LAS f32x4*)(Ks + stt * 512 + 4 * (sl + 64)) = (wk1[0] * a1.x + wk1[1] * a1.y + wk1[2] * a1.z + wk1[3] * a1.w) * kscale;
          f32x4 wvb[4];
#pragma unroll
          for (int c = 0; c < 4; ++c) wvb[c] = *(const f32x4*)(a.in(I_ML_WV) + zoff + (((size_t)o_ * 512 + nv) * 4 + c) * 4);
          const u32x2 xr = *(const u32x2*)(xm + tok * MI + 4 * nv);
          const f32x4 xv = (f32x4){bflo(xr.x), bfhi(xr.x), bflo(xr.y), bfhi(xr.y)};
          const f32x4 vv = wvb[0] * xv.x + wvb[1] * xv.y + wvb[2] * xv.z + wvb[3] * xv.w;
          Vs[stt * 128 + 2 * sl] = (dv == 0) ? vv.x : vv.z; Vs[stt * 128 + 2 * sl + 1] = (dv == 0) ? vv.y : vv.w;
          if (t2 < 8) { GI[t2] = gates[(tok0 + t2) * 8 + h]; GF[t2] = gates[(tok0 + t2) * 8 + 4 + h]; } }
        __syncthreads();
        int t3 = threadIdx.x; asm volatile("" : "+v"(t3));
        const int el = t3 & 127, dq = t3 >> 7;
#pragma unroll 1
        for (int t = 0; t < 8; ++t) {
            const float li = GI[t], lf = GF[t];
            const float mnew = fmaxf(lf + mst, li);
            const float fp = __expf(lf + mst - mnew), ip = __expf(li - mnew);
            mst = mnew;
            if (t3 == 0) EM[t] = __expf(-mnew);
            const float ipv = ip * Vs[t * 128 + el];
            float hp = 0.f;
#pragma unroll
            for (int d4 = 0; d4 < 32; ++d4) {
                if ((d4 & 7) == 0) __builtin_amdgcn_sched_barrier(0);
                const f32x4 kv = *(const LAS f32x4*)(Ks + t * 512 + dq * 128 + 4 * d4), qv = *(const LAS f32x4*)(Qs + t * 512 + dq * 128 + 4 * d4);
                C[4 * d4 + 0] = fmaf(fp, C[4 * d4 + 0], ipv * kv.x); hp = fmaf(C[4 * d4 + 0], qv.x, hp);
                C[4 * d4 + 1] = fmaf(fp, C[4 * d4 + 1], ipv * kv.y); hp = fmaf(C[4 * d4 + 1], qv.y, hp);
                C[4 * d4 + 2] = fmaf(fp, C[4 * d4 + 2], ipv * kv.z); hp = fmaf(C[4 * d4 + 2], qv.z, hp);
                C[4 * d4 + 3] = fmaf(fp, C[4 * d4 + 3], ipv * kv.w); hp = fmaf(C[4 * d4 + 3], qv.w, hp);
            }
            HP[(dq * 8 + t) * 128 + el] = hp;
            nst = fmaf(fp, nst, ip * Ks[t * 512 + t3]);
            const float nq = wave_sum(nst * Qs[t * 512 + t3]);
            if ((t3 & 63) == 0) NQ[(t3 >> 6) * 8 + t] = nq;
        }
        __syncthreads();
        { int t4 = threadIdx.x; asm volatile("" : "+v"(t4));
          const int ft = t4 >> 6, fe = (t4 & 63) * 2;
          float den = 0.f;
#pragma unroll
          for (int w = 0; w < 8; ++w) den += NQ[w * 8 + ft];
          const float dn = fmaxf(fabsf(den), EM[ft]);
          float h0 = HP[(0 * 8 + ft) * 128 + fe] + HP[(1 * 8 + ft) * 128 + fe] + HP[(2 * 8 + ft) * 128 + fe] + HP[(3 * 8 + ft) * 128 + fe];
          float h1 = HP[(0 * 8 + ft) * 128 + fe + 1] + HP[(1 * 8 + ft) * 128 + fe + 1] + HP[(2 * 8 + ft) * 128 + fe + 1] + HP[(3 * 8 + ft) * 128 + fe + 1];
          h0 /= dn; h1 /= dn;
          *(unsigned*)(xm + (tok0 + ft) * MI + h * 512 + es * 128 + fe) = pk2(h0, h1);
          const float ssq = wave_sum(h0 * h0 + h1 * h1);
          if ((t4 & 63) == 0) SS[(tok0 + ft) * 16 + h * 4 + es] = ssq; }
        __syncthreads();
    }
}

typedef short bf16x8v __attribute__((ext_vector_type(8)));
typedef short bf16x4v __attribute__((ext_vector_type(4)));
constexpr int ML_WQ = 0, ML_WK = 8192, ML_WV = 16384, ML_N = 18432, ML_QN = 22528, ML_RS = 22784, ML_NROW = 23808  , ML_GA = 25856, ML_GM = 26112, ML_GW = 26368, ML_GE = 26624, ML_RD = 26880, ML_QNL = 27136,
              ML_NP = 29184  , ML_WU = 33280  , ML_B0 = 35328;
constexpr int ML_QP = 272, ML_TP = 144, ML_BSTR = 2 * 64 * ML_QP + 128 * ML_TP, ML_VT = ML_B0 + 2 * ML_BSTR, ML_PS = ML_B0, ML_OT = ML_B0 + ML_BSTR, ML_END = ML_VT + 128 * ML_TP;
#define ML_QS_(b) (ML_B0 + (b) * ML_BSTR)
#define ML_KS_(b) (ML_B0 + (b) * ML_BSTR + 64 * ML_QP)
#define ML_KWT_(b) (ML_B0 + (b) * ML_BSTR + 2 * 64 * ML_QP)
static_assert(ML_END <= LDSCTL_OFF, "mLSTM LDS map");
__device__ __forceinline__ unsigned cvtpk(float lo, float hi) { return pg8::cvt_pk_bf16(lo, hi); }

typedef __bf16 bf16x2c __attribute__((ext_vector_type(2)));
__device__ __forceinline__ unsigned cvtpk_c(float lo, float hi) { const bf16x2c v = {(__bf16)lo, (__bf16)hi}; return __builtin_bit_cast(unsigned, v); }
__device__ __forceinline__ bf16x4v blockdiag_frag(const LAS float* T, int blk0, int l15, int g4) {
    const f32x4 w4 = *(const LAS f32x4*)(T + ((blk0 + g4) * 4 + (l15 & 3)) * 4);
    u32x2 p; p.x = cvtpk(w4[0], w4[1]); p.y = cvtpk(w4[2], w4[3]);
    if (g4 != (l15 >> 2)) { p.x = 0u; p.y = 0u; }
    return __builtin_bit_cast(bf16x4v, p);
}
template <int s>
__device__ __forceinline__ void ml_stage(LAS unsigned char* lds, const bf16* xc, size_t tokn, int h, int w, u32x2 (&pre)[4]) {
    int l15, g4; { int t_ = threadIdx.x; asm volatile("" : "+v"(t_)); l15 = t_ & 15; g4 = (t_ & 63) >> 4;
      if (t_ < 128) { const int q_ = (t_ & 31) >> 2; *(LAS unsigned short*)(lds + ML_NROW + (s & 1) * 256 + 2 * ((t_ & ~31) + (((q_ & 3) * 2 + (q_ >> 2)) << 2) + (t_ & 3))) = bf_rne(*(const LAS float*)(lds + ML_N + 4 * (128 * s + t_))); } }
    const bf16x4v wqf = blockdiag_frag((const LAS float*)(lds + ML_WQ), 32 * s + 4 * w, l15, g4), wkf = blockdiag_frag((const LAS float*)(lds + ML_WK), 32 * s + 4 * w, l15, g4);
    const f32x4 z4 = (f32x4){0.f, 0.f, 0.f, 0.f};
    const int pcol = (w >> 1) * 64 + (2 * g4 + (w & 1)) * 8;
#pragma unroll
    for (int mb = 0; mb < 4; ++mb) {
        const bf16x4v xf = __builtin_bit_cast(bf16x4v, pre[mb]);
        const f32x4 qT = __builtin_amdgcn_mfma_f32_16x16x16bf16_1k(wqf, xf, z4, 0, 0, 0);
        const f32x4 kT = __builtin_amdgcn_mfma_f32_16x16x16bf16_1k(wkf, xf, z4, 0, 0, 0);
        const f32x4 kR = __builtin_amdgcn_mfma_f32_16x16x16bf16_1k(xf, wkf, z4, 0, 0, 0);
        const f32x4 wu4 = *(const LAS f32x4*)(lds + ML_WU + 4 * (64 * w + 16 * mb + 4 * g4));
        *(LAS u32x2*)(lds + ML_QS_(s & 1) + (16 * mb + l15) * ML_QP + pcol) = (u32x2){cvtpk_c(qT[0], qT[1]), cvtpk_c(qT[2], qT[3])};
        *(LAS u32x2*)(lds + ML_KS_(s & 1) + (16 * mb + l15) * ML_QP + pcol) = (u32x2){cvtpk_c(kT[0], kT[1]), cvtpk_c(kT[2], kT[3])};
        *(LAS u32x2*)(lds + ML_KWT_(s & 1) + (16 * w + l15) * ML_TP + (16 * mb + 4 * g4) * 2) = (u32x2){cvtpk_c(kR[0] * wu4[0], kR[1] * wu4[1]), cvtpk_c(kR[2] * wu4[2], kR[3] * wu4[3])};
    }
#pragma unroll
    for (int mb = 0; mb < 4; ++mb) pre[mb] = *(const u32x2*)(xc + (tokn + 16 * mb + l15) * MI + h * 512 + 128 * ((s + 1) & 3) + 16 * w + 4 * g4);
}
template <int s>
__device__ __forceinline__ void ml_compute(LAS unsigned char* lds, int w, int ib, int jb0, float decay, f32x4 (&acc)[32], f32x4 (&sacc)[2], f32x4 (&hin)[4], const bf16x8v vtf0, const bf16x8v vtf1) {
    int l15, g4; { int t_ = threadIdx.x; asm volatile("" : "+v"(t_)); l15 = t_ & 15; g4 = (t_ & 63) >> 4; }
#define ML_WAIT() do { asm volatile("s_waitcnt lgkmcnt(0)" ::: "memory"); __builtin_amdgcn_sched_barrier(0); } while (0)
            bf16x8v ka[2][4];
            const LAS unsigned char* kwrow = lds + ML_KWT_(s & 1) + l15 * ML_TP + (8 * g4) * 2;
            { bf16x8v qf[4], kb[2];
              const bool lowq = (w <= 2), do0 = (w != 1) && (w != 7), isn = (w == 2) || (w == 3);
              const LAS unsigned char* qrow = lds + ML_QS_(s & 1) + l15 * ML_QP + (8 * g4) * 2;
              const LAS unsigned char* krow = isn ? lds + ML_NROW + (s & 1) * 256 + (8 * g4) * 2 : lds + ML_KS_(s & 1) + (16 * (w & 3) + l15) * ML_QP + (8 * g4) * 2;
#pragma unroll
              for (int i4 = 0; i4 < 4; ++i4) qf[i4] = *(const LAS bf16x8v*)(qrow + 16 * i4 * ML_QP);
              kb[0] = *(const LAS bf16x8v*)krow;
#pragma unroll
              for (int kk = 0; kk < 4; ++kk) {
                  __builtin_amdgcn_sched_barrier(0);
                  if (kk < 3) kb[(kk + 1) & 1] = *(const LAS bf16x8v*)(krow + 64 * (kk + 1));
                  const f32x4 c0 = acc[8 * s + 2 * kk], c1 = acc[8 * s + 2 * kk + 1];
                  u32x4 cbits; cbits.x = cvtpk(c0[0], c0[1]); cbits.y = cvtpk(c0[2], c0[3]); cbits.z = cvtpk(c1[0], c1[1]); cbits.w = cvtpk(c1[2], c1[3]);
                  const bf16x8v cb = __builtin_bit_cast(bf16x8v, cbits);
#pragma unroll
                  for (int i4 = 0; i4 < 4; ++i4) {
                      hin[i4] = __builtin_amdgcn_mfma_f32_16x16x32_bf16(cb, qf[i4], hin[i4], 0, 0, 0);
                      if (lowq == (i4 < 2)) { if ((i4 & 1) == 0) { if (do0) sacc[0] = __builtin_amdgcn_mfma_f32_16x16x32_bf16(qf[i4], kb[kk & 1], sacc[0], 0, 0, 0); }
                                              else sacc[1] = __builtin_amdgcn_mfma_f32_16x16x32_bf16(qf[i4], kb[kk & 1], sacc[1], 0, 0, 0); }
                      __builtin_amdgcn_sched_barrier(0);
                      if (kk < 3) qf[i4] = *(const LAS bf16x8v*)(qrow + 16 * i4 * ML_QP + 64 * (kk + 1));
                      if (kk == 3 && i4 == 0) { ka[0][0] = *(const LAS bf16x8v*)kwrow; ka[0][1] = *(const LAS bf16x8v*)(kwrow + 64); ka[0][2] = *(const LAS bf16x8v*)(kwrow + 16 * ML_TP); ka[0][3] = *(const LAS bf16x8v*)(kwrow + 16 * ML_TP + 64); }
                  }
              } }
            { const LAS unsigned char* krow = kwrow;
#pragma unroll
              for (int gq = 0; gq < 4; ++gq) {
                  ML_WAIT();
                  if (gq < 3) { const LAS unsigned char* kr2 = krow + 32 * (gq + 1) * ML_TP;
                      ka[(gq + 1) & 1][0] = *(const LAS bf16x8v*)kr2; ka[(gq + 1) & 1][1] = *(const LAS bf16x8v*)(kr2 + 64); ka[(gq + 1) & 1][2] = *(const LAS bf16x8v*)(kr2 + 16 * ML_TP); ka[(gq + 1) & 1][3] = *(const LAS bf16x8v*)(kr2 + 16 * ML_TP + 64); }
                  __builtin_amdgcn_sched_barrier(0);
                  f32x4 c0 = acc[8 * s + 2 * gq] * decay, c1 = acc[8 * s + 2 * gq + 1] * decay;
                  c0 = __builtin_amdgcn_mfma_f32_16x16x32_bf16(ka[gq & 1][0], vtf0, c0, 0, 0, 0);
                  c1 = __builtin_amdgcn_mfma_f32_16x16x32_bf16(ka[gq & 1][2], vtf0, c1, 0, 0, 0);
                  c0 = __builtin_amdgcn_mfma_f32_16x16x32_bf16(ka[gq & 1][1], vtf1, c0, 0, 0, 0);
                  c1 = __builtin_amdgcn_mfma_f32_16x16x32_bf16(ka[gq & 1][3], vtf1, c1, 0, 0, 0);
                  acc[8 * s + 2 * gq] = c0; acc[8 * s + 2 * gq + 1] = c1;
                  if (gq == (w >> 1)) {
                      const bf16x8v ones = __builtin_bit_cast(bf16x8v, (u32x4){0x3f803f80u, 0x3f803f80u, 0x3f803f80u, 0x3f803f80u});
                      f32x4 rsum = (f32x4){0.f, 0.f, 0.f, 0.f};
                      if (w & 1) { rsum = __builtin_amdgcn_mfma_f32_16x16x32_bf16(ka[gq & 1][2], ones, rsum, 0, 0, 0); rsum = __builtin_amdgcn_mfma_f32_16x16x32_bf16(ka[gq & 1][3], ones, rsum, 0, 0, 0); }
                      else       { rsum = __builtin_amdgcn_mfma_f32_16x16x32_bf16(ka[gq & 1][0], ones, rsum, 0, 0, 0); rsum = __builtin_amdgcn_mfma_f32_16x16x32_bf16(ka[gq & 1][1], ones, rsum, 0, 0, 0); }
                      if (l15 == 0) { LAS f32x4* np_ = (LAS f32x4*)(lds + ML_N + 4 * (128 * s + 16 * w + 4 * g4)); *np_ = *np_ * decay + rsum; } }
              } }
}
__device__ __forceinline__ void ml_nupdate(LAS unsigned char* lds, int s, float decay) {
    int tid = threadIdx.x; asm volatile("" : "+v"(tid));
    LAS float* NST = (LAS float*)(lds + ML_N); LAS float* NP = (LAS float*)(lds + ML_NP) + (s & 1) * 512;
    if (tid < 128) NST[128 * s + tid] = decay * NST[128 * s + tid] + ((NP[tid] + NP[128 + tid]) + (NP[256 + tid] + NP[384 + tid]));
}
__device__ __forceinline__ void mlstm_unit_mfma(const Ctx& a, int o_, bf16* xm, const bf16* xc, const float* gates, float* SS, LAS unsigned char* lds, int unit, bool store_out) {
    int tid = threadIdx.x; asm volatile("" : "+v"(tid));
    const int w = __builtin_amdgcn_readfirstlane(tid >> 6);
    const int es = unit & 3, h = (unit >> 2) & 3, b = unit >> 4;
    LAS float* WQ = (LAS float*)(lds + ML_WQ); LAS float* WK = (LAS float*)(lds + ML_WK); LAS float* WV = (LAS float*)(lds + ML_WV);
    LAS float* NST = (LAS float*)(lds + ML_N); LAS float* RS = (LAS float*)(lds + ML_RS);
    { const float* wq = a.in(I_ML_WQ) + ((size_t)o_ * 512 + h * 128) * 16; const float* wk = a.in(I_ML_WK) + ((size_t)o_ * 512 + h * 128) * 16; const float* wv = a.in(I_ML_WV) + ((size_t)o_ * 512 + h * 128 + es * 32) * 16;
      for (int i = tid; i < 2048; i += NTHREADS) { const int ti = (i & ~15) | ((i & 3) << 2) | ((i >> 2) & 3);
          WQ[ti] = wq[i]; WK[ti] = wk[i] * 0.04419417382415922f; }
      NST[tid] = 0.f; WV[(tid & ~15) | ((tid & 3) << 2) | ((tid >> 2) & 3)] = wv[tid]; }
    f32x4 acc[32];
#pragma unroll
    for (int i = 0; i < 32; ++i) acc[i] = (f32x4){0.f, 0.f, 0.f, 0.f};
    float mst = 0.f;
    const int ib = 2 * (w >> 2), jb0 = w & 3;
    u32x2 pre[4], vpre[4]; float gli, glf;
    { const int l0 = tid & 63, f15 = tid & 15, fg4 = l0 >> 4; const size_t t0 = (size_t)b * SEQ + l0, tb = (size_t)b * SEQ;
#pragma unroll
      for (int mb = 0; mb < 4; ++mb) { pre[mb] = *(const u32x2*)(xc + (tb + 16 * mb + f15) * MI + h * 512 + 16 * w + 4 * fg4); vpre[mb] = *(const u32x2*)(xm + (tb + 16 * mb + f15) * MI + h * 512 + es * 128 + 16 * w + 4 * fg4); }
      gli = gates[t0 * 8 + h]; glf = gates[t0 * 8 + 4 + h]; }
    __syncthreads();
    for (int ch = 0; ch < SEQ / 64; ++ch) {
        const size_t tok0 = (size_t)b * SEQ + ch * 64;
        int tid = threadIdx.x; asm volatile("" : "+v"(tid));
        const int lane = tid & 63, l15 = lane & 15, g4 = lane >> 4;
        float decay, flast, M63;
        { const float li = gli, lf = glf;
          { const size_t tn = (ch + 1 < SEQ / 64) ? tok0 + 64 + lane : tok0 + lane; gli = gates[tn * 8 + h]; glf = gates[tn * 8 + 4 + h]; }
          const float fc = wave_scan_sum(lf, lane), av = li - fc, Mv = fmaxf(mst, wave_scan_max(av, lane));
          M63 = __uint_as_float(__builtin_amdgcn_readlane(__float_as_uint(Mv), 63)); flast = __uint_as_float(__builtin_amdgcn_readlane(__float_as_uint(fc), 63));
          decay = __expf(mst - M63);
          *(LAS float*)(lds + ML_WU + 4 * (64 * w + lane)) = __expf(av - M63);
          if (w == 0) { *(LAS float*)(lds + ML_GA + 4 * lane) = av; *(LAS float*)(lds + ML_GM + 4 * lane) = Mv; *(LAS float*)(lds + ML_GW + 4 * lane) = __expf(mst - Mv); *(LAS float*)(lds + ML_GE + 4 * lane) = __expf(-(fc + Mv)); } }
        LDS_WAIT(); asm volatile("" ::: "memory");
        { const bf16x4v wvf = blockdiag_frag((const LAS float*)(lds + ML_WV), 4 * w, l15, g4);
#pragma unroll
          for (int mb = 0; mb < 4; ++mb) {
              const f32x4 vR = __builtin_amdgcn_mfma_f32_16x16x16bf16_1k(__builtin_bit_cast(bf16x4v, vpre[mb]), wvf, (f32x4){0.f, 0.f, 0.f, 0.f}, 0, 0, 0);
              *(LAS u32x2*)(lds + ML_VT + (16 * w + l15) * ML_TP + (16 * mb + 4 * g4) * 2) = (u32x2){cvtpk_c(vR[0], vR[1]), cvtpk_c(vR[2], vR[3])}; } }
        const size_t tokn = (ch + 1 < SEQ / 64) ? tok0 + 64 : tok0;
        f32x4 sacc[2] = {(f32x4){0.f, 0.f, 0.f, 0.f}, (f32x4){0.f, 0.f, 0.f, 0.f}};
        f32x4 hin[4] = {(f32x4){0.f, 0.f, 0.f, 0.f}, (f32x4){0.f, 0.f, 0.f, 0.f}, (f32x4){0.f, 0.f, 0.f, 0.f}, (f32x4){0.f, 0.f, 0.f, 0.f}};
        ml_stage<0>(lds, xc, tok0, h, w, pre);
        __syncthreads();
        const bf16x8v vtf0 = *(const LAS bf16x8v*)(lds + ML_VT + (16 * w + l15) * ML_TP + (8 * g4) * 2), vtf1 = *(const LAS bf16x8v*)(lds + ML_VT + (16 * w + l15) * ML_TP + (32 + 8 * g4) * 2);
        ml_compute<0>(lds, w, ib, jb0, decay, acc, sacc, hin, vtf0, vtf1);
        ml_stage<1>(lds, xc, tok0, h, w, pre);
        __syncthreads();
        ml_compute<1>(lds, w, ib, jb0, decay, acc, sacc, hin, vtf0, vtf1);
        ml_stage<2>(lds, xc, tok0, h, w, pre);
        __syncthreads();
        ml_compute<2>(lds, w, ib, jb0, decay, acc, sacc, hin, vtf0, vtf1);
        ml_stage<3>(lds, xc, tokn, h, w, pre);
        __syncthreads();
        ml_compute<3>(lds, w, ib, jb0, decay, acc, sacc, hin, vtf0, vtf1);
#pragma unroll
        for (int mb = 0; mb < 4; ++mb) vpre[mb] = *(const u32x2*)(xm + (tokn + 16 * mb + l15) * MI + h * 512 + es * 128 + 16 * w + 4 * g4);
#pragma unroll
        for (int jj = 0; jj < 2; ++jj) {
            const int ibj = ib + jj, jb = jb0, jcol = 16 * jb + l15;
            const float aj = *(const LAS float*)(lds + ML_GA + 4 * jcol);
            float p[4];
#pragma unroll
            for (int r = 0; r < 4; ++r) { const int irow = 16 * ibj + 4 * g4 + r; const float Mi = *(const LAS float*)(lds + ML_GM + 4 * irow);
                p[r] = (jb <= ibj && jcol <= irow) ? sacc[jj][r] * __expf(aj - Mi) : 0.f;
                *(LAS unsigned short*)(lds + ML_PS + irow * ML_TP + jcol * 2) = bf_rne(p[r]);
                const float rs = row16_sum(p[r]);
                if (l15 == 0) RS[jb * 64 + irow] = rs; }
        }
        if ((w == 2 || w == 3) && l15 == 0) { const int r0 = 32 * (w - 2) + 4 * g4; *(LAS f32x4*)(lds + ML_QN + 4 * r0) = sacc[0]; *(LAS f32x4*)(lds + ML_QN + 4 * (r0 + 16)) = sacc[1]; }
        __syncthreads();
        { const float qn = *(const LAS float*)(lds + ML_QN + 4 * lane);
          const float den = ((RS[lane] + RS[64 + lane]) + (RS[128 + lane] + RS[192 + lane])) + *(const LAS float*)(lds + ML_GW + 4 * lane) * qn;
          *(LAS float*)(lds + ML_RD + 4 * lane) = 1.0f / fmaxf(fabsf(den), *(const LAS float*)(lds + ML_GE + 4 * lane));
          { bf16x8v pa[2][2];
            const LAS unsigned char* prow = lds + ML_PS + l15 * ML_TP + (8 * g4) * 2;
            pa[0][0] = *(const LAS bf16x8v*)prow; pa[0][1] = *(const LAS bf16x8v*)(prow + 64);
#pragma unroll
            for (int i4 = 0; i4 < 4; ++i4) {
              ML_WAIT();
              if (i4 < 3) { pa[(i4 + 1) & 1][0] = *(const LAS bf16x8v*)(prow + 16 * (i4 + 1) * ML_TP); pa[(i4 + 1) & 1][1] = *(const LAS bf16x8v*)(prow + 16 * (i4 + 1) * ML_TP + 64); }
              const float wi = *(const LAS float*)(lds + ML_GW + 4 * (16 * i4 + l15)), rd = *(const LAS float*)(lds + ML_RD + 4 * (16 * i4 + l15));
              __builtin_amdgcn_sched_barrier(0);
              f32x4 hx = (f32x4){0.f, 0.f, 0.f, 0.f};
              hx = __builtin_amdgcn_mfma_f32_16x16x32_bf16(vtf0, pa[i4 & 1][0], hx, 0, 0, 0);
              hx = __builtin_amdgcn_mfma_f32_16x16x32_bf16(vtf1, pa[i4 & 1][1], hx, 0, 0, 0);
              const f32x4 hv = (hx + hin[i4] * wi) * rd;
              u32x2 o; o.x = cvtpk_c(hv[0], hv[1]); o.y = cvtpk_c(hv[2], hv[3]);
              if (store_out) *(u32x2*)(xm + (tok0 + 16 * i4 + l15) * MI + h * 512 + es * 128 + 16 * w + 4 * g4) = o;
              const float e0 = bflo(o.x), e1 = bfhi(o.x), e2 = bflo(o.y), e3 = bfhi(o.y);
              float sq = (e0 * e0 + e1 * e1) + (e2 * e2 + e3 * e3);
              sq += __shfl_xor(sq, 16); sq += __shfl_xor(sq, 32);
              if (g4 == 0) *(LAS float*)(lds + ML_NP + 4 * (w * 64 + 16 * i4 + l15)) = sq;
            } } }
        mst = flast + M63;
        __syncthreads();
        if (w == 0 && store_out) { const LAS float* sq = (const LAS float*)(lds + ML_NP) + lane; float sum = 0.f;
#pragma unroll
            for (int ww = 0; ww < 8; ++ww) sum += sq[64 * ww];
            SS[(tok0 + lane) * 16 + h * 4 + es] = sum; }
    }
}

constexpr int GL_WUP = 0, GL_DEC = 4096, GL_SSQ = 4352, GL_RSTD = 6400, GL_QD = 8192, GL_QP = 144, GL_KD = GL_QD + 64 * GL_QP, GL_KUT = GL_KD + 64 * GL_QP, GL_VT = GL_KUT + 64 * GL_QP, GL_PS = GL_VT + 128 * GL_QP,
              GL_OT = GL_PS + 64 * GL_QP, GL_OP = 528, GL_END = GL_OT + 64 * GL_OP;
static_assert(GL_END <= RING_BYTES, "GLA LDS map");
__device__ __forceinline__ void gla_unit_mfma(const Ctx& a, int e_, const bf16* pbuf, bf16* yb2, LAS unsigned char* lds, int unit) {
    int tid0 = threadIdx.x; asm volatile("" : "+v"(tid0));
    const int w = __builtin_amdgcn_readfirstlane(tid0 >> 6);
    const int b = unit >> 2, h = unit & 3;
    LAS float* WUP = (LAS float*)(lds + GL_WUP);
    { const float* wup = a.in(I_GLA_WUP) + (size_t)e_ * 16 * 256; for (int idx = tid0; idx < 1024; idx += NTHREADS) { const int j = idx >> 6, d = idx & 63; WUP[d * 16 + j] = wup[j * 256 + h * 64 + d]; } }
    f32x4 acc[4];
#pragma unroll
    for (int i = 0; i < 4; ++i) acc[i] = (f32x4){0.f, 0.f, 0.f, 0.f};
    const int ib = w >> 1, jb0 = 2 * (w & 1);
    float balpha[8];
    { const float* bp = a.in(I_GLA_BALPHA) + e_ * 256 + h * 64 + 8 * w;
#pragma unroll
      for (int c = 0; c < 8; ++c) balpha[c] = bp[c]; }
    f32x4 gnv[4];
    { const float* gnp = a.in(I_GLA_NORM) + e_ * 512 + h * 128 + 16 * (tid0 & 7);
#pragma unroll
      for (int c4 = 0; c4 < 4; ++c4) gnv[c4] = *(const f32x4*)(gnp + 4 * c4); }
    u32x4 nqr, nkr, na0, na1, nv0, nv1;
    { const bf16* row = pbuf + ((size_t)b * SEQ + (tid0 & 63)) * EPAD;
      nqr = *(const u32x4*)(row + PC_Q + h * 64 + 8 * w); nkr = *(const u32x4*)(row + PC_K + h * 64 + 8 * w); na0 = *(const u32x4*)(row + PC_A); na1 = *(const u32x4*)(row + PC_A + 8);
      nv0 = *(const u32x4*)(row + PC_V + h * 128 + 16 * w); nv1 = *(const u32x4*)(row + PC_V + h * 128 + 16 * w + 8); }
    __syncthreads();
    for (int ch = 0; ch < SEQ / 64; ++ch) {
        const size_t tok0 = (size_t)b * SEQ + ch * 64;
        int tid = threadIdx.x; asm volatile("" : "+v"(tid));
        const int lane = tid & 63, l15 = lane & 15, g4 = lane >> 4;
        u32x4 rg0, rg1;
        { const bf16* rrow = pbuf + (tok0 + (tid >> 3)) * EPAD + PC_R + h * 128 + 16 * (tid & 7); rg0 = *(const u32x4*)rrow; rg1 = *(const u32x4*)(rrow + 8); }
        { const u32x4 qr = nqr, kr = nkr, a0 = na0, a1 = na1, v0 = nv0, v1 = nv1;
          { const bf16* row = pbuf + (((ch + 1 < SEQ / 64) ? tok0 + 64 : tok0) + lane) * EPAD;
            nqr = *(const u32x4*)(row + PC_Q + h * 64 + 8 * w); nkr = *(const u32x4*)(row + PC_K + h * 64 + 8 * w); na0 = *(const u32x4*)(row + PC_A); na1 = *(const u32x4*)(row + PC_A + 8);
            nv0 = *(const u32x4*)(row + PC_V + h * 128 + 16 * w); nv1 = *(const u32x4*)(row + PC_V + h * 128 + 16 * w + 8); }
          float al[16]; al[0] = bflo(a0.x); al[1] = bfhi(a0.x); al[2] = bflo(a0.y); al[3] = bfhi(a0.y); al[4] = bflo(a0.z); al[5] = bfhi(a0.z); al[6] = bflo(a0.w); al[7] = bfhi(a0.w);
          al[8] = bflo(a1.x); al[9] = bfhi(a1.x); al[10] = bflo(a1.y); al[11] = bfhi(a1.y); al[12] = bflo(a1.z); al[13] = bfhi(a1.z); al[14] = bflo(a1.w); al[15] = bfhi(a1.w);
          const float qf[8] = {bflo(qr.x), bfhi(qr.x), bflo(qr.y), bfhi(qr.y), bflo(qr.z), bfhi(qr.z), bflo(qr.w), bfhi(qr.w)};
          const float kf[8] = {bflo(kr.x), bfhi(kr.x), bflo(kr.y), bfhi(kr.y), bflo(kr.z), bfhi(kr.z), bflo(kr.w), bfhi(kr.w)};
          unsigned qd[4], kd[4];
          float qprev = 0.f, kprev = 0.f;
#pragma unroll
          for (int c = 0; c < 8; ++c) {
              const int d = 8 * w + c;
              float z = balpha[c];
#pragma unroll
              for (int j4 = 0; j4 < 4; ++j4) { const f32x4 wv = *(const LAS f32x4*)(WUP + d * 16 + 4 * j4); z = fmaf(al[4 * j4], wv[0], z); z = fmaf(al[4 * j4 + 1], wv[1], z); z = fmaf(al[4 * j4 + 2], wv[2], z); z = fmaf(al[4 * j4 + 3], wv[3], z); }
              const float la = logsigm_fast(z) * (1.0f / 16.0f);
              const float gi = wave_scan_sum(la, lane);
              const float gl = __uint_as_float(__builtin_amdgcn_readlane(__float_as_uint(gi), 63));
              const float qv = qf[c] * __expf(gi) * 0.125f, kv = kf[c] * __expf(-gi), ku = kf[c] * __expf(gl - gi);
              *(LAS unsigned short*)(lds + GL_KUT + d * GL_QP + lane * 2) = bf_rne(ku);
              if (lane == 0) *(LAS float*)(lds + GL_DEC + 4 * d) = __expf(gl);
              if (c & 1) { qd[c >> 1] = cvtpk(qprev, qv); kd[c >> 1] = cvtpk(kprev, kv); } else { qprev = qv; kprev = kv; }
          }
          *(LAS u32x4*)(lds + GL_QD + lane * GL_QP + 16 * w) = (u32x4){qd[0], qd[1], qd[2], qd[3]};
          *(LAS u32x4*)(lds + GL_KD + lane * GL_QP + 16 * w) = (u32x4){kd[0], kd[1], kd[2], kd[3]};
          const unsigned vr[8] = {v0.x, v0.y, v0.z, v0.w, v1.x, v1.y, v1.z, v1.w};
#pragma unroll
          for (int c = 0; c < 8; ++c) { *(LAS unsigned short*)(lds + GL_VT + (16 * w + 2 * c) * GL_QP + lane * 2) = (unsigned short)(vr[c] & 0xffffu); *(LAS unsigned short*)(lds + GL_VT + (16 * w + 2 * c + 1) * GL_QP + lane * 2) = (unsigned short)(vr[c] >> 16); } }
        __syncthreads();
        const bf16x8v vtf0 = *(const LAS bf16x8v*)(lds + GL_VT + (16 * w + l15) * GL_QP + (8 * g4) * 2), vtf1 = *(const LAS bf16x8v*)(lds + GL_VT + (16 * w + l15) * GL_QP + (32 + 8 * g4) * 2);
        f32x4 sacc[2] = {(f32x4){0.f, 0.f, 0.f, 0.f}, (f32x4){0.f, 0.f, 0.f, 0.f}};
#pragma unroll
        for (int kk = 0; kk < 2; ++kk) {
            const bf16x8v qa = *(const LAS bf16x8v*)(lds + GL_QD + (16 * ib + l15) * GL_QP + (32 * kk + 8 * g4) * 2);
#pragma unroll
            for (int jj = 0; jj < 2; ++jj) if (jb0 + jj <= ib) {
                const bf16x8v kb = *(const LAS bf16x8v*)(lds + GL_KD + (16 * (jb0 + jj) + l15) * GL_QP + (32 * kk + 8 * g4) * 2);
                sacc[jj] = __builtin_amdgcn_mfma_f32_16x16x32_bf16(qa, kb, sacc[jj], 0, 0, 0); }
        }
        f32x4 hin[4] = {(f32x4){0.f, 0.f, 0.f, 0.f}, (f32x4){0.f, 0.f, 0.f, 0.f}, (f32x4){0.f, 0.f, 0.f, 0.f}, (f32x4){0.f, 0.f, 0.f, 0.f}};
#pragma unroll
        for (int kk = 0; kk < 2; ++kk) {
            const f32x4 c0 = acc[2 * kk], c1 = acc[2 * kk + 1];
            u32x4 cbits; cbits.x = cvtpk(c0[0], c0[1]); cbits.y = cvtpk(c0[2], c0[3]); cbits.z = cvtpk(c1[0], c1[1]); cbits.w = cvtpk(c1[2], c1[3]);
            const bf16x8v cb = __builtin_bit_cast(bf16x8v, cbits);
#pragma unroll
            for (int i4 = 0; i4 < 4; ++i4) {
                const u32x2 qlo = *(const LAS u32x2*)(lds + GL_QD + (16 * i4 + l15) * GL_QP + (32 * kk + 4 * g4) * 2), qhi = *(const LAS u32x2*)(lds + GL_QD + (16 * i4 + l15) * GL_QP + (32 * kk + 16 + 4 * g4) * 2);
                const bf16x8v qa = __builtin_bit_cast(bf16x8v, (u32x4){qlo.x, qlo.y, qhi.x, qhi.y});
                hin[i4] = __builtin_amdgcn_mfma_f32_16x16x32_bf16(qa, cb, hin[i4], 0, 0, 0); }
        }
#pragma unroll
        for (int db = 0; db < 4; ++db) {
            const f32x4 dec = *(const LAS f32x4*)(lds + GL_DEC + 4 * (16 * db + 4 * g4));
            f32x4 c = acc[db] * dec;
            const bf16x8v ka0 = *(const LAS bf16x8v*)(lds + GL_KUT + (16 * db + l15) * GL_QP + (8 * g4) * 2), ka1 = *(const LAS bf16x8v*)(lds + GL_KUT + (16 * db + l15) * GL_QP + (32 + 8 * g4) * 2);
            c = __builtin_amdgcn_mfma_f32_16x16x32_bf16(ka0, vtf0, c, 0, 0, 0);
            c = __builtin_amdgcn_mfma_f32_16x16x32_bf16(ka1, vtf1, c, 0, 0, 0);
            acc[db] = c; }
#pragma unroll
        for (int jj = 0; jj < 2; ++jj) {
            const int jb = jb0 + jj, jcol = 16 * jb + l15;
#pragma unroll
            for (int r = 0; r < 4; ++r) { const int irow = 16 * ib + 4 * g4 + r;
                const float p = (jb <= ib && jcol <= irow) ? sacc[jj][r] : 0.f;
                *(LAS unsigned short*)(lds + GL_PS + irow * GL_QP + jcol * 2) = bf_rne(p); }
        }
        __syncthreads();
#pragma unroll
        for (int i4 = 0; i4 < 4; ++i4) {
            const bf16x8v pa0 = *(const LAS bf16x8v*)(lds + GL_PS + (16 * i4 + l15) * GL_QP + (8 * g4) * 2), pa1 = *(const LAS bf16x8v*)(lds + GL_PS + (16 * i4 + l15) * GL_QP + (32 + 8 * g4) * 2);
            f32x4 hx = hin[i4];
            hx = __builtin_amdgcn_mfma_f32_16x16x32_bf16(pa0, vtf0, hx, 0, 0, 0);
            hx = __builtin_amdgcn_mfma_f32_16x16x32_bf16(pa1, vtf1, hx, 0, 0, 0);
#pragma unroll
            for (int r = 0; r < 4; ++r) { const int irow = 16 * i4 + 4 * g4 + r;
                *(LAS float*)(lds + GL_OT + irow * GL_OP + (16 * w + l15) * 4) = hx[r];
                const float sq = row16_sum(hx[r] * hx[r]);
                if (l15 == 0) *(LAS float*)(lds + GL_SSQ + 4 * (w * 64 + irow)) = sq; }
        }
        __syncthreads();
        { const int orow = tid >> 3, op = tid & 7;
          float ss = 0.f;
#pragma unroll
          for (int ww = 0; ww < 8; ++ww) ss += *(const LAS float*)(lds + GL_SSQ + 4 * (ww * 64 + orow));
          const float rstd = rsqrtf(ss * (1.0f / 128.0f) + EPS);
          const u32x4 r0 = rg0, r1 = rg1;
          const unsigned rr[8] = {r0.x, r0.y, r0.z, r0.w, r1.x, r1.y, r1.z, r1.w};
          unsigned ow[8];
#pragma unroll
          for (int c4 = 0; c4 < 4; ++c4) {
              const f32x4 o = *(const LAS f32x4*)(lds + GL_OT + orow * GL_OP + (16 * op + 4 * c4) * 4); const f32x4 gn = gnv[c4];
              const float r_0 = bflo(rr[2 * c4]), r_1 = bfhi(rr[2 * c4]), r_2 = bflo(rr[2 * c4 + 1]), r_3 = bfhi(rr[2 * c4 + 1]);
              ow[2 * c4] = cvtpk(o.x * rstd * gn.x * r_0 * sigm(r_0), o.y * rstd * gn.y * r_1 * sigm(r_1));
              ow[2 * c4 + 1] = cvtpk(o.z * rstd * gn.z * r_2 * sigm(r_2), o.w * rstd * gn.w * r_3 * sigm(r_3)); }
          bf16* outp = yb2 + (tok0 + orow) * D + 512 + h * 128 + 16 * op;
          *(u32x4*)outp = (u32x4){ow[0], ow[1], ow[2], ow[3]}; *(u32x4*)(outp + 8) = (u32x4){ow[4], ow[5], ow[6], ow[7]}; }
        __syncthreads();
    }
}

typedef float f32x16 __attribute__((ext_vector_type(16)));
constexpr int S5_XP = 272;
__device__ __forceinline__ void cmul_acc(float& orr, float& oi, float ar, float ai, float br, float bi) { orr = fmaf(ar, br, fmaf(-ai, bi, orr)); oi = fmaf(ar, bi, fmaf(ai, br, oi)); }
__device__ __forceinline__ void s5_unit_mfma(const Ctx& a, int e, bf16* pbuf, bf16* yout, int ypitch, LAS unsigned char* lds, int wgS) {
    int tid = threadIdx.x; asm volatile("" : "+v"(tid));
    const int lane = tid & 63, wave = __builtin_amdgcn_readfirstlane(tid >> 6), l31 = lane & 31, hh = lane >> 5, l15 = lane & 15, g4 = lane >> 4;
    const int g = wgS & 31, b = (wgS >> 5) * 8 + wave, eg = e * S5G + g;
    LAS unsigned char* X = lds + wave * (32 * S5_XP);
    const float dt = expf(a.in(I_S5_LOGDT)[eg]);
    float Lr[2][4], Li[2][4];
    bf16x8v bfr[4];
#pragma unroll
    for (int sset = 0; sset < 2; ++sset) {
        const int p = l31 + 32 * sset;
        const float lr = a.in(I_S5_LRE)[eg * 64 + p], li = a.in(I_S5_LIM)[eg * 64 + p];
        const float mag = expf(lr * dt), lbr = mag * cosf(li * dt), lbi = mag * sinf(li * dt);
        const float inv = 1.0f / (lr * lr + li * li);
        const float zr = ((lbr - 1.0f) * lr + lbi * li) * inv, zi = (lbi * lr - (lbr - 1.0f) * li) * inv;
        Lr[sset][0] = lbr; Li[sset][0] = lbi;
#pragma unroll
        for (int k = 1; k < 4; ++k) { Lr[sset][k] = Lr[sset][k - 1] * lbr - Li[sset][k - 1] * lbi; Li[sset][k] = Lr[sset][k - 1] * lbi + Li[sset][k - 1] * lbr; }
        const float* bre = a.in(I_S5_BRE) + ((size_t)eg * 64 + p) * 16 + 8 * hh; const float* bim = a.in(I_S5_BIM) + ((size_t)eg * 64 + p) * 16 + 8 * hh;
        unsigned wr_[4], wi_[4];
#pragma unroll
        for (int j = 0; j < 4; ++j) { const float br0 = bre[2 * j], bi0 = bim[2 * j], br1 = bre[2 * j + 1], bi1 = bim[2 * j + 1];
            wr_[j] = cvtpk(zr * br0 - zi * bi0, zr * br1 - zi * bi1); wi_[j] = cvtpk(zr * bi0 + zi * br0, zr * bi1 + zi * br1); }
        bfr[sset] = __builtin_bit_cast(bf16x8v, (u32x4){wr_[0], wr_[1], wr_[2], wr_[3]}); bfr[2 + sset] = __builtin_bit_cast(bf16x8v, (u32x4){wi_[0], wi_[1], wi_[2], wi_[3]});
    }
    bf16x8v cfr[4];
    { const float* cre = a.in(I_S5_CRE) + ((size_t)eg * 16 + l15) * 64; const float* cim = a.in(I_S5_CIM) + ((size_t)eg * 16 + l15) * 64;
#pragma unroll
      for (int ks = 0; ks < 4; ++ks) { const int c0 = 32 * ks + 8 * g4; unsigned wv[4];
#pragma unroll
          for (int j = 0; j < 4; ++j) { const int c = c0 + 2 * j; const float v0 = (c < 64) ? cre[c] : -cim[c - 64], v1 = (c < 64) ? cre[c + 1] : -cim[c + 1 - 64]; wv[j] = cvtpk(v0, v1); }
          cfr[ks] = __builtin_bit_cast(bf16x8v, (u32x4){wv[0], wv[1], wv[2], wv[3]}); } }
    const float dsk = a.in(I_S5_D)[eg * 16 + l15];
    float cr[2] = {0.f, 0.f}, ci[2] = {0.f, 0.f};
    u32x4 unext = *(const u32x4*)(pbuf + ((size_t)b * SEQ + l31) * EPAD + PC_U + g * 16 + 8 * hh);
    for (int blk = 0; blk < SEQ / 32; ++blk) {
        const size_t tok0 = (size_t)b * SEQ + blk * 32;
        const bf16x8v ufr = __builtin_bit_cast(bf16x8v, unext);
        { const size_t tn = (blk + 1 < SEQ / 32) ? tok0 + 32 : tok0; unext = *(const u32x4*)(pbuf + (tn + l31) * EPAD + PC_U + g * 16 + 8 * hh); }
        const f32x16 z16 = {0.f, 0.f, 0.f, 0.f, 0.f, 0.f, 0.f, 0.f, 0.f, 0.f, 0.f, 0.f, 0.f, 0.f, 0.f, 0.f};
        bf16 ue[2][4];
#pragma unroll
        for (int mb = 0; mb < 2; ++mb)
#pragma unroll
            for (int r = 0; r < 4; ++r) ue[mb][r] = pbuf[(tok0 + 16 * mb + 4 * g4 + r) * EPAD + PC_U + g * 16 + l15];
#pragma unroll
        for (int sset = 0; sset < 2; ++sset) {
            f32x16 xr = __builtin_amdgcn_mfma_f32_32x32x16_bf16(ufr, bfr[sset], z16, 0, 0, 0);
            f32x16 xi = __builtin_amdgcn_mfma_f32_32x32x16_bf16(ufr, bfr[2 + sset], z16, 0, 0, 0);
#pragma unroll
            for (int q = 0; q < 4; ++q) {
#pragma unroll
                for (int r = 1; r < 4; ++r) { float vr_ = xr[4 * q + r], vi_ = xi[4 * q + r]; cmul_acc(vr_, vi_, Lr[sset][0], Li[sset][0], xr[4 * q + r - 1], xi[4 * q + r - 1]); xr[4 * q + r] = vr_; xi[4 * q + r] = vi_; }
                float tr = xr[4 * q + 3], ti = xi[4 * q + 3];
                cmul_acc(tr, ti, Lr[sset][3], Li[sset][3], cr[sset], ci[sset]);
                float ur, ui, dum;
                half_pair(tr, ur, dum); half_pair(ti, ui, dum);
                const float inr = hh ? ur : cr[sset], ini = hh ? ui : ci[sset];
#pragma unroll
                for (int r = 0; r < 4; ++r) { float vr_ = xr[4 * q + r], vi_ = xi[4 * q + r]; cmul_acc(vr_, vi_, Lr[sset][r], Li[sset][r], inr, ini); xr[4 * q + r] = vr_; xi[4 * q + r] = vi_; }
                half_pair(xr[4 * q + 3], dum, cr[sset]); half_pair(xi[4 * q + 3], dum, ci[sset]);
            }
#pragma unroll
            for (int r = 0; r < 16; ++r) { const int trow = (r & 3) + 8 * (r >> 2) + 4 * hh;
                *(LAS unsigned short*)(X + trow * S5_XP + (32 * sset + l31) * 2) = bf_rne(xr[r]);
                *(LAS unsigned short*)(X + trow * S5_XP + (64 + 32 * sset + l31) * 2) = bf_rne(xi[r]); }
        }
        LDS_WAIT(); asm volatile("" ::: "memory");
#pragma unroll
        for (int mb = 0; mb < 2; ++mb) {
            f32x4 y = (f32x4){0.f, 0.f, 0.f, 0.f};
#pragma unroll
            for (int ks = 0; ks < 4; ++ks) { const bf16x8v xa = *(const LAS bf16x8v*)(X + (16 * mb + l15) * S5_XP + (32 * ks + 8 * g4) * 2); y = __builtin_amdgcn_mfma_f32_16x16x32_bf16(xa, cfr[ks], y, 0, 0, 0); }
#pragma unroll
            for (int r = 0; r < 4; ++r) { bf16* yp = yout + (tok0 + 16 * mb + 4 * g4 + r) * ypitch + g * 16 + l15;
                const float yv = y[r] + dsk * bf1(ue[mb][r]);
                *yp = bf_rne(gelu_t(yv)); }
        }
        LDS_WAIT(); asm volatile("" ::: "memory");
    }
}

__device__ __forceinline__ void ffn_fixup(const bf16* HTG, const bf16* HTU, const bf16* HBG, const float* cw, const float* cb, bf16* act, int gtid, int gthreads) {
    constexpr int C8 = FF / 8, TOTAL = (NTOK / 64) * 2 * C8;
    for (int idx = gtid; idx < TOTAL; idx += gthreads) {
        const int c8 = idx % C8, lr = (idx / C8) & 1, blk = idx / (2 * C8), ch = 8 * c8;
        const bool inner = (blk & 31) != 0;
        const u32x4 z = (u32x4){0u, 0u, 0u, 0u};
        const u32x4 g = *(const u32x4*)(HTG + ((size_t)blk * 2 + lr) * FF + ch), uu = *(const u32x4*)(HTU + ((size_t)blk * 2 + lr) * FF + ch);
        u32x4 gm1, gm2;
        if (lr == 0) { gm1 = inner ? *(const u32x4*)(HBG + ((size_t)(blk - 1) * 2 + 1) * FF + ch) : z; gm2 = inner ? *(const u32x4*)(HBG + ((size_t)(blk - 1) * 2 + 0) * FF + ch) : z; }
        else         { gm1 = *(const u32x4*)(HTG + ((size_t)blk * 2 + 0) * FF + ch);                       gm2 = inner ? *(const u32x4*)(HBG + ((size_t)(blk - 1) * 2 + 1) * FF + ch) : z; }
        const unsigned gw[4] = {g.x, g.y, g.z, g.w}, uw[4] = {uu.x, uu.y, uu.z, uu.w}, g1w[4] = {gm1.x, gm1.y, gm1.z, gm1.w}, g2w[4] = {gm2.x, gm2.y, gm2.z, gm2.w};
        unsigned ow[4];
        const f32x4 bA = *(const f32x4*)(cb + ch), bB = *(const f32x4*)(cb + ch + 4), w0A = *(const f32x4*)(cw + ch), w0B = *(const f32x4*)(cw + ch + 4),
                    w1A = *(const f32x4*)(cw + FF + ch), w1B = *(const f32x4*)(cw + FF + ch + 4), w2A = *(const f32x4*)(cw + 2 * FF + ch), w2B = *(const f32x4*)(cw + 2 * FF + ch + 4);
        const float bbv[8] = {bA[0], bA[1], bA[2], bA[3], bB[0], bB[1], bB[2], bB[3]}, w0v[8] = {w0A[0], w0A[1], w0A[2], w0A[3], w0B[0], w0B[1], w0B[2], w0B[3]},
                    w1v[8] = {w1A[0], w1A[1], w1A[2], w1A[3], w1B[0], w1B[1], w1B[2], w1B[3]}, w2v[8] = {w2A[0], w2A[1], w2A[2], w2A[3], w2B[0], w2B[1], w2B[2], w2B[3]};
#pragma unroll
        for (int p = 0; p < 4; ++p) {
            const float cv0 = bbv[2 * p] + w0v[2 * p] * bflo(g2w[p]) + w1v[2 * p] * bflo(g1w[p]) + w2v[2 * p] * bflo(gw[p]);
            const float cv1 = bbv[2 * p + 1] + w0v[2 * p + 1] * bfhi(g2w[p]) + w1v[2 * p + 1] * bfhi(g1w[p]) + w2v[2 * p + 1] * bfhi(gw[p]);
            ow[p] = pk2(gelu_t(cv0) * bflo(uw[p]), gelu_t(cv1) * bfhi(uw[p])); }
        *(u32x4*)(act + ((size_t)blk * 64 + lr) * FF + ch) = (u32x4){ow[0], ow[1], ow[2], ow[3]};
    }
}

#ifndef WGM_UP
#define WGM_UP 4
#endif
#ifndef SITE_MASK
#define SITE_MASK 0xffff
#endif
#ifndef PROBE_DUP
#define PROBE_DUP 0
#endif
#ifndef PROBE_EXTRA
#define PROBE_EXTRA 0
#endif
#define SITE(n) for (int rep_ = 0, nrep_ = opaque_int((((PROBE_DUP) >> (n)) & 1) ? 2 : 1); rep_ < nrep_; ++rep_) if constexpr ((((SITE_MASK) >> (n)) & 1) != 0)
__global__ void __launch_bounds__(NTHREADS, 2) fwd(Args args) {
    extern __shared__ __attribute__((aligned(16))) unsigned char lds_raw[];
    LAS unsigned char* lds = (LAS unsigned char*)lds_raw;
    volatile LAS unsigned* MISC = (volatile LAS unsigned*)(lds + MISC_OFF);
    const int G = gridDim.x, bx = blockIdx.x;
    const int vcu = (G % 8 == 0) ? (bx % 8) * (G / 8) + bx / 8 : bx;
    const int NGW = G * NWAVES;
#define FRESH_IDS int tid = threadIdx.x; asm volatile("" : "+v"(tid)); const int lane = tid & 63, wave = __builtin_amdgcn_readfirstlane(tid >> 6), gw = vcu * NWAVES + wave; (void)lane; (void)gw;
    unsigned char* ws = args.ws;
    unsigned* ctl = (unsigned*)(ws + WS_CTL);
    if (threadIdx.x < 256) ((LAS unsigned*)(lds + LDSCTL_OFF))[threadIdx.x] = 0u;
    if (threadIdx.x < 35) ((LAS unsigned long long*)(lds + PTAB_OFF))[threadIdx.x] = (unsigned long long)args.in[threadIdx.x];
    __syncthreads();
    Ctx a; a.tab = (const LAS unsigned long long*)(lds + PTAB_OFF); a.ws = ws;
    XcdBarrier bar; bar.bar = ctl + CW_BAR; bar.x = 0; bar.st = nullptr;
    const bool multi = (args.ph_hi - args.ph_lo) > 1;
    if (multi) bar = xcd_barrier_post(ctl + CW_BAR, MISC + 8);
    const int lo = args.ph_lo, hi = args.ph_hi;
#define IN(k) (lo <= (k) && (k) < hi)
#define SEAM(k) do { if (IN((k) + 1)) xcd_barrier(bar); } while (0)
#define SEAM2(k) do { if (IN((k) + 2)) xcd_barrier(bar); } while (0)

    unsigned long long* slotx = (unsigned long long*)(ws + WS_SLOT); float* rsx = (float*)(ws + WS_HA);
    float* xres = args.out; bf16* xs = (bf16*)(ws + WS_XS);

    if (IN(0)) { FRESH_IDS
        for (int rep = 0, nrep = opaque_int((PROBE_EXTRA & 32) ? 2 : 1); rep < nrep; ++rep) {
        for (int i = vcu * NTHREADS + tid; i < NTOK * 2; i += G * NTHREADS) ((u32x4*)slotx)[i] = (u32x4){0u, 0u, 0u, 0u};
        prepass_frag_table(a, vcu * NTHREADS + tid, G * NTHREADS);
        prologue_weights(a, lds, gw, NGW, wave, lane);
        norm_phase<0, 1>(nullptr, nullptr, a.in(I_X), xs, rsx, gw, NGW, lane); }
        SEAM(0);
    }
    const int G0 = G, bx0 = bx, vcu0 = vcu;
    for (int L = 0; L < DEPTH; ++L) {
        const int pb = 1 + 10 * L, e = L >> 1;
        int G = G0, bx = bx0, vcu = vcu0; asm volatile("" : "+s"(G), "+s"(bx), "+s"(vcu));
        const int NGW = G * NWAVES;
        if ((L & 1) == 0) {
            bf16* pbuf = (bf16*)(ws + WS_PBUF); bf16* yb2 = (bf16*)(ws + WS_YB2);
            if (IN(pb + 0)) {
                pg8::Gemm g{xs, (const bf16*)(ws + WS_W_EVIN + e * SZ_W_EVIN), NTOK, EPAD, D, D, D}; pg8::StaticOrder S; S.init(NTOK, EPAD, G, bx);
                pg8::EpiBf16P E{pbuf, EPAD, rsx};
                SITE(0) pg8::gemm_phase<pg8::EpiBf16P, pg8::StaticOrder, true, true>(lds, g, S, E);
                SEAM(pb + 0);
            }
            if (IN(pb + 2)) { FRESH_IDS
                for (int w = vcu; w < 256; w += G) {
#ifndef NO_S5
#if (PROBE_EXTRA & 64)
                    if (w < 128) { s5_unit_mfma(a, e, pbuf, yb2, D, lds, w); __syncthreads(); }
#endif
#if (PROBE_EXTRA & 128)
                    if (w >= 128) { gla_unit_mfma(a, e, pbuf, yb2, lds, w - 128); __syncthreads(); }
#endif
#ifdef MIX_SIMPLE
                    if (w < 128) s5_unit_simple(a, e, pbuf, pbuf + PC_U, EPAD, lds, w, tid, wave, lane);
#else
                    if (w < 128) s5_unit_mfma(a, e, pbuf, pbuf + PC_U, EPAD, lds, w);
#endif
#endif
#ifdef MIX_SIMPLE
                    if (w >= 128) gla_unit_simple(a, e, pbuf, yb2, lds, w - 128, tid, wave, lane);
#else
                    if (w >= 128) gla_unit_mfma(a, e, pbuf, yb2, lds, w - 128);
#endif
                    __syncthreads();
                }
                SEAM(pb + 2);
            }
            if (IN(pb + 3)) {
                pg8::Gemm g{pbuf + PC_U, (const bf16*)(ws + WS_W_GLU + e * SZ_W_GLU), NTOK, 512, 512, EPAD, 512}; pg8::StaticOrder S; S.init(NTOK, 512, G, bx);
                pg8::EpiGlu E{pbuf + PC_U, EPAD, a.in(I_S5_BGLU) + e * 512, yb2, D};
                SITE(1) pg8::gemm_phase<pg8::EpiGlu, pg8::StaticOrder, true, true>(lds, g, S, E);
                SEAM(pb + 3);
            }
            if (IN(pb + 4)) {
                pg8::Gemm g{yb2, (const bf16*)(ws + WS_W_EVOUT + e * SZ_W_EVOUT), NTOK, D, D, D, D}; pg8::StaticOrder S; S.init(NTOK, D, G, bx);
                pg8::EpiNormRes E{xs, xres, a.in(I_LN_MIX_POST) + L * D, slotx, rsx, (unsigned)(2 * L + 1), ctl + CW_BAR + XB_TMO, lds + RING_BYTES, false};
                SITE(2) pg8::gemm_phase<pg8::EpiNormRes, pg8::StaticOrder, true, true>(lds, g, S, E);
                SEAM2(pb + 4);
            }
        } else {
            bf16* xm = (bf16*)(ws + WS_XM); bf16* xc = (bf16*)(ws + WS_XC); float* gates = (float*)(ws + WS_GATES); float* SSb = (float*)(ws + WS_SS);
            const bf16* wodin = (const bf16*)(ws + WS_W_ODIN + e * SZ_W_ODIN);
            if (IN(pb + 0)) {
                pg8::Gemm g{xs, wodin, NTOK, MI, D, D, D}; pg8::StaticOrder S; S.init(NTOK, MI, G, bx);
                pg8::EpiBf16P E{xm, MI, rsx};
                SITE(3) pg8::gemm_phase<pg8::EpiBf16P, pg8::StaticOrder, true, true>(lds, g, S, E);
                SEAM(pb + 0);
            }
            if (IN(pb + 1)) { FRESH_IDS
#ifndef NO_PRE
                for (int rep = 0, nrep = opaque_int((PROBE_EXTRA & 2) ? 2 : 1); rep < nrep; ++rep) { mlstm_prepass(a, e, xm, xc, gates, lds, vcu, G, tid, wave, lane); __syncthreads(); }
#endif
                SEAM(pb + 1); }
            if (IN(pb + 2)) { FRESH_IDS
#ifndef NO_ML
#ifdef MLSTM_SIMPLE
                for (int u = vcu; u < BATCH * MH * 4; u += G) { mlstm_unit_simple(a, e, xm, xc, gates, SSb, lds, u, tid, wave, lane); __syncthreads(); }
#else
                for (int rep = 0, nrep = opaque_int((PROBE_EXTRA & 4) ? 2 : 1); rep < nrep; ++rep)
                for (int u = vcu; u < BATCH * MH * 4; u += G) { mlstm_unit_mfma(a, e, xm, xc, gates, SSb, lds, u, rep == nrep - 1); __syncthreads(); }
#endif
#endif
                SEAM(pb + 2);
            }
            if (IN(pb + 3)) {
                pg8::Gemm g{xs, wodin + (size_t)MI * D, NTOK, MI, D, D, D}; pg8::StaticOrder S; S.init(NTOK, MI, G, bx);
                pg8::EpiOGate E{xm, xc, SSb, a.in(I_ML_NORM) + e * MI, a.in(I_ML_SKIP) + e * MI, MI, EPS, rsx};
                SITE(4) pg8::gemm_phase<pg8::EpiOGate, pg8::StaticOrder, true, true>(lds, g, S, E);
                SEAM(pb + 3);
            }
            if (IN(pb + 4)) {
                pg8::Gemm g{xm, (const bf16*)(ws + WS_W_ODOUT + e * SZ_W_ODOUT), NTOK, D, MI, MI, MI}; pg8::StaticOrder S; S.init(NTOK, D, G, bx);
                pg8::EpiNormRes E{xs, xres, a.in(I_LN_MIX_POST) + L * D, slotx, rsx, (unsigned)(2 * L + 1), ctl + CW_BAR + XB_TMO, lds + RING_BYTES, false};
                SITE(5) pg8::gemm_phase<pg8::EpiNormRes, pg8::StaticOrder, true, true>(lds, g, S, E);
                SEAM2(pb + 4);
            }
        }
        bf16* act = (bf16*)(ws + WS_ACT); bf16* HTG = (bf16*)(ws + WS_HALO); bf16* HTU = (bf16*)(ws + WS_HALO + SZ_HALO); bf16* HBG = (bf16*)(ws + WS_HALO + 2 * SZ_HALO);
        const float* fcw = a.in(I_FFN_CONV_W) + (size_t)L * 3 * FF; const float* fcb = a.in(I_FFN_CONV_B) + (size_t)L * FF;
        if (IN(pb + 6)) {
            pg8::Gemm g{xs, (const bf16*)(ws + WS_W_UP + L * SZ_W_UP), NTOK, 2 * FF, D, D, D}; pg8::StaticOrder S; S.init(NTOK, 2 * FF, G, bx, WGM_UP);
            pg8::EpiFfnUp E{act, HTG, HTU, HBG, fcw, fcb, FF, rsx};
            SITE(6) pg8::gemm_phase<pg8::EpiFfnUp, pg8::StaticOrder, true, true>(lds, g, S, E);
            SEAM(pb + 6);
        }
        if (IN(pb + 7)) { FRESH_IDS
#if (PROBE_EXTRA & 16)
            ffn_fixup(HTG, HTU, HBG, fcw, fcb, act, vcu * NTHREADS + tid, G * NTHREADS);
#endif
            ffn_fixup(HTG, HTU, HBG, fcw, fcb, act, vcu * NTHREADS + tid, G * NTHREADS); SEAM(pb + 7); }
        if (IN(pb + 8)) {
            pg8::Gemm g{act, (const bf16*)(ws + WS_W_DOWN + L * SZ_W_DOWN), NTOK, D, FF, FF, FF}; pg8::StaticOrder S; S.init(NTOK, D, G, bx);
            pg8::EpiNormRes E{xs, xres, a.in(I_LN_FFN_POST) + L * D, slotx, rsx, (unsigned)(2 * L + 2), ctl + CW_BAR + XB_TMO, lds + RING_BYTES, L + 1 == DEPTH};
            SITE(7) pg8::gemm_phase<pg8::EpiNormRes, pg8::StaticOrder, true, true>(lds, g, S, E);
            SEAM2(pb + 8);
        }
    }
#undef IN
#undef SEAM
#undef SEAM2
}

extern "C" void kernel_launch(void* const* d_in, const int* in_sizes, int n_in, void* d_out, int out_size, void* d_ws, size_t ws_size, hipStream_t stream) {
    static int grid = 0;
    if (grid == 0) {
        if (n_in != 35 || in_sizes[0] != NTOK * D || out_size != NTOK * D || ws_size < WS_END) {
            fprintf(stderr, "kernel_launch: unexpected shapes: n_in %d in0 %d out %d ws %zu (need %zu)\n", n_in, n_in > 0 ? in_sizes[0] : -1, out_size, ws_size, (size_t)WS_END); grid = -1; return; }
        int dev = 0, cus = 0, per_cu = 0;
        if (hipGetDevice(&dev) != hipSuccess || hipDeviceGetAttribute(&cus, hipDeviceAttributeMultiprocessorCount, dev) != hipSuccess) { grid = -1; return; }
        if (hipFuncSetAttribute((const void*)fwd, hipFuncAttributeMaxDynamicSharedMemorySize, LDS_BYTES) != hipSuccess) { fprintf(stderr, "kernel_launch: hipFuncSetAttribute failed\n"); grid = -1; return; }
        if (hipOccupancyMaxActiveBlocksPerMultiprocessor(&per_cu, (const void*)fwd, NTHREADS, LDS_BYTES) != hipSuccess || per_cu < 1)
            fprintf(stderr, "kernel_launch: occupancy query reports %d workgroups per CU\n", per_cu);
        (void)hipGetLastError();
        grid = cus;
    }
    if (grid < 0) return;
    if (hipMemsetAsync((char*)d_ws + WS_CTL, 0, CTL_ZERO_BYTES, stream) != hipSuccess) return;
    Args a{};
    for (int i = 0; i < 35; ++i) a.in[i] = (const float*)d_in[i];
    a.out = (float*)d_out; a.ws = (unsigned char*)d_ws;
#if MK_PER_PHASE_LAUNCH
    for (int p = 0; p < NPHASE; ++p) {
        const int L = (p - 1) / 10, slot = (p - 1) % 10;
        if (p > 0 && slot == 1 && (L & 1) == 0) continue;
        a.ph_lo = p; a.ph_hi = p + 1;
        hipLaunchKernelGGL(fwd, dim3(grid), dim3(NTHREADS), LDS_BYTES, stream, a);
    }
#else
    a.ph_lo = 0; a.ph_hi = NPHASE;
    hipLaunchKernelGGL(fwd, dim3(grid), dim3(NTHREADS), LDS_BYTES, stream, a);
#endif
}
```

```cpp
#include <hip/hip_runtime.h>
#include <cstdio>
#include <cstdint>

#ifndef MK_PER_PHASE_LAUNCH
#define MK_PER_PHASE_LAUNCH 0
#endif

template <int CTRL> __device__ __forceinline__ float dpp_mov(float x) { return __builtin_bit_cast(float, __builtin_amdgcn_mov_dpp(__builtin_bit_cast(int, x), CTRL, 0xf, 0xf, true)); }
template <int CTRL> __device__ __forceinline__ float dpp_z(float x) { return __builtin_bit_cast(float, __builtin_amdgcn_update_dpp(0, __builtin_bit_cast(int, x), CTRL, 0xf, 0xf, true)); }
template <int CTRL, int RM> __device__ __forceinline__ float dpp_o(float oldv, float x) { return __builtin_bit_cast(float, __builtin_amdgcn_update_dpp(__builtin_bit_cast(int, oldv), __builtin_bit_cast(int, x), CTRL, RM, 0xf, false)); }
namespace pg8 {
#define PG8_LAS __attribute__((address_space(3)))
typedef unsigned short bf16_t;
typedef short bf16x8 __attribute__((ext_vector_type(8)));
typedef float f32x4 __attribute__((ext_vector_type(4)));
typedef unsigned u32x4 __attribute__((ext_vector_type(4)));
typedef unsigned u32x2 __attribute__((ext_vector_type(2)));
constexpr int BM = 256, BK = 64, HALF = 128, HTB = HALF * BK * 2  , STAGE_BYTES = 8 * HTB, NXCD = 8, WGM = 8;

__host__ __device__ __forceinline__ int lds_byte(int r, int c) { const int st = (r >> 4) * 2 + (c >> 5), rr = r & 15, cc = c & 31, ob = rr * 64 + cc * 2; return st * 1024 + (ob ^ (((ob >> 9) & 1) << 5)); }
__host__ __device__ __forceinline__ void stage_rc(int b, int& R, int& C) { const int st = b / 1024, sb = b % 1024, swz = sb ^ (((sb >> 9) & 1) << 5); R = (st >> 1) * 16 + swz / 64; C = (st & 1) * 32 + (swz % 64) / 2; }
__host__ __device__ __forceinline__ int perm32(int rho) { const int n = rho >> 4, i = rho & 15; return 8 * (i >> 2) + 4 * n + (i & 3); }

struct Unit { int pm, pn; };
struct Gemm { const bf16_t* A; const bf16_t* Bt; int M, N, K, lda, ldb; };

struct StaticOrder {
    int nM, nN, nwg, G, c, wgm;
    __host__ __device__ void init(int M, int N, int G_, int c_, int wgm_ = WGM) { nM = M / BM; nN = N / BM; nwg = nM * nN; G = G_; c = c_; wgm = wgm_; }
    __host__ __device__ bool next(int i, Unit& u) const {
        const long L = (long)i * G + c; if (L >= nwg) return false;
        int wgid = (int)L; { const int q = nwg / NXCD, r = nwg % NXCD, xcd = wgid % NXCD, off = wgid / NXCD; wgid = (xcd < r ? xcd * (q + 1) : r * (q + 1) + (xcd - r) * q) + off; }
        const int nig = wgm * nN, gid = wgid / nig, fm = gid * wgm, gsz = (nM - fm) < wgm ? (nM - fm) : wgm;
        u.pm = fm + ((wgid % nig) % gsz); u.pn = (wgid % nig) / gsz; return true;
    }
    __device__ __forceinline__ void a_ready(const Unit&) const {}
    __device__ __forceinline__ void done(const Unit&) const {}
};

typedef __bf16 bf16x2n __attribute__((ext_vector_type(2)));
__device__ __forceinline__ unsigned cvt_pk_bf16(float lo, float hi) { const bf16x2n v = {(__bf16)lo, (__bf16)hi}; return __builtin_bit_cast(unsigned, v); }
__device__ __forceinline__ float bf_lo(unsigned u) { return __uint_as_float(u << 16); }
__device__ __forceinline__ float bf_hi(unsigned u) { return __uint_as_float(u & 0xffff0000u); }
__device__ __forceinline__ float sigmoidf_(float x) { return __builtin_amdgcn_rcpf(1.0f + __expf(-x)); }
__device__ __forceinline__ float gelu_tanh(float x) { const float p = fmaf(x * x, -0.10294323f, -2.3022082f); return x * __builtin_amdgcn_rcpf(1.0f + __builtin_amdgcn_exp2f(x * p)); }

__device__ __forceinline__ float rs_of(const float* rsp, size_t row) { const f32x4 p = *(const f32x4*)(rsp + 4 * row); return rsqrtf(((p[0] + p[1]) + (p[2] + p[3])) * (1.0f / 1024.0f) + 1e-6f); }
struct EpiBf16P {
    static constexpr bool PERM = true, AFTER_DRAIN = false;
    bf16_t* O; int ldc; const float* rs;
    __device__ __forceinline__ void operator()(const f32x4 (&acc)[2][2][4][2], const Unit& u, int wr, int wc, int fr, int fq) const {
        const int row0 = u.pm * BM + wr * 64 + fr, col0 = u.pn * BM + wc * 32 + 8 * fq;
#pragma unroll
        for (int ai = 0; ai < 2; ++ai)
#pragma unroll
            for (int m = 0; m < 4; ++m) { bf16_t* rowp = O + (size_t)(row0 + ai * HALF + m * 16) * ldc + col0; const float rsc = rs ? rs_of(rs, (size_t)(row0 + ai * HALF + m * 16)) : 1.0f;
#pragma unroll
                for (int bj = 0; bj < 2; ++bj) { const f32x4 v0 = acc[ai][bj][m][0] * rsc, v1 = acc[ai][bj][m][1] * rsc;
                    u32x4 w; w.x = cvt_pk_bf16(v0[0], v0[1]); w.y = cvt_pk_bf16(v0[2], v0[3]); w.z = cvt_pk_bf16(v1[0], v1[1]); w.w = cvt_pk_bf16(v1[2], v1[3]);
                    *(u32x4*)(rowp + bj * HALF) = w; } }
    }
};
struct EpiGlu {
    static constexpr bool PERM = true, AFTER_DRAIN = false;
    const bf16_t* Y; int ldy; const float* bias; bf16_t* O; int ldc;
    __device__ __forceinline__ void operator()(const f32x4 (&acc)[2][2][4][2], const Unit& u, int wr, int wc, int fr, int fq) const {
        const int row0 = u.pm * BM + wr * 64 + fr, col0 = u.pn * BM + wc * 32 + 8 * fq;
        f32x4 bv[2][2];
#pragma unroll
        for (int bj = 0; bj < 2; ++bj)
#pragma unroll
            for (int n = 0; n < 2; ++n) bv[bj][n] = *(const f32x4*)(bias + col0 + bj * HALF + 4 * n);
#pragma unroll
        for (int ai = 0; ai < 2; ++ai)
#pragma unroll
            for (int m = 0; m < 4; ++m) { const size_t row = (size_t)(row0 + ai * HALF + m * 16);
#pragma unroll
                for (int bj = 0; bj < 2; ++bj) { const int col = col0 + bj * HALF;
                    const u32x4 yv = *(const u32x4*)(Y + row * ldy + col);
                    const f32x4 z0 = acc[ai][bj][m][0] + bv[bj][0], z1 = acc[ai][bj][m][1] + bv[bj][1];
                    float o[8];
                    o[0] = bf_lo(yv.x) * sigmoidf_(z0[0]); o[1] = bf_hi(yv.x) * sigmoidf_(z0[1]); o[2] = bf_lo(yv.y) * sigmoidf_(z0[2]); o[3] = bf_hi(yv.y) * sigmoidf_(z0[3]);
                    o[4] = bf_lo(yv.z) * sigmoidf_(z1[0]); o[5] = bf_hi(yv.z) * sigmoidf_(z1[1]); o[6] = bf_lo(yv.w) * sigmoidf_(z1[2]); o[7] = bf_hi(yv.w) * sigmoidf_(z1[3]);
                    u32x4 w; w.x = cvt_pk_bf16(o[0], o[1]); w.y = cvt_pk_bf16(o[2], o[3]); w.z = cvt_pk_bf16(o[4], o[5]); w.w = cvt_pk_bf16(o[6], o[7]);
                    *(u32x4*)(O + row * ldc + col) = w; } }
    }
};
struct EpiOGate {
    static constexpr bool PERM = true, AFTER_DRAIN = false;
    bf16_t* H; const bf16_t* XC; const float* SS; const float* gn; const float* skip; int ld; float eps; const float* rs;
    struct RowIn { f32x4 ss, rp; u32x4 hv[2], xv[2]; };
    __device__ __forceinline__ void operator()(const f32x4 (&acc)[2][2][4][2], const Unit& u, int wr, int wc, int fr_, int fq_) const {
        int tq = threadIdx.x; asm volatile("" : "+v"(tq));
        const int fr = tq & 15, fq = (tq >> 4) & 3; (void)fr_; (void)fq_;
        const int row0 = u.pm * BM + wr * 64 + fr, col0 = u.pn * BM + wc * 32 + 8 * fq, head = u.pn >> 1;
        f32x4 gv[2][2], sv[2][2];
#pragma unroll
        for (int bj = 0; bj < 2; ++bj)
#pragma unroll
            for (int n = 0; n < 2; ++n) { gv[bj][n] = *(const f32x4*)(gn + col0 + bj * HALF + 4 * n); sv[bj][n] = *(const f32x4*)(skip + col0 + bj * HALF + 4 * n); }
        auto load_row = [&](int it, RowIn& R) { const size_t row = (size_t)(row0 + (it >> 2) * HALF + (it & 3) * 16);
            R.ss = *(const f32x4*)(SS + row * 16 + head * 4); R.rp = *(const f32x4*)(rs + 4 * row);
#pragma unroll
            for (int bj = 0; bj < 2; ++bj) { R.hv[bj] = *(const u32x4*)(H + row * ld + col0 + bj * HALF); R.xv[bj] = *(const u32x4*)(XC + row * ld + col0 + bj * HALF); } };
        RowIn cur, nxt;
        load_row(0, cur);
#pragma unroll
        for (int it = 0; it < 8; ++it) { const int ai = it >> 2, m = it & 3;
            const size_t row = (size_t)(row0 + ai * HALF + m * 16);
            if (it < 7) load_row(it + 1, nxt);
            __builtin_amdgcn_sched_barrier(0);
            const float rstd = rsqrtf(((cur.ss[0] + cur.ss[1]) + (cur.ss[2] + cur.ss[3])) * (1.0f / 512.0f) + eps);
            const float rsc = rsqrtf(((cur.rp[0] + cur.rp[1]) + (cur.rp[2] + cur.rp[3])) * (1.0f / 1024.0f) + 1e-6f);
#pragma unroll
            for (int bj = 0; bj < 2; ++bj) { const int col = col0 + bj * HALF;
                const u32x4 hv = cur.hv[bj], xv = cur.xv[bj];
                const f32x4 a0 = acc[ai][bj][m][0] * rsc, a1 = acc[ai][bj][m][1] * rsc; const f32x4 g0 = gv[bj][0] * rstd, g1 = gv[bj][1] * rstd, s0 = sv[bj][0], s1 = sv[bj][1];
                float o[8];
                o[0] = sigmoidf_(a0[0]) * (bf_lo(hv.x) * g0[0] + s0[0] * bf_lo(xv.x)); o[1] = sigmoidf_(a0[1]) * (bf_hi(hv.x) * g0[1] + s0[1] * bf_hi(xv.x));
                o[2] = sigmoidf_(a0[2]) * (bf_lo(hv.y) * g0[2] + s0[2] * bf_lo(xv.y)); o[3] = sigmoidf_(a0[3]) * (bf_hi(hv.y) * g0[3] + s0[3] * bf_hi(xv.y));
                o[4] = sigmoidf_(a1[0]) * (bf_lo(hv.z) * g1[0] + s1[0] * bf_lo(xv.z)); o[5] = sigmoidf_(a1[1]) * (bf_hi(hv.z) * g1[1] + s1[1] * bf_hi(xv.z));
                o[6] = sigmoidf_(a1[2]) * (bf_lo(hv.w) * g1[2] + s1[2] * bf_lo(xv.w)); o[7] = sigmoidf_(a1[3]) * (bf_hi(hv.w) * g1[3] + s1[3] * bf_hi(xv.w));
                u32x4 w; w.x = cvt_pk_bf16(o[0], o[1]); w.y = cvt_pk_bf16(o[2], o[3]); w.z = cvt_pk_bf16(o[4], o[5]); w.w = cvt_pk_bf16(o[6], o[7]);
                *(u32x4*)(H + row * ld + col) = w; }
            __builtin_amdgcn_sched_barrier(0);
            if (it < 7) cur = nxt; }
    }
};
struct EpiFfnUp {
    static constexpr bool PERM = true, AFTER_DRAIN = false;
    bf16_t* ACT; bf16_t* HTG; bf16_t* HTU; bf16_t* HBG; const float* cw; const float* cb; int FFd; const float* rs;
    __device__ __forceinline__ void operator()(const f32x4 (&acc)[2][2][4][2], const Unit& u, int wr, int wc, int fr, int fq) const {
        const int ch = u.pn * HALF + wc * 32 + 8 * fq;
        f32x4 w0[2], w1[2], w2[2], bb[2];
#pragma unroll
        for (int n = 0; n < 2; ++n) { w0[n] = *(const f32x4*)(cw + ch + 4 * n); w1[n] = *(const f32x4*)(cw + FFd + ch + 4 * n); w2[n] = *(const f32x4*)(cw + 2 * FFd + ch + 4 * n); bb[n] = *(const f32x4*)(cb + ch + 4 * n); }
#pragma unroll
        for (int ai = 0; ai < 2; ++ai) {
            const int blk = u.pm * 4 + ai * 2 + wr;
            float rsm[4];
#pragma unroll
            for (int m = 0; m < 4; ++m) rsm[m] = rs_of(rs, (size_t)(u.pm * BM + ai * HALF + wr * 64 + m * 16 + fr));
            f32x4 gpv[2] = {(f32x4){0.f, 0.f, 0.f, 0.f}, (f32x4){0.f, 0.f, 0.f, 0.f}};
#pragma unroll
            for (int m = 0; m < 4; ++m) {
                float o[8];
#pragma unroll
                for (int n = 0; n < 2; ++n)
#pragma unroll
                    for (int j = 0; j < 4; ++j) {
                        const float g = acc[ai][0][m][n][j] * rsm[m], gp = gpv[n][j];
                        float cv = fmaf(w2[n][j], g, bb[n][j]);
                        cv = fmaf(dpp_z<0x111>(g), w1[n][j], cv); cv = fmaf(dpp_z<0x10F>(gp), w1[n][j], cv);
                        cv = fmaf(dpp_z<0x112>(g), w0[n][j], cv); cv = fmaf(dpp_z<0x10E>(gp), w0[n][j], cv);
                        o[4 * n + j] = gelu_tanh(cv) * (acc[ai][1][m][n][j] * rsm[m]);
                        gpv[n][j] = g;
                    }
                const size_t row = (size_t)(u.pm * BM + ai * HALF + wr * 64 + m * 16 + fr);
                if (m == 0 && fr < 2) {
                    const f32x4 ga = acc[ai][0][0][0] * rsm[0], gb = acc[ai][0][0][1] * rsm[0], ua = acc[ai][1][0][0] * rsm[0], ub = acc[ai][1][0][1] * rsm[0];
                    u32x4 wg, wu; wg.x = cvt_pk_bf16(ga[0], ga[1]); wg.y = cvt_pk_bf16(ga[2], ga[3]); wg.z = cvt_pk_bf16(gb[0], gb[1]); wg.w = cvt_pk_bf16(gb[2], gb[3]);
                    wu.x = cvt_pk_bf16(ua[0], ua[1]); wu.y = cvt_pk_bf16(ua[2], ua[3]); wu.z = cvt_pk_bf16(ub[0], ub[1]); wu.w = cvt_pk_bf16(ub[2], ub[3]);
                    *(u32x4*)(HTG + ((size_t)blk * 2 + fr) * FFd + ch) = wg; *(u32x4*)(HTU + ((size_t)blk * 2 + fr) * FFd + ch) = wu;
                } else {
                    u32x4 w; w.x = cvt_pk_bf16(o[0], o[1]); w.y = cvt_pk_bf16(o[2], o[3]); w.z = cvt_pk_bf16(o[4], o[5]); w.w = cvt_pk_bf16(o[6], o[7]);
                    *(u32x4*)(ACT + row * FFd + ch) = w;
                }
                if (m == 3 && fr >= 14) { const f32x4 ga = acc[ai][0][3][0] * rsm[3], gb = acc[ai][0][3][1] * rsm[3];
                    u32x4 wg; wg.x = cvt_pk_bf16(ga[0], ga[1]); wg.y = cvt_pk_bf16(ga[2], ga[3]); wg.z = cvt_pk_bf16(gb[0], gb[1]); wg.w = cvt_pk_bf16(gb[2], gb[3]);
                    *(u32x4*)(HBG + ((size_t)blk * 2 + (fr - 14)) * FFd + ch) = wg; }
                if (m & 1) __builtin_amdgcn_sched_barrier(0);
            }
        }
    }
};

struct EpiNormRes {
    static constexpr bool PERM = true, AFTER_DRAIN = false;
    bf16_t* XS; float* OUT; const float* gpost; unsigned long long* slot; float* RSP; unsigned tag; unsigned* tmo; PG8_LAS unsigned char* tab; bool last;
    __device__ __forceinline__ void operator()(const f32x4 (&acc)[2][2][4][2], const Unit& u, int wr, int wc, int fr_, int fq_) const {
        int tq = threadIdx.x; asm volatile("" : "+v"(tq));
        const int fr = tq & 15, fq = (tq >> 4) & 3; (void)fr_; (void)fq_;
        PG8_LAS float* P = (PG8_LAS float*)tab;
        PG8_LAS float* Sx = (PG8_LAS float*)(tab + 16384);
        const int lane = fq * 16 + fr, prow = wc * 64 + lane;
        const int col0 = u.pn * BM + wc * 32 + 8 * fq;
        u32x4 xv[2][4][2];
#pragma unroll
        for (int ai = 0; ai < 2; ++ai)
#pragma unroll
            for (int m = 0; m < 4; ++m)
#pragma unroll
                for (int bj = 0; bj < 2; ++bj) xv[ai][m][bj] = *(const u32x4*)(XS + (size_t)(u.pm * BM + ai * HALF + wr * 64 + m * 16 + fr) * 1024 + col0 + bj * HALF);
#pragma unroll
        for (int ai = 0; ai < 2; ++ai)
#pragma unroll
            for (int m = 0; m < 4; ++m) { float s = 0.f;
#pragma unroll
                for (int bj = 0; bj < 2; ++bj)
#pragma unroll
                    for (int n = 0; n < 2; ++n) { const f32x4 x = acc[ai][bj][m][n]; s += (x[0] * x[0] + x[1] * x[1]) + (x[2] * x[2] + x[3] * x[3]); }
                P[(ai * HALF + wr * 64 + m * 16 + fr) * 16 + wc * 4 + fq] = s; }
        asm volatile("s_waitcnt lgkmcnt(0)" ::: "memory"); __builtin_amdgcn_s_barrier(); asm volatile("" ::: "memory");
        if (wr == 0) {
            const f32x4 a = *(const PG8_LAS f32x4*)(P + prow * 16), b = *(const PG8_LAS f32x4*)(P + prow * 16 + 4), c = *(const PG8_LAS f32x4*)(P + prow * 16 + 8), d = *(const PG8_LAS f32x4*)(P + prow * 16 + 12);
            const f32x4 t4 = (a + b) + (c + d); const float t = (t4[0] + t4[1]) + (t4[2] + t4[3]);
            unsigned long long* sp4 = slot + (size_t)(u.pm * BM + prow) * 4;
            __hip_atomic_store(sp4 + u.pn, ((unsigned long long)tag << 32) | __float_as_uint(t), __ATOMIC_RELAXED, __HIP_MEMORY_SCOPE_AGENT);
            unsigned long long w0, w1, w2, w3; unsigned sp = 0u;
            for (;;) {
                w0 = __hip_atomic_load(sp4, __ATOMIC_RELAXED, __HIP_MEMORY_SCOPE_AGENT); w1 = __hip_atomic_load(sp4 + 1, __ATOMIC_RELAXED, __HIP_MEMORY_SCOPE_AGENT);
                w2 = __hip_atomic_load(sp4 + 2, __ATOMIC_RELAXED, __HIP_MEMORY_SCOPE_AGENT); w3 = __hip_atomic_load(sp4 + 3, __ATOMIC_RELAXED, __HIP_MEMORY_SCOPE_AGENT);
                const bool ok = (unsigned)(w0 >> 32) == tag && (unsigned)(w1 >> 32) == tag && (unsigned)(w2 >> 32) == tag && (unsigned)(w3 >> 32) == tag;
                if (__builtin_amdgcn_ballot_w64(!ok) == 0ull) break;
                __builtin_amdgcn_s_sleep(1);
                if (++sp > (1u << 19)) { if (lane == 0) __hip_atomic_fetch_add(tmo, 1u, __ATOMIC_RELAXED, __HIP_MEMORY_SCOPE_AGENT); break; }
            }
            const float p0 = __uint_as_float((unsigned)w0), p1 = __uint_as_float((unsigned)w1), p2 = __uint_as_float((unsigned)w2), p3 = __uint_as_float((unsigned)w3);
            Sx[prow] = rsqrtf(((p0 + p1) + (p2 + p3)) * (1.0f / 1024.0f) + 1e-6f);
        }
        asm volatile("s_waitcnt lgkmcnt(0)" ::: "memory"); __builtin_amdgcn_s_barrier(); asm volatile("" ::: "memory");
        f32x4 gv[2][2];
#pragma unroll
        for (int bj = 0; bj < 2; ++bj)
#pragma unroll
            for (int n = 0; n < 2; ++n) gv[bj][n] = *(const f32x4*)(gpost + col0 + bj * HALF + 4 * n);
#pragma unroll
        for (int ai = 0; ai < 2; ++ai)
#pragma unroll
            for (int m = 0; m < 4; ++m) { const int r = ai * HALF + wr * 64 + m * 16 + fr; const size_t off = (size_t)(u.pm * BM + r) * 1024 + col0; const float rstd = Sx[r]; float s2 = 0.f;
#pragma unroll
                for (int bj = 0; bj < 2; ++bj) { const u32x4 xw = xv[ai][m][bj];
                    const f32x4 x0 = (f32x4){bf_lo(xw.x), bf_hi(xw.x), bf_lo(xw.y), bf_hi(xw.y)} + acc[ai][bj][m][0] * rstd * gv[bj][0];
                    const f32x4 x1 = (f32x4){bf_lo(xw.z), bf_hi(xw.z), bf_lo(xw.w), bf_hi(xw.w)} + acc[ai][bj][m][1] * rstd * gv[bj][1];
                    s2 += ((x0[0] * x0[0] + x0[1] * x0[1]) + (x0[2] * x0[2] + x0[3] * x0[3])) + ((x1[0] * x1[0] + x1[1] * x1[1]) + (x1[2] * x1[2] + x1[3] * x1[3]));
                    if (last) { *(f32x4*)(OUT + off + bj * HALF) = x0; *(f32x4*)(OUT + off + bj * HALF + 4) = x1; }
                    else { u32x4 w; w.x = cvt_pk_bf16(x0[0], x0[1]); w.y = cvt_pk_bf16(x0[2], x0[3]); w.z = cvt_pk_bf16(x1[0], x1[1]); w.w = cvt_pk_bf16(x1[2], x1[3]); *(u32x4*)(XS + off + bj * HALF) = w; } }
                P[r * 16 + wc * 4 + fq] = s2; }
        asm volatile("s_waitcnt lgkmcnt(0)" ::: "memory"); __builtin_amdgcn_s_barrier(); asm volatile("" ::: "memory");
        if (wr == 0 && !last) {
            const f32x4 a = *(const PG8_LAS f32x4*)(P + prow * 16), b = *(const PG8_LAS f32x4*)(P + prow * 16 + 4), c = *(const PG8_LAS f32x4*)(P + prow * 16 + 8), d = *(const PG8_LAS f32x4*)(P + prow * 16 + 12);
            const f32x4 t4 = (a + b) + (c + d);
            RSP[(size_t)(u.pm * BM + prow) * 4 + u.pn] = (t4[0] + t4[1]) + (t4[2] + t4[3]); }
    }
};

template <class Epi, class Sched, bool ALIGN_EPI = false, bool SP2 = false>
__device__ __forceinline__ void gemm_phase(PG8_LAS unsigned char* lds, const Gemm g, const Sched& S, const Epi& E) {
    int tid = threadIdx.x; asm volatile("" : "+v"(tid));
    const int wid = __builtin_amdgcn_readfirstlane(tid >> 6), lane = tid & 63, wr = wid >> 2, wc = wid & 3, fr = lane & 15, fq = lane >> 4;
    const int K = g.K, nt = K / BK;
    unsigned voffA[2], voffB[2];
#pragma unroll
    for (int i = 0; i < 2; ++i) { int R, C; stage_rc(tid * 16 + i * 8192, R, C); const int Rb = Epi::PERM ? ((R & ~31) + perm32(R & 31)) : R;
        voffA[i] = (unsigned)(R * g.lda + C) * 2u; voffB[i] = (unsigned)(Rb * g.ldb + C) * 2u; }
    const size_t kstep = (size_t)(BK * 2);
    const size_t hstepA = (size_t)HALF * g.lda * 2, hstepB = (size_t)HALF * g.ldb * 2;
    const size_t tstepA = 2 * hstepA, tstepB = 2 * hstepB;
    const unsigned ldsw = (unsigned)wid * 1024u;
    const int aoff = lds_byte(wr * 64 + fr, fq * 8), boff = lds_byte(wc * 32 + fr, fq * 8);
#define PG8_SA(b, h) (((b) * 2 + (h)) * HTB)
#define PG8_SB(b, h) ((4 + (b) * 2 + (h)) * HTB)
#define PG8_STAGE(bufoff, gbase, voff) do { _Pragma("unroll") for (int _i = 0; _i < 2; ++_i) \
        __builtin_amdgcn_global_load_lds((const unsigned*)((const char*)(gbase) + (voff)[_i]), (PG8_LAS unsigned*)(lds + (bufoff) + ldsw + _i * 8192), 16, 0, 0); } while (0)
#define PG8_LDA(dst, b, h) do { _Pragma("unroll") for (int m = 0; m < 4; ++m) _Pragma("unroll") for (int k = 0; k < 2; ++k) dst[m][k] = *(const PG8_LAS bf16x8*)(lds + PG8_SA(b, h) + aoff + m * 2048 + k * 1024); } while (0)
#define PG8_LDB(dst, b, h) do { _Pragma("unroll") for (int n = 0; n < 2; ++n) _Pragma("unroll") for (int k = 0; k < 2; ++k) dst[n][k] = *(const PG8_LAS bf16x8*)(lds + PG8_SB(b, h) + boff + n * 2048 + k * 1024); } while (0)
#define PG8_MMA(ai, bj, At, Bt) do { __builtin_amdgcn_s_setprio(1); _Pragma("unroll") for (int m = 0; m < 4; ++m) _Pragma("unroll") for (int n = 0; n < 2; ++n) _Pragma("unroll") for (int k = 0; k < 2; ++k) \
        acc[ai][bj][m][n] = __builtin_amdgcn_mfma_f32_16x16x32_bf16(Bt[n][k], At[m][k], acc[ai][bj][m][n], 0, 0, 0); __builtin_amdgcn_s_setprio(0); } while (0)
#define PG8_WAIT_V(n) asm volatile("s_waitcnt vmcnt(" #n ")" ::: "memory")
#define PG8_WAIT_L(n) asm volatile("s_waitcnt lgkmcnt(" #n ")" ::: "memory")
#define PG8_BAR __builtin_amdgcn_s_barrier()
#define PG8_SCHED __builtin_amdgcn_sched_barrier(0)
    Unit cur, nxt; int ui = 0;
    if (!S.next(0, cur)) return;
    f32x4 acc[2][2][4][2];
#pragma unroll
    for (int a = 0; a < 2; ++a)
#pragma unroll
        for (int b = 0; b < 2; ++b)
#pragma unroll
            for (int m = 0; m < 4; ++m)
#pragma unroll
                for (int n = 0; n < 2; ++n) acc[a][b][m][n] = (f32x4){0.f, 0.f, 0.f, 0.f};
    bf16x8 At[4][2], B0[2][2], B1[2][2];
    const char* cA = (const char*)g.A + (size_t)cur.pm * tstepA; const char* cB = (const char*)g.Bt + (size_t)cur.pn * tstepB;
    S.a_ready(cur);
    if constexpr (SP2) {
        PG8_STAGE(PG8_SB(0, 0), cB, voffB); PG8_STAGE(PG8_SB(0, 1), cB + hstepB, voffB); PG8_STAGE(PG8_SA(0, 0), cA, voffA); PG8_STAGE(PG8_SA(0, 1), cA + hstepA, voffA);
        if (wr == 1) PG8_BAR;
        PG8_WAIT_V(2); PG8_BAR;
        PG8_STAGE(PG8_SB(1, 0), cB + kstep, voffB); PG8_STAGE(PG8_SA(1, 0), cA + kstep, voffA); PG8_STAGE(PG8_SB(1, 1), cB + hstepB + kstep, voffB);
        PG8_WAIT_V(6); PG8_BAR;
    } else {
        PG8_STAGE(PG8_SB(0, 0), cB, voffB); PG8_STAGE(PG8_SA(0, 0), cA, voffA); PG8_STAGE(PG8_SB(0, 1), cB + hstepB, voffB); PG8_STAGE(PG8_SA(0, 1), cA + hstepA, voffA);
        if (wr == 1) PG8_BAR;
        PG8_WAIT_V(4); PG8_BAR;
        PG8_STAGE(PG8_SB(1, 0), cB + kstep, voffB); PG8_STAGE(PG8_SA(1, 0), cA + kstep, voffA); PG8_STAGE(PG8_SB(1, 1), cB + hstepB + kstep, voffB);
        PG8_WAIT_V(6); PG8_BAR;
    }
    for (;;) {
        const bool has_next = S.next(ui + 1, nxt);
        const char* nA = has_next ? (const char*)g.A + (size_t)nxt.pm * tstepA : cA; const char* nB = has_next ? (const char*)g.Bt + (size_t)nxt.pn * tstepB : cB;
        for (int t = 0; t < nt; t += 2) {
            const bool last = (t == nt - 2);
            const char* a1 = cA + (size_t)(t + 1) * kstep;
            const char* a2 = last ? nA : cA + (size_t)(t + 2) * kstep; const char* b2 = last ? nB : cB + (size_t)(t + 2) * kstep;
            const char* a3 = a2 + kstep; const char* b3 = b2 + kstep;
            if (last && has_next) S.a_ready(nxt);
            if constexpr (SP2) {
            PG8_LDB(B0, 0, 0); PG8_LDB(B1, 0, 1); PG8_SCHED; PG8_LDA(At, 0, 0); PG8_STAGE(PG8_SA(1, 1), a1 + hstepA, voffA);
            PG8_WAIT_V(8); PG8_WAIT_L(0); PG8_BAR; PG8_MMA(0, 0, At, B0); PG8_MMA(0, 1, At, B1); PG8_BAR; PG8_SCHED;
            PG8_LDA(At, 0, 1); PG8_STAGE(PG8_SB(0, 0), b2, voffB); PG8_STAGE(PG8_SB(0, 1), b2 + hstepB, voffB); PG8_STAGE(PG8_SA(0, 0), a2, voffA);
            PG8_WAIT_V(8); PG8_WAIT_L(0); PG8_BAR; PG8_MMA(1, 0, At, B0); PG8_MMA(1, 1, At, B1); PG8_BAR; PG8_SCHED;
            PG8_LDB(B0, 1, 0); PG8_LDB(B1, 1, 1); PG8_SCHED; PG8_LDA(At, 1, 0); PG8_STAGE(PG8_SA(0, 1), a2 + hstepA, voffA);
            PG8_WAIT_V(8); PG8_WAIT_L(0); PG8_BAR; PG8_MMA(0, 0, At, B0); PG8_MMA(0, 1, At, B1); PG8_BAR; PG8_SCHED;
            PG8_LDA(At, 1, 1); PG8_STAGE(PG8_SB(1, 0), b3, voffB); PG8_STAGE(PG8_SB(1, 1), b3 + hstepB, voffB); PG8_STAGE(PG8_SA(1, 0), a3, voffA);
            PG8_WAIT_V(8); PG8_WAIT_L(0); PG8_BAR; PG8_MMA(1, 0, At, B0); PG8_MMA(1, 1, At, B1); PG8_BAR; PG8_SCHED;
            } else {
            PG8_LDB(B0, 0, 0); PG8_SCHED; PG8_LDA(At, 0, 0); PG8_STAGE(PG8_SA(1, 1), a1 + hstepA, voffA);
            PG8_WAIT_L(8); PG8_BAR; PG8_WAIT_L(0); PG8_MMA(0, 0, At, B0); PG8_BAR; PG8_SCHED;
            PG8_LDB(B1, 0, 1); PG8_STAGE(PG8_SB(0, 0), b2, voffB);
            PG8_BAR; PG8_WAIT_L(0); PG8_MMA(0, 1, At, B1); PG8_BAR;
            PG8_LDA(At, 0, 1); PG8_STAGE(PG8_SA(0, 0), a2, voffA);
            PG8_BAR; PG8_WAIT_L(0); PG8_MMA(1, 0, At, B0); PG8_BAR; PG8_SCHED;
            PG8_STAGE(PG8_SB(0, 1), b2 + hstepB, voffB);
            PG8_WAIT_V(6); PG8_BAR; PG8_MMA(1, 1, At, B1); PG8_BAR;
            PG8_LDB(B0, 1, 0); PG8_SCHED; PG8_LDA(At, 1, 0); PG8_STAGE(PG8_SA(0, 1), a2 + hstepA, voffA);
            PG8_WAIT_L(8); PG8_BAR; PG8_WAIT_L(0); PG8_MMA(0, 0, At, B0); PG8_BAR; PG8_SCHED;
            PG8_LDB(B1, 1, 1); PG8_STAGE(PG8_SB(1, 0), b3, voffB);
            PG8_BAR; PG8_WAIT_L(0); PG8_MMA(0, 1, At, B1); PG8_BAR;
            PG8_LDA(At, 1, 1); PG8_STAGE(PG8_SA(1, 0), a3, voffA);
            PG8_BAR; PG8_WAIT_L(0); PG8_MMA(1, 0, At, B0); PG8_BAR; PG8_SCHED;
            PG8_STAGE(PG8_SB(1, 1), b3 + hstepB, voffB);
            PG8_WAIT_V(6); PG8_BAR; PG8_MMA(1, 1, At, B1); PG8_BAR;
            }
        }
        if constexpr (ALIGN_EPI) { if (wr == 0) PG8_BAR; }
        if constexpr (!Epi::AFTER_DRAIN) { E(acc, cur, wr, wc, fr, fq); S.done(cur); }
        if (!has_next) break;
#pragma unroll
        for (int a = 0; a < 2; ++a)
#pragma unroll
            for (int b = 0; b < 2; ++b)
#pragma unroll
                for (int m = 0; m < 4; ++m)
#pragma unroll
                    for (int n = 0; n < 2; ++n) acc[a][b][m][n] = (f32x4){0.f, 0.f, 0.f, 0.f};
        cur = nxt; cA = nA; cB = nB; ++ui;
        if constexpr (ALIGN_EPI) { if (wr == 1) PG8_BAR; }
    }
    PG8_WAIT_V(0);
    if constexpr (!ALIGN_EPI) { if (wr == 0) PG8_BAR; }
    PG8_BAR;
    if constexpr (Epi::AFTER_DRAIN) { E.fused(acc, cur, wr, wc, fr, fq, lds, wid, lane); S.done(cur); }
#undef PG8_SA
#undef PG8_SB
#undef PG8_STAGE
#undef PG8_LDA
#undef PG8_LDB
#undef PG8_MMA
#undef PG8_WAIT_V
#undef PG8_WAIT_L
#undef PG8_BAR
#undef PG8_SCHED
}
}

constexpr int D = 1024, BATCH = 32, SEQ = 2048, NTOK = BATCH * SEQ, DEPTH = 4;
constexpr int S5G = 32, S5P = 64, S5GS = 16;
constexpr int GH = 4, GDK = 64, GDV = 128;
constexpr int EPROJ = 2064, EPAD = 2304;
constexpr int PC_U = 0, PC_Q = 512, PC_K = 768, PC_V = 1024, PC_R = 1536, PC_A = 2048;
constexpr int MI = 2048, MH = 4, MDH = 512;
constexpr int FF = 2816;
constexpr float EPS = 1e-6f;
constexpr int NWAVES = 8, NTHREADS = 512;
constexpr int NPHASE = 1 + 10 * DEPTH;

constexpr size_t MiB = 1u << 20;
constexpr size_t WS_CTL = 0, CTL_ZERO_BYTES = 1 * MiB;
constexpr size_t WS_W_EVIN = 2 * MiB, SZ_W_EVIN = (size_t)EPAD * D * 2;
constexpr size_t WS_W_GLU = 11 * MiB, SZ_W_GLU = (size_t)512 * 512 * 2;
constexpr size_t WS_W_EVOUT = 12 * MiB, SZ_W_EVOUT = (size_t)D * D * 2;
constexpr size_t WS_W_ODIN = 16 * MiB, SZ_W_ODIN = (size_t)2 * MI * D * 2;
constexpr size_t WS_W_ODOUT = 32 * MiB, SZ_W_ODOUT = (size_t)D * MI * 2;
constexpr size_t WS_W_UP = 40 * MiB, SZ_W_UP = (size_t)2 * FF * D * 2;
constexpr size_t WS_W_DOWN = 84 * MiB, SZ_W_DOWN = (size_t)D * FF * 2;
constexpr size_t WS_HA = 112 * MiB;
constexpr size_t WS_SLOT = WS_HA + 2 * MiB;
constexpr size_t WS_GFR = WS_HA + 8 * MiB;
constexpr size_t WS_MIX = 240 * MiB;
constexpr size_t WS_BIG = 368 * MiB;
constexpr size_t WS_PBUF = WS_BIG;
constexpr size_t WS_YB2 = WS_BIG + 288 * MiB;
constexpr size_t WS_XM = WS_BIG;
constexpr size_t WS_XC = WS_BIG + 256 * MiB;
constexpr size_t WS_GATES = WS_BIG + 512 * MiB;
constexpr size_t WS_SS = WS_BIG + 514 * MiB;
constexpr size_t WS_ACT = WS_BIG;
constexpr size_t WS_HALO = WS_BIG + 352 * MiB, SZ_HALO = (size_t)(NTOK / 64) * 2 * FF * 4;
constexpr size_t WS_XS = WS_BIG + 520 * MiB;
constexpr size_t WS_END = WS_XS + 128 * MiB;
static_assert(WS_W_DOWN + 4 * SZ_W_DOWN <= WS_HA && WS_HALO + 3 * SZ_HALO <= WS_END && WS_SS + (size_t)NTOK * 16 * 4 <= WS_END, "d_ws map");
constexpr int CW_PAN = 16384;
constexpr int CW_BAR = 4096;

constexpr int RING_BYTES = 131072, LDS_BYTES = 163840, LDSCTL_OFF = LDS_BYTES - 2048, MISC_OFF = LDSCTL_OFF + 320, PTAB_OFF = LDSCTL_OFF + 1024;

#define GAS __attribute__((address_space(1)))
#define LAS __attribute__((address_space(3)))
typedef unsigned short bf16;
typedef float f32x4 __attribute__((ext_vector_type(4)));
typedef unsigned u32x4 __attribute__((ext_vector_type(4)));
typedef unsigned u32x2 __attribute__((ext_vector_type(2)));
#define LDS_WAIT() asm volatile("s_waitcnt lgkmcnt(0)" ::: "memory")
__device__ __forceinline__ unsigned f2bf(float f) { unsigned u = __builtin_bit_cast(unsigned, f); return (u + 0x7fffu + ((u >> 16) & 1u)) >> 16; }
__device__ __forceinline__ unsigned pk2(float lo, float hi) { return pg8::cvt_pk_bf16(lo, hi); }
__device__ __forceinline__ float bflo(unsigned u) { return __uint_as_float(u << 16); }
__device__ __forceinline__ float bfhi(unsigned u) { return __uint_as_float(u & 0xffff0000u); }
__device__ __forceinline__ float bf1(bf16 b) { return __uint_as_float(((unsigned)b) << 16); }
__device__ __forceinline__ unsigned short bf_rne(float x) { return __builtin_bit_cast(unsigned short, (__bf16)x); }
__device__ __forceinline__ void half_pair(float x, float& from_lo, float& from_hi) { const auto sw = __builtin_amdgcn_permlane32_swap(__float_as_uint(x), __float_as_uint(x), false, false); from_lo = __uint_as_float(sw[0]); from_hi = __uint_as_float(sw[1]); }
__device__ __forceinline__ float logsigm_fast(float x) { return fminf(x, 0.f) - __logf(1.0f + __expf(-fabsf(x))); }
__device__ __forceinline__ float row16_sum(float x) { x += dpp_mov<0xB1>(x); x += dpp_mov<0x4E>(x); x += dpp_mov<0x141>(x); x += dpp_mov<0x128>(x); return x; }
__device__ __forceinline__ float wave_scan_sum(float v, int) {
    v += dpp_z<0x111>(v); v += dpp_z<0x112>(v); v += dpp_z<0x114>(v); v += dpp_z<0x118>(v);
    v += dpp_o<0x142, 0xa>(0.f, v); v += dpp_o<0x143, 0xc>(0.f, v); return v; }
__device__ __forceinline__ float wave_scan_max(float v, int) {
    v = fmaxf(v, dpp_o<0x111, 0xf>(v, v)); v = fmaxf(v, dpp_o<0x112, 0xf>(v, v)); v = fmaxf(v, dpp_o<0x114, 0xf>(v, v)); v = fmaxf(v, dpp_o<0x118, 0xf>(v, v));
    v = fmaxf(v, dpp_o<0x142, 0xa>(v, v)); v = fmaxf(v, dpp_o<0x143, 0xc>(v, v)); return v; }
__device__ __forceinline__ float wave_sum(float v) { v = wave_scan_sum(v, 0); return __uint_as_float(__builtin_amdgcn_readlane(__float_as_uint(v), 63)); }
__device__ __forceinline__ int opaque_int(int v) { asm volatile("" : "+s"(v)); return v; }
__device__ __forceinline__ float sigm(float x) { return __builtin_amdgcn_rcpf(1.0f + __expf(-x)); }
__device__ __forceinline__ float logsigm(float x) { return fminf(x, 0.f) - log1pf(expf(-fabsf(x))); }
__device__ __forceinline__ float gelu_t(float x) { const float t = 1.5957691216057308f * (x + 0.044715f * x * x * x); return x * __builtin_amdgcn_rcpf(1.0f + __expf(-t)); }

#define XB_TMO      128
#define XB_XCNT(j)  (256  + 64 * (j))
#define XB_XSUB(j)  (1280 + 64 * (j))
#define XB_XGEN(j)  (2304 + 64 * (j))
#define XB_TOP      3328
#define XB_TOPGEN   3392
#define XCD_BAR_WORDS 3456
#define XB_SPIN_CAP (1u << 20)
__device__ __forceinline__ unsigned xb_ld(unsigned* p)              { return __hip_atomic_load(p, __ATOMIC_RELAXED, __HIP_MEMORY_SCOPE_AGENT); }
__device__ __forceinline__ unsigned xb_add(unsigned* p, unsigned v) { return __hip_atomic_fetch_add(p, v, __ATOMIC_RELAXED, __HIP_MEMORY_SCOPE_AGENT); }
__device__ __forceinline__ unsigned xb_xcc_id() { return (unsigned)__builtin_amdgcn_s_getreg((3 << 11) | 20) & 0xFu; }
#define XB_SPIN(cond, bar) do { unsigned _sp = 0; while (cond) { __builtin_amdgcn_s_sleep(1); \
    if ((++_sp & 255u) == 0u) { if (xb_ld(&(bar)[XB_TMO])) break; if (_sp > XB_SPIN_CAP) { atomicAdd(&(bar)[XB_TMO], 1u); break; } } } } while (0)
struct XcdBarrier { unsigned* bar; unsigned x; volatile LAS unsigned* st; };
__device__ __forceinline__ XcdBarrier xcd_barrier_post(unsigned* bar, volatile LAS unsigned* st) {
    XcdBarrier b; b.bar = bar; b.x = xb_xcc_id(); b.st = st;
    if (threadIdx.x == 0) (void)xb_add(&bar[XB_XCNT(b.x)], 1u);
    return b;
}
__device__ __forceinline__ void xcd_barrier_complete(unsigned* bar, unsigned x, unsigned& nloc, unsigned& nx) {
    const unsigned G = gridDim.x * gridDim.y * gridDim.z;
    unsigned sum, cnt, mine, sp = 0u;
    for (;;) {
        sum = 0u; cnt = 0u; mine = 0u;
#pragma unroll
        for (unsigned j = 0; j < 16; ++j) { const unsigned c = xb_ld(&bar[XB_XCNT(j)]); sum += c; cnt += (c > 0u) ? 1u : 0u; mine = (j == x) ? c : mine; }
        if (sum == G) break;
        __builtin_amdgcn_s_sleep(1);
        if ((++sp & 255u) == 0u) { if (xb_ld(&bar[XB_TMO])) break; if (sp > XB_SPIN_CAP) { atomicAdd(&bar[XB_TMO], 1u); break; } }
    }
    nloc = mine > 0u ? mine : 1u; nx = cnt > 0u ? cnt : 1u;
}
__device__ __forceinline__ void xcd_barrier(const XcdBarrier& b) {
    asm volatile("s_waitcnt vmcnt(0)" ::: "memory");
    __syncthreads();
    if (threadIdx.x == 0) {
        unsigned* bar = b.bar;
        __builtin_amdgcn_s_waitcnt(0);
        unsigned nloc = b.st[0], nx = b.st[1];
        if (nloc == 0u) { xcd_barrier_complete(bar, b.x, nloc, nx); b.st[0] = nloc; b.st[1] = nx; }
        const unsigned old = xb_add(&bar[XB_XSUB(b.x)], 1u);
        const unsigned gen = old / nloc;
        if (old + 1u == (gen + 1u) * nloc) {
            __builtin_amdgcn_fence(__ATOMIC_RELEASE, "agent");
            asm volatile("s_waitcnt vmcnt(0)" ::: "memory");
            const unsigned og = xb_add(&bar[XB_TOP], 1u);
            const unsigned tg = og / nx;
            if (og + 1u == (tg + 1u) * nx) xb_add(&bar[XB_TOPGEN], 1u);
            else XB_SPIN(xb_ld(&bar[XB_TOPGEN]) == tg, bar);
            __builtin_amdgcn_fence(__ATOMIC_ACQUIRE, "agent");
            xb_add(&bar[XB_XGEN(b.x)], 1u);
            asm volatile("s_waitcnt vmcnt(0)" ::: "memory");
        } else {
            XB_SPIN(xb_ld(&bar[XB_XGEN(b.x)]) == gen, bar);
            __builtin_amdgcn_fence(__ATOMIC_ACQUIRE, "agent");
            asm volatile("s_waitcnt vmcnt(0)" ::: "memory");
        }
    }
    __syncthreads();
}

struct Args { const float* in[35]; float* out; unsigned char* ws; int ph_lo, ph_hi; };
struct Ctx { const LAS unsigned long long* tab; unsigned char* ws;
    __device__ __forceinline__ const float* in(int i) const { const unsigned long long v = tab[i];
        const unsigned lo = __builtin_amdgcn_readfirstlane((unsigned)v), hi = __builtin_amdgcn_readfirstlane((unsigned)(v >> 32));
        return (const float*)(((unsigned long long)hi << 32) | lo); } };
enum { I_X = 0, I_LN_MIX_PRE, I_LN_MIX_POST, I_LN_FFN_PRE, I_LN_FFN_POST, I_EV_W_IN, I_S5_LRE, I_S5_LIM, I_S5_BRE, I_S5_BIM, I_S5_CRE, I_S5_CIM, I_S5_D, I_S5_LOGDT, I_S5_WGLU, I_S5_BGLU,
       I_GLA_WUP, I_GLA_BALPHA, I_GLA_NORM, I_EV_W_OUT, I_OD_W_IN, I_ML_CONV_W, I_ML_CONV_B, I_ML_WQ, I_ML_WK, I_ML_WV, I_ML_WGATE, I_ML_BGATE, I_ML_NORM, I_ML_SKIP, I_OD_W_OUT,
       I_FFN_W_UP, I_FFN_CONV_W, I_FFN_CONV_B, I_FFN_W_DOWN };

__device__ __forceinline__ void transpose_item(const float* W, int K, int ldw, int sc0, int nvalid, bf16* WT, int n0, int k0, LAS float* scr, int lane, const float* gk = nullptr) {
    { const int c4 = lane & 7, rsub = lane >> 3;
      f32x4 v[8]; float gsc[8];
#pragma unroll
      for (int i = 0; i < 8; ++i) { const int kk = 8 * i + rsub; gsc[i] = gk ? gk[k0 + kk] : 1.0f;
          v[i] = (4 * c4 < nvalid) ? *(const f32x4*)(W + (size_t)(k0 + kk) * ldw + sc0 + 4 * c4) : (f32x4){0.f, 0.f, 0.f, 0.f}; }
#pragma unroll
      for (int i = 0; i < 8; ++i) { const int kk = 8 * i + rsub; LAS float* d = scr + kk * 33 + 4 * c4; const f32x4 t = v[i] * gsc[i]; d[0] = t[0]; d[1] = t[1]; d[2] = t[2]; d[3] = t[3]; } }
    LDS_WAIT(); asm volatile("" ::: "memory");
    const int c8 = lane & 7;
#pragma unroll
    for (int j = 0; j < 4; ++j) { const int n = (lane >> 3) + 8 * j; const LAS float* s = scr + (8 * c8) * 33 + n;
        u32x4 o; o.x = pk2(s[0 * 33], s[1 * 33]); o.y = pk2(s[2 * 33], s[3 * 33]); o.z = pk2(s[4 * 33], s[5 * 33]); o.w = pk2(s[6 * 33], s[7 * 33]);
        *(u32x4*)(WT + (size_t)(n0 + n) * K + k0 + 8 * c8) = o; }
    LDS_WAIT(); asm volatile("" ::: "memory");
}
__device__ __forceinline__ void prologue_weights(const Ctx& a, LAS unsigned char* lds, int gw, int NGW, int wave, int lane) {
    LAS float* scr = (LAS float*)(lds + wave * 16384);
    unsigned char* ws = a.ws;
    constexpr int I_EVIN = (D / 64) * (EPAD / 32), I_GLU = (512 / 64) * (512 / 32), I_EVOUT = (D / 64) * (D / 32), I_ODIN = (D / 64) * (2 * MI / 32), I_ODOUT = (MI / 64) * (D / 32),
                  I_UP = (D / 64) * (2 * FF / 32), I_DOWN = (FF / 64) * (D / 32);
    constexpr int NITEMS = 2 * (I_EVIN + I_GLU + I_EVOUT + I_ODIN + I_ODOUT) + 4 * (I_UP + I_DOWN);
    for (int it = gw; it < NITEMS; it += NGW) {
        int r = it;
        if (r < 2 * I_EVIN) { const int e = r / I_EVIN; r %= I_EVIN; const int nb = r % (EPAD / 32), kb = r / (EPAD / 32), n0 = nb * 32; int nv = EPROJ - n0; nv = nv < 0 ? 0 : (nv > 32 ? 32 : nv);
            transpose_item(a.in(I_EV_W_IN) + (size_t)e * D * EPROJ, D, EPROJ, n0, nv, (bf16*)(ws + WS_W_EVIN + e * SZ_W_EVIN), n0, kb * 64, scr, lane, a.in(I_LN_MIX_PRE) + (2 * e) * D); continue; } r -= 2 * I_EVIN;
        if (r < 2 * I_GLU) { const int e = r / I_GLU; r %= I_GLU; const int nb = r % 16, kb = r / 16;
            transpose_item(a.in(I_S5_WGLU) + (size_t)e * 512 * 512, 512, 512, nb * 32, 32, (bf16*)(ws + WS_W_GLU + e * SZ_W_GLU), nb * 32, kb * 64, scr, lane); continue; } r -= 2 * I_GLU;
        if (r < 2 * I_EVOUT) { const int e = r / I_EVOUT; r %= I_EVOUT; const int nb = r % 32, kb = r / 32;
            transpose_item(a.in(I_EV_W_OUT) + (size_t)e * D * D, D, D, nb * 32, 32, (bf16*)(ws + WS_W_EVOUT + e * SZ_W_EVOUT), nb * 32, kb * 64, scr, lane); continue; } r -= 2 * I_EVOUT;
        if (r < 2 * I_ODIN) { const int e = r / I_ODIN; r %= I_ODIN; const int nb = r % 128, kb = r / 128;
            transpose_item(a.in(I_OD_W_IN) + (size_t)e * D * 2 * MI, D, 2 * MI, nb * 32, 32, (bf16*)(ws + WS_W_ODIN + e * SZ_W_ODIN), nb * 32, kb * 64, scr, lane, a.in(I_LN_MIX_PRE) + (2 * e + 1) * D); continue; } r -= 2 * I_ODIN;
        if (r < 2 * I_ODOUT) { const int e = r / I_ODOUT; r %= I_ODOUT; const int nb = r % 32, kb = r / 32;
            transpose_item(a.in(I_OD_W_OUT) + (size_t)e * MI * D, MI, D, nb * 32, 32, (bf16*)(ws + WS_W_ODOUT + e * SZ_W_ODOUT), nb * 32, kb * 64, scr, lane); continue; } r -= 2 * I_ODOUT;
        if (r < 4 * I_UP) { const int l = r / I_UP; r %= I_UP; const int nb = r % 176, kb = r / 176, n0 = nb * 32;
            const int pn = n0 >> 8, half = (n0 >> 7) & 1, c = n0 & 127, sc0 = half * FF + pn * 128 + c;
            transpose_item(a.in(I_FFN_W_UP) + (size_t)l * D * 2 * FF, D, 2 * FF, sc0, 32, (bf16*)(ws + WS_W_UP + l * SZ_W_UP), n0, kb * 64, scr, lane, a.in(I_LN_FFN_PRE) + l * D); continue; } r -= 4 * I_UP;
        { const int l = r / I_DOWN; r %= I_DOWN; const int nb = r % 32, kb = r / 32;
            transpose_item(a.in(I_FFN_W_DOWN) + (size_t)l * FF * D, FF, D, nb * 32, 32, (bf16*)(ws + WS_W_DOWN + l * SZ_W_DOWN), nb * 32, kb * 64, scr, lane); }
    }
}

template <int XIN, int XOUT>
__device__ __forceinline__ void norm_phase(const bf16* mix, const float* gpost, const void* xin, void* xout, float* rs_out, int gw, int NGW, int lane) {
    f32x4 nv[4]; u32x2 nb[4], nm[4];
    f32x4 gp4[4];
#pragma unroll
    for (int j = 0; j < 4; ++j) gp4[j] = mix ? *((const f32x4*)gpost + lane + 64 * j) : (f32x4){0.f, 0.f, 0.f, 0.f};
    auto load_row = [&](int row) {
        if (XIN == 0) { const f32x4* xr = (const f32x4*)((const float*)xin + (size_t)row * D) + lane;
#pragma unroll
            for (int j = 0; j < 4; ++j) nv[j] = xr[64 * j]; }
        else { const u32x2* xr = (const u32x2*)((const bf16*)xin + (size_t)row * D) + lane;
#pragma unroll
            for (int j = 0; j < 4; ++j) nb[j] = xr[64 * j]; }
        if (mix) { const u32x2* mr = (const u32x2*)(mix + (size_t)row * D) + lane;
#pragma unroll
            for (int j = 0; j < 4; ++j) nm[j] = mr[64 * j]; } };
    load_row(gw < NTOK ? gw : 0);
    for (int row = gw; row < NTOK; row += NGW) {
        f32x4 v[4]; u32x2 mraw[4];
#pragma unroll
        for (int j = 0; j < 4; ++j) { v[j] = (XIN == 0) ? nv[j] : (f32x4){bflo(nb[j].x), bfhi(nb[j].x), bflo(nb[j].y), bfhi(nb[j].y)}; mraw[j] = nm[j]; }
        load_row((row + NGW < NTOK) ? row + NGW : row);
        if (mix) {
            f32x4 mv[4]; float s = 0.f;
#pragma unroll
            for (int j = 0; j < 4; ++j) { const u32x2 t = mraw[j]; mv[j] = (f32x4){bflo(t.x), bfhi(t.x), bflo(t.y), bfhi(t.y)}; s += (mv[j].x * mv[j].x + mv[j].y * mv[j].y) + (mv[j].z * mv[j].z + mv[j].w * mv[j].w); }
            const float rstd = rsqrtf(wave_sum(s) * (1.f / D) + EPS);
#pragma unroll
            for (int j = 0; j < 4; ++j) v[j] = v[j] + mv[j] * rstd * gp4[j];
        }
        if (XOUT == 0) { f32x4* xo = (f32x4*)((float*)xout + (size_t)row * D) + lane;
#pragma unroll
            for (int j = 0; j < 4; ++j) xo[64 * j] = v[j]; }
        else { u32x2* xo = (u32x2*)((bf16*)xout + (size_t)row * D) + lane;
#pragma unroll
            for (int j = 0; j < 4; ++j) { u32x2 o; o.x = pk2(v[j].x, v[j].y); o.y = pk2(v[j].z, v[j].w); xo[64 * j] = o; } }
        if (rs_out) {
            float s2 = 0.f;
#pragma unroll
            for (int j = 0; j < 4; ++j) s2 += (v[j].x * v[j].x + v[j].y * v[j].y) + (v[j].z * v[j].z + v[j].w * v[j].w);
            const float t2 = wave_sum(s2);
            if (lane == 0) *(f32x4*)(rs_out + 4 * (size_t)row) = (f32x4){t2, 0.f, 0.f, 0.f};
        }
    }
}

__device__ __forceinline__ void s5_unit_simple(const Ctx& a, int e, bf16* pbuf, bf16* yout, int ypitch, LAS unsigned char* lds, int wgS, int tid, int wave, int lane) {
    const int g = wgS & 31, b = (wgS >> 5) * 8 + wave, eg = e * S5G + g;
    LAS float* Cc = (LAS float*)lds;
    LAS float* X = (LAS float*)(lds + 16 * 132 * 4) + wave * (16 * 132);
    { const float* cre = a.in(I_S5_CRE) + (size_t)eg * 16 * 64; const float* cim = a.in(I_S5_CIM) + (size_t)eg * 16 * 64;
      for (int idx = tid; idx < 2048; idx += NTHREADS) { const int i = idx >> 7, c = idx & 127; Cc[i * 132 + c] = (c < 64) ? cre[i * 64 + c] : -cim[i * 64 + c - 64]; } }
    const int p = lane;
    const float dt = expf(a.in(I_S5_LOGDT)[eg]);
    const float lr = a.in(I_S5_LRE)[eg * 64 + p], li = a.in(I_S5_LIM)[eg * 64 + p];
    const float mag = expf(lr * dt), lbr = mag * cosf(li * dt), lbi = mag * sinf(li * dt);
    const float inv = 1.0f / (lr * lr + li * li);
    const float zr = ((lbr - 1.0f) * lr + lbi * li) * inv, zi = (lbi * lr - (lbr - 1.0f) * li) * inv;
    float bbr[16], bbi[16];
    { const float* bre = a.in(I_S5_BRE) + ((size_t)eg * 64 + p) * 16; const float* bim = a.in(I_S5_BIM) + ((size_t)eg * 64 + p) * 16;
#pragma unroll
      for (int i = 0; i < 16; ++i) { const float br = bre[i], bi = bim[i]; bbr[i] = zr * br - zi * bi; bbi[i] = zr * bi + zi * br; } }
    const int tt2 = lane >> 2, i0 = (lane & 3) * 4;
    const f32x4 dsk = *(const f32x4*)(a.in(I_S5_D) + eg * 16 + i0);
    __syncthreads();
    float xr = 0.f, xi = 0.f;
    for (int blk = 0; blk < SEQ / 64; ++blk) {
        const size_t tok0 = (size_t)b * SEQ + blk * 64;
        float uf[16];
        { const u32x4* up = (const u32x4*)(pbuf + (tok0 + lane) * EPAD + PC_U + g * 16); const u32x4 u0 = up[0], u1 = up[1];
          uf[0] = bflo(u0.x); uf[1] = bfhi(u0.x); uf[2] = bflo(u0.y); uf[3] = bfhi(u0.y); uf[4] = bflo(u0.z); uf[5] = bfhi(u0.z); uf[6] = bflo(u0.w); uf[7] = bfhi(u0.w);
          uf[8] = bflo(u1.x); uf[9] = bfhi(u1.x); uf[10] = bflo(u1.y); uf[11] = bfhi(u1.y); uf[12] = bflo(u1.z); uf[13] = bfhi(u1.z); uf[14] = bflo(u1.w); uf[15] = bfhi(u1.w); }
        for (int sb = 0; sb < 4; ++sb) {
            for (int tt = 0; tt < 16; ++tt) {
                const int t = sb * 16 + tt;
                float br = 0.f, bi = 0.f;
#pragma unroll
                for (int i = 0; i < 16; ++i) { const float s = __uint_as_float(__builtin_amdgcn_readlane(__float_as_uint(uf[i]), t)); br = fmaf(bbr[i], s, br); bi = fmaf(bbi[i], s, bi); }
                const float nxr = lbr * xr - lbi * xi + br, nxi = lbr * xi + lbi * xr + bi;
                xr = nxr; xi = nxi;
                X[tt * 132 + p] = xr; X[tt * 132 + 64 + p] = xi;
            }
            LDS_WAIT(); asm volatile("" ::: "memory");
            float y0 = 0.f, y1 = 0.f, y2 = 0.f, y3 = 0.f;
#pragma unroll 8
            for (int c4 = 0; c4 < 32; ++c4) {
                const f32x4 xv = *(const LAS f32x4*)(X + tt2 * 132 + 4 * c4);
                const f32x4 c0 = *(const LAS f32x4*)(Cc + (i0 + 0) * 132 + 4 * c4), c1 = *(const LAS f32x4*)(Cc + (i0 + 1) * 132 + 4 * c4);
                const f32x4 c2 = *(const LAS f32x4*)(Cc + (i0 + 2) * 132 + 4 * c4), c3 = *(const LAS f32x4*)(Cc + (i0 + 3) * 132 + 4 * c4);
                y0 += (xv.x * c0.x + xv.y * c0.y) + (xv.z * c0.z + xv.w * c0.w); y1 += (xv.x * c1.x + xv.y * c1.y) + (xv.z * c1.z + xv.w * c1.w);
                y2 += (xv.x * c2.x + xv.y * c2.y) + (xv.z * c2.z + xv.w * c2.w); y3 += (xv.x * c3.x + xv.y * c3.y) + (xv.z * c3.z + xv.w * c3.w);
            }
            { const bf16* up2 = pbuf + (tok0 + sb * 16 + tt2) * EPAD + PC_U + g * 16 + i0; const u32x2 uu = *(const u32x2*)up2; bf16* yp = yout + (tok0 + sb * 16 + tt2) * ypitch + g * 16 + i0;
              y0 += dsk.x * bflo(uu.x); y1 += dsk.y * bfhi(uu.x); y2 += dsk.z * bflo(uu.y); y3 += dsk.w * bfhi(uu.y);
              u32x2 o; o.x = pk2(gelu_t(y0), gelu_t(y1)); o.y = pk2(gelu_t(y2), gelu_t(y3)); *(u32x2*)yp = o; }
            LDS_WAIT(); asm volatile("" ::: "memory");
        }
    }
}

__device__ __forceinline__ void gla_unit_simple(const Ctx& a, int e_, const bf16* pbuf, bf16* yb2, LAS unsigned char* lds, int unit, int tid, int wave, int lane) {
    const int b = unit >> 2, h = unit & 3;
    LAS float* WUP = (LAS float*)lds;
    LAS float* Qs = WUP + 16 * 64;
    LAS float* Ks = Qs + 16 * 64;
    LAS float* As = Ks + 16 * 64;
    LAS float* Vs = As + 16 * 64;
    LAS float* Rs = Vs + 16 * 128;
    LAS float* OP = Rs + 16 * 128;
    { const float* wup = a.in(I_GLA_WUP) + (size_t)e_ * 16 * 256; for (int idx = tid; idx < 1024; idx += NTHREADS) { const int j = idx >> 6, d = idx & 63; WUP[idx] = wup[j * 256 + h * 64 + d]; } }
    const int e = tid & 127, dq = tid >> 7;
    const int st = tid >> 5, sl = tid & 31;
    const float ba0 = a.in(I_GLA_BALPHA)[e_ * 256 + h * 64 + 2 * sl], ba1 = a.in(I_GLA_BALPHA)[e_ * 256 + h * 64 + 2 * sl + 1];
    const int ft = tid >> 5, fe = (tid & 31) * 4;
    const f32x4 gnv = *(const f32x4*)(a.in(I_GLA_NORM) + e_ * 512 + h * 128 + fe);
    float S[16];
#pragma unroll
    for (int i = 0; i < 16; ++i) S[i] = 0.f;
    __syncthreads();
    for (int blk = 0; blk < SEQ / 16; ++blk) {
        const size_t tok0 = (size_t)b * SEQ + blk * 16;
        { const bf16* row = pbuf + (tok0 + st) * EPAD;
          const unsigned qq = *(const unsigned*)(row + PC_Q + h * 64 + 2 * sl), kk = *(const unsigned*)(row + PC_K + h * 64 + 2 * sl);
          const u32x2 vv = *(const u32x2*)(row + PC_V + h * 128 + 4 * sl), rr = *(const u32x2*)(row + PC_R + h * 128 + 4 * sl);
          const u32x4 a0 = *(const u32x4*)(row + PC_A), a1 = *(const u32x4*)(row + PC_A + 8);
          float al[16]; al[0] = bflo(a0.x); al[1] = bfhi(a0.x); al[2] = bflo(a0.y); al[3] = bfhi(a0.y); al[4] = bflo(a0.z); al[5] = bfhi(a0.z); al[6] = bflo(a0.w); al[7] = bfhi(a0.w);
          al[8] = bflo(a1.x); al[9] = bfhi(a1.x); al[10] = bflo(a1.y); al[11] = bfhi(a1.y); al[12] = bflo(a1.z); al[13] = bfhi(a1.z); al[14] = bflo(a1.w); al[15] = bfhi(a1.w);
          float z0 = ba0, z1 = ba1;
#pragma unroll
          for (int j = 0; j < 16; ++j) { z0 = fmaf(al[j], WUP[j * 64 + 2 * sl], z0); z1 = fmaf(al[j], WUP[j * 64 + 2 * sl + 1], z1); }
          Qs[st * 64 + 2 * sl] = bflo(qq) * 0.125f; Qs[st * 64 + 2 * sl + 1] = bfhi(qq) * 0.125f;
          Ks[st * 64 + 2 * sl] = bflo(kk); Ks[st * 64 + 2 * sl + 1] = bfhi(kk);
          As[st * 64 + 2 * sl] = expf(logsigm(z0) * (1.0f / 16.0f)); As[st * 64 + 2 * sl + 1] = expf(logsigm(z1) * (1.0f / 16.0f));
          *(LAS f32x4*)(Vs + st * 128 + 4 * sl) = (f32x4){bflo(vv.x), bfhi(vv.x), bflo(vv.y), bfhi(vv.y)};
          *(LAS f32x4*)(Rs + st * 128 + 4 * sl) = (f32x4){bflo(rr.x), bfhi(rr.x), bflo(rr.y), bfhi(rr.y)}; }
        __syncthreads();
        for (int t = 0; t < 16; ++t) {
            const float v = Vs[t * 128 + e]; float o = 0.f;
#pragma unroll
            for (int d4 = 0; d4 < 4; ++d4) {
                const f32x4 av = *(const LAS f32x4*)(As + t * 64 + dq * 16 + 4 * d4), kv = *(const LAS f32x4*)(Ks + t * 64 + dq * 16 + 4 * d4), qv = *(const LAS f32x4*)(Qs + t * 64 + dq * 16 + 4 * d4);
                S[4 * d4 + 0] = av.x * S[4 * d4 + 0] + kv.x * v; o = fmaf(qv.x, S[4 * d4 + 0], o);
                S[4 * d4 + 1] = av.y * S[4 * d4 + 1] + kv.y * v; o = fmaf(qv.y, S[4 * d4 + 1], o);
                S[4 * d4 + 2] = av.z * S[4 * d4 + 2] + kv.z * v; o = fmaf(qv.z, S[4 * d4 + 2], o);
                S[4 * d4 + 3] = av.w * S[4 * d4 + 3] + kv.w * v; o = fmaf(qv.w, S[4 * d4 + 3], o);
            }
            OP[(dq * 16 + t) * 128 + e] = o;
        }
        __syncthreads();
        { f32x4 o = *(const LAS f32x4*)(OP + (0 * 16 + ft) * 128 + fe);
          o = o + *(const LAS f32x4*)(OP + (1 * 16 + ft) * 128 + fe); o = o + *(const LAS f32x4*)(OP + (2 * 16 + ft) * 128 + fe); o = o + *(const LAS f32x4*)(OP + (3 * 16 + ft) * 128 + fe);
          float s = (o.x * o.x + o.y * o.y) + (o.z * o.z + o.w * o.w);
#pragma unroll
          for (int off = 1; off < 32; off <<= 1) s += __shfl_xor(s, off);
          const float rstd = rsqrtf(s * (1.0f / 128.0f) + EPS);
          const f32x4 r = *(const LAS f32x4*)(Rs + ft * 128 + fe);
          const f32x4 res = o * rstd * gnv * (f32x4){r.x * sigm(r.x), r.y * sigm(r.y), r.z * sigm(r.z), r.w * sigm(r.w)};
          u32x2 w; w.x = pk2(res.x, res.y); w.y = pk2(res.z, res.w);
          *(u32x2*)(yb2 + (tok0 + ft) * D + 512 + h * 128 + fe) = w; }
        __syncthreads();
    }
}

typedef short pp_bf16x8 __attribute__((ext_vector_type(8)));
__device__ __forceinline__ void prepass_frag_table(const Ctx& a, int gtid, int gthreads) {
    u32x4* gt = (u32x4*)(a.ws + WS_GFR);
    for (int i = gtid; i < 2 * 8 * 8 * 64; i += gthreads) {
        const int lane = i & 63, s8 = (i >> 6) & 7, w = (i >> 9) & 7, o_ = i >> 12;
        const int gn = lane & 7, q = lane >> 4; const float gon = ((lane & 15) < 8) ? 1.0f : 0.0f;
        const float* WG = a.in(I_ML_WGATE) + (size_t)o_ * 3 * MI * 8;
        unsigned wc_[4], wm_[4];
#pragma unroll
        for (int bb = 0; bb < 2; ++bb) {
            const int blk = 64 * w + 8 * s8 + 2 * q + bb;
            float g0[4], g1[4], g2[4];
#pragma unroll
            for (int d = 0; d < 4; ++d) { g0[d] = WG[((size_t)0 * MI + 4 * blk + d) * 8 + gn] * gon; g1[d] = WG[((size_t)1 * MI + 4 * blk + d) * 8 + gn] * gon; g2[d] = WG[((size_t)2 * MI + 4 * blk + d) * 8 + gn] * gon; }
            float vc[4], vm[4];
#pragma unroll
            for (int c = 0; c < 4; ++c) {
                const f32x4 wq = *(const f32x4*)(a.in(I_ML_WQ) + ((size_t)o_ * 512 + blk) * 16 + 4 * c), wk = *(const f32x4*)(a.in(I_ML_WK) + ((size_t)o_ * 512 + blk) * 16 + 4 * c),
                            wv = *(const f32x4*)(a.in(I_ML_WV) + ((size_t)o_ * 512 + blk) * 16 + 4 * c);
                float sc = 0.f, sm = 0.f;
#pragma unroll
                for (int d = 0; d < 4; ++d) { sc = fmaf(wq[d], g0[d], sc); sc = fmaf(wk[d], g1[d], sc); sm = fmaf(wv[d], g2[d], sm); }
                vc[c] = sc; vm[c] = sm; }
            wc_[2 * bb] = pk2(vc[0], vc[1]); wc_[2 * bb + 1] = pk2(vc[2], vc[3]); wm_[2 * bb] = pk2(vm[0], vm[1]); wm_[2 * bb + 1] = pk2(vm[2], vm[3]);
        }
        gt[((size_t)(o_ * 8 + w) * 16 + s8) * 64 + lane] = (u32x4){wc_[0], wc_[1], wc_[2], wc_[3]};
        gt[((size_t)(o_ * 8 + w) * 16 + 8 + s8) * 64 + lane] = (u32x4){wm_[0], wm_[1], wm_[2], wm_[3]};
    }
}
constexpr int PP_TP = 1040;
__device__ __forceinline__ void mlstm_prepass(const Ctx& a, int o_, const bf16* xm, bf16* xc, float* gates, LAS unsigned char* lds, int wg, int nwg, int tid, int wave, int lane) {
    LAS float* P = (LAS float*)lds;
    LAS unsigned char* T = lds + 16384 + wave * (16 * PP_TP);
    const int n = tid;
    f32x4 cw[4], cb;
#pragma unroll
    for (int k = 0; k < 4; ++k) cw[k] = *(const f32x4*)(a.in(I_ML_CONV_W) + ((size_t)o_ * 4 + k) * MI + 4 * n);
    cb = *(const f32x4*)(a.in(I_ML_CONV_B) + (size_t)o_ * MI + 4 * n);
    pp_bf16x8 gfr[16];
    { const u32x4* gt = (const u32x4*)(a.ws + WS_GFR) + ((size_t)(o_ * 8 + wave) * 16) * 64 + lane;
#pragma unroll
      for (int s = 0; s < 16; ++s) gfr[s] = __builtin_bit_cast(pp_bf16x8, gt[64 * s]); }
    for (int chunk = wg; chunk < NTOK / 256; chunk += nwg) {
        const size_t tokc = (size_t)chunk * 256;
        const int tpos0 = (int)(tokc % SEQ);
        f32x4 x0 = (f32x4){0.f, 0.f, 0.f, 0.f}, x1 = x0, x2 = x0;
        if (tpos0 > 0) {
            const u32x2 r0 = *(const u32x2*)(xm + (tokc - 3) * MI + 4 * n), r1 = *(const u32x2*)(xm + (tokc - 2) * MI + 4 * n), r2 = *(const u32x2*)(xm + (tokc - 1) * MI + 4 * n);
            x0 = (f32x4){bflo(r0.x), bfhi(r0.x), bflo(r0.y), bfhi(r0.y)}; x1 = (f32x4){bflo(r1.x), bfhi(r1.x), bflo(r1.y), bfhi(r1.y)}; x2 = (f32x4){bflo(r2.x), bfhi(r2.x), bflo(r2.y), bfhi(r2.y)};
        }
        u32x2 nxt[8];
#pragma unroll
        for (int j = 0; j < 8; ++j) nxt[j] = *(const u32x2*)(xm + (tokc + j) * MI + 4 * n);
        for (int sub = 0; sub < 4; ++sub) {
            for (int grp = 0; grp < 8; ++grp) {
                u32x2 cur[8];
#pragma unroll
                for (int j = 0; j < 8; ++j) cur[j] = nxt[j];
                { const size_t tn = tokc + sub * 64 + grp * 8 + 8; const size_t tnc = (tn + 8 <= tokc + 256) ? tn : tokc;
#pragma unroll
                  for (int j = 0; j < 8; ++j) nxt[j] = *(const u32x2*)(xm + (tnc + j) * MI + 4 * n); }
#pragma unroll
                for (int j8 = 0; j8 < 8; ++j8) {
                    const size_t tok = tokc + sub * 64 + grp * 8 + j8;
                    const u32x2 r3 = cur[j8];
                    const f32x4 x3 = (f32x4){bflo(r3.x), bfhi(r3.x), bflo(r3.y), bfhi(r3.y)};
                    f32x4 cv = cb + cw[0] * x0 + cw[1] * x1 + cw[2] * x2 + cw[3] * x3;
                    const f32x4 xcv = (f32x4){cv.x * sigm(cv.x), cv.y * sigm(cv.y), cv.z * sigm(cv.z), cv.w * sigm(cv.w)};
                    u32x2 w; w.x = pk2(xcv.x, xcv.y); w.y = pk2(xcv.z, xcv.w);
                    *(u32x2*)(xc + tok * MI + 4 * n) = w;
                    LAS unsigned char* trow = T + ((grp & 1) * 8 + j8) * PP_TP + 8 * lane;
                    *(LAS u32x2*)trow = w; *(LAS u32x2*)(trow + 512) = r3;
                    x0 = x1; x1 = x2; x2 = x3;
                }
                if (grp & 1) {
                    asm volatile("s_waitcnt lgkmcnt(0)" ::: "memory");
                    f32x4 d0 = (f32x4){0.f, 0.f, 0.f, 0.f}, d1 = d0;
                    const LAS unsigned char* arow = T + (lane & 15) * PP_TP + (lane >> 4) * 16;
#pragma unroll
                    for (int s = 0; s < 16; s += 2) {
                        const pp_bf16x8 a0 = *(const LAS pp_bf16x8*)(arow + (s >> 3) * 512 + (s & 7) * 64), a1 = *(const LAS pp_bf16x8*)(arow + ((s + 1) >> 3) * 512 + ((s + 1) & 7) * 64);
                        d0 = __builtin_amdgcn_mfma_f32_16x16x32_bf16(a0, gfr[s], d0, 0, 0, 0); d1 = __builtin_amdgcn_mfma_f32_16x16x32_bf16(a1, gfr[s + 1], d1, 0, 0, 0); }
                    d0 = d0 + d1;
                    if ((lane & 15) < 8) {
#pragma unroll
                        for (int r = 0; r < 4; ++r) P[(wave * 64 + (grp >> 1) * 16 + 4 * (lane >> 4) + r) * 8 + (lane & 15)] = d0[r]; }
                    asm volatile("" ::: "memory");
                }
            }
            __syncthreads();
            { const int tl = tid >> 3, g8 = tid & 7; float s = a.in(I_ML_BGATE)[o_ * 8 + g8];
#pragma unroll
              for (int w = 0; w < 8; ++w) s += P[(w * 64 + tl) * 8 + g8];
              if (g8 >= 4) s = logsigm(s);
              gates[(tokc + sub * 64 + tl) * 8 + g8] = s; }
            __syncthreads();
        }
    }
}

__device__ __forceinline__ void mlstm_unit_simple(const Ctx& a, int o_, bf16* xm, const bf16* xc, const float* gates, float* SS, LAS unsigned char* lds, int unit, int tid, int wave, int lane) {
    const int es = unit & 3, h = (unit >> 2) & 3, b = unit >> 4;
    LAS float* Qs = (LAS float*)lds;
    LAS float* Ks = Qs + 8 * 512;
    LAS float* Vs = Ks + 8 * 512;
    LAS float* HP = Vs + 8 * 128;
    LAS float* NQ = HP + 4 * 8 * 128;
    LAS float* GI = NQ + 64;
    LAS float* GF = GI + 8;
    LAS float* EM = GF + 8;
    const float kscale = 0.04419417382415922f;
    float C[128];
#pragma unroll
    for (int i = 0; i < 128; ++i) C[i] = 0.f;
    float nst = 0.f, mst = 0.f;
    for (int blk = 0; blk < SEQ / 8; ++blk) {
        const size_t tok0 = (size_t)b * SEQ + blk * 8;
        { int t2 = threadIdx.x; asm volatile("" : "+v"(t2));
          const int stt = t2 >> 6, sl = t2 & 63, nv = h * 128 + es * 32 + (sl >> 1), dv = 2 * (sl & 1);
          const size_t tok = tok0 + stt;
          int zoff = 0; asm volatile("" : "+v"(zoff));
          f32x4 wq0[4], wk0[4], wq1[4], wk1[4];
#pragma unroll
          for (int c = 0; c < 4; ++c) {
              wq0[c] = *(const f32x4*)(a.in(I_ML_WQ) + zoff + (((size_t)o_ * 512 + h * 128 + sl) * 4 + c) * 4); wk0[c] = *(const f32x4*)(a.in(I_ML_WK) + zoff + (((size_t)o_ * 512 + h * 128 + sl) * 4 + c) * 4);
              wq1[c] = *(const f32x4*)(a.in(I_ML_WQ) + zoff + (((size_t)o_ * 512 + h * 128 + sl + 64) * 4 + c) * 4); wk1[c] = *(const f32x4*)(a.in(I_ML_WK) + zoff + (((size_t)o_ * 512 + h * 128 + sl + 64) * 4 + c) * 4);
          }
          const u32x2 c0 = *(const u32x2*)(xc + tok * MI + h * 512 + 4 * sl), c1 = *(const u32x2*)(xc + tok * MI + h * 512 + 4 * (sl + 64));
          const f32x4 a0 = (f32x4){bflo(c0.x), bfhi(c0.x), bflo(c0.y), bfhi(c0.y)}, a1 = (f32x4){bflo(c1.x), bfhi(c1.x), bflo(c1.y), bfhi(c1.y)};
          *(LAS f32x4*)(Qs + stt * 512 + 4 * sl) = wq0[0] * a0.x + wq0[1] * a0.y + wq0[2] * a0.z + wq0[3] * a0.w;
          *(LAS f32x4*)(Ks + stt * 512 + 4 * sl) = (wk0[0] * a0.x + wk0[1] * a0.y + wk0[2] * a0.z + wk0[3] * a0.w) * kscale;
          *(LAS f32x4*)(Qs + stt * 512 + 4 * (sl + 64)) = wq1[0] * a1.x + wq1[1] * a1.y + wq1[2] * a1.z + wq1[3] * a1.w;
          *(LAS f32x4*)(Ks + stt * 512 + 4 * (sl + 64)) = (wk1[0] * a1.x + wk1[1] * a1.y + wk1[2] * a1.z + wk1[3] * a1.w) * kscale;
          f32x4 wvb[4];
#pragma unroll
          for (int c = 0; c < 4; ++c) wvb[c] = *(const f32x4*)(a.in(I_ML_WV) + zoff + (((size_t)o_ * 512 + nv) * 4 + c) * 4);
          const u32x2 xr = *(const u32x2*)(xm + tok * MI + 4 * nv);
          const f32x4 xv = (f32x4){bflo(xr.x), bfhi(xr.x), bflo(xr.y), bfhi(xr.y)};
          const f32x4 vv = wvb[0] * xv.x + wvb[1] * xv.y + wvb[2] * xv.z + wvb[3] * xv.w;
          Vs[stt * 128 + 2 * sl] = (dv == 0) ? vv.x : vv.z; Vs[stt * 128 + 2 * sl + 1] = (dv == 0) ? vv.y : vv.w;
          if (t2 < 8) { GI[t2] = gates[(tok0 + t2) * 8 + h]; GF[t2] = gates[(tok0 + t2) * 8 + 4 + h]; } }
        __syncthreads();
        int t3 = threadIdx.x; asm volatile("" : "+v"(t3));
        const int el = t3 & 127, dq = t3 >> 7;
#pragma unroll 1
        for (int t = 0; t < 8; ++t) {
            const float li = GI[t], lf = GF[t];
            const float mnew = fmaxf(lf + mst, li);
            const float fp = __expf(lf + mst - mnew), ip = __expf(li - mnew);
            mst = mnew;
            if (t3 == 0) EM[t] = __expf(-mnew);
            const float ipv = ip * Vs[t * 128 + el];
            float hp = 0.f;
#pragma unroll
            for (int d4 = 0; d4 < 32; ++d4) {
                if ((d4 & 7) == 0) __builtin_amdgcn_sched_barrier(0);
                const f32x4 kv = *(const LAS f32x4*)(Ks + t * 512 + dq * 128 + 4 * d4), qv = *(const LAS f32x4*)(Qs + t * 512 + dq * 128 + 4 * d4);
                C[4 * d4 + 0] = fmaf(fp, C[4 * d4 + 0], ipv * kv.x); hp = fmaf(C[4 * d4 + 0], qv.x, hp);
                C[4 * d4 + 1] = fmaf(fp, C[4 * d4 + 1], ipv * kv.y); hp = fmaf(C[4 * d4 + 1], qv.y, hp);
                C[4 * d4 + 2] = fmaf(fp, C[4 * d4 + 2], ipv * kv.z); hp = fmaf(C[4 * d4 + 2], qv.z, hp);
                C[4 * d4 + 3] = fmaf(fp, C[4 * d4 + 3], ipv * kv.w); hp = fmaf(C[4 * d4 + 3], qv.w, hp);
            }
            HP[(dq * 8 + t) * 128 + el] = hp;
            nst = fmaf(fp, nst, ip * Ks[t * 512 + t3]);
            const float nq = wave_sum(nst * Qs[t * 512 + t3]);
            if ((t3 & 63) == 0) NQ[(t3 >> 6) * 8 + t] = nq;
        }
        __syncthreads();
        { int t4 = threadIdx.x; asm volatile("" : "+v"(t4));
          const int ft = t4 >> 6, fe = (t4 & 63) * 2;
          float den = 0.f;
#pragma unroll
          for (int w = 0; w < 8; ++w) den += NQ[w * 8 + ft];
          const float dn = fmaxf(fabsf(den), EM[ft]);
          float h0 = HP[(0 * 8 + ft) * 128 + fe] + HP[(1 * 8 + ft) * 128 + fe] + HP[(2 * 8 + ft) * 128 + fe] + HP[(3 * 8 + ft) * 128 + fe];
          float h1 = HP[(0 * 8 + ft) * 128 + fe + 1] + HP[(1 * 8 + ft) * 128 + fe + 1] + HP[(2 * 8 + ft) * 128 + fe + 1] + HP[(3 * 8 + ft) * 128 + fe + 1];
          h0 /= dn; h1 /= dn;
          *(unsigned*)(xm + (tok0 + ft) * MI + h * 512 + es * 128 + fe) = pk2(h0, h1);
          const float ssq = wave_sum(h0 * h0 + h1 * h1);
          if ((t4 & 63) == 0) SS[(tok0 + ft) * 16 + h * 4 + es] = ssq; }
        __syncthreads();
    }
}

typedef short bf16x8v __attribute__((ext_vector_type(8)));
typedef short bf16x4v __attribute__((ext_vector_type(4)));
constexpr int ML_WQ = 0, ML_WK = 8192, ML_WV = 16384, ML_N = 18432, ML_QN = 22528, ML_RS = 22784, ML_NROW = 23808  , ML_GA = 25856, ML_GM = 26112, ML_GW = 26368, ML_GE = 26624, ML_RD = 26880, ML_QNL = 27136,
              ML_NP = 29184  , ML_WU = 33280  , ML_B0 = 35328;
constexpr int ML_QP = 272, ML_TP = 144, ML_BSTR = 2 * 64 * ML_QP + 128 * ML_TP, ML_VT = ML_B0 + 2 * ML_BSTR, ML_PS = ML_B0, ML_OT = ML_B0 + ML_BSTR, ML_END = ML_VT + 128 * ML_TP;
#define ML_QS_(b) (ML_B0 + (b) * ML_BSTR)
#define ML_KS_(b) (ML_B0 + (b) * ML_BSTR + 64 * ML_QP)
#define ML_KWT_(b) (ML_B0 + (b) * ML_BSTR + 2 * 64 * ML_QP)
static_assert(ML_END <= LDSCTL_OFF, "mLSTM LDS map");
__device__ __forceinline__ unsigned cvtpk(float lo, float hi) { return pg8::cvt_pk_bf16(lo, hi); }

typedef __bf16 bf16x2c __attribute__((ext_vector_type(2)));
__device__ __forceinline__ unsigned cvtpk_c(float lo, float hi) { const bf16x2c v = {(__bf16)lo, (__bf16)hi}; return __builtin_bit_cast(unsigned, v); }
__device__ __forceinline__ bf16x4v blockdiag_frag(const LAS float* T, int blk0, int l15, int g4) {
    const f32x4 w4 = *(const LAS f32x4*)(T + ((blk0 + g4) * 4 + (l15 & 3)) * 4);
    u32x2 p; p.x = cvtpk(w4[0], w4[1]); p.y = cvtpk(w4[2], w4[3]);
    if (g4 != (l15 >> 2)) { p.x = 0u; p.y = 0u; }
    return __builtin_bit_cast(bf16x4v, p);
}
template <int s>
__device__ __forceinline__ void ml_stage(LAS unsigned char* lds, const bf16* xc, size_t tokn, int h, int w, u32x2 (&pre)[4]) {
    int l15, g4; { int t_ = threadIdx.x; asm volatile("" : "+v"(t_)); l15 = t_ & 15; g4 = (t_ & 63) >> 4;
      if (t_ < 128) { const int q_ = (t_ & 31) >> 2; *(LAS unsigned short*)(lds + ML_NROW + (s & 1) * 256 + 2 * ((t_ & ~31) + (((q_ & 3) * 2 + (q_ >> 2)) << 2) + (t_ & 3))) = bf_rne(*(const LAS float*)(lds + ML_N + 4 * (128 * s + t_))); } }
    const bf16x4v wqf = blockdiag_frag((const LAS float*)(lds + ML_WQ), 32 * s + 4 * w, l15, g4), wkf = blockdiag_frag((const LAS float*)(lds + ML_WK), 32 * s + 4 * w, l15, g4);
    const f32x4 z4 = (f32x4){0.f, 0.f, 0.f, 0.f};
    const int pcol = (w >> 1) * 64 + (2 * g4 + (w & 1)) * 8;
#pragma unroll
    for (int mb = 0; mb < 4; ++mb) {
        const bf16x4v xf = __builtin_bit_cast(bf16x4v, pre[mb]);
        const f32x4 qT = __builtin_amdgcn_mfma_f32_16x16x16bf16_1k(wqf, xf, z4, 0, 0, 0);
        const f32x4 kT = __builtin_amdgcn_mfma_f32_16x16x16bf16_1k(wkf, xf, z4, 0, 0, 0);
        const f32x4 kR = __builtin_amdgcn_mfma_f32_16x16x16bf16_1k(xf, wkf, z4, 0, 0, 0);
        const f32x4 wu4 = *(const LAS f32x4*)(lds + ML_WU + 4 * (64 * w + 16 * mb + 4 * g4));
        *(LAS u32x2*)(lds + ML_QS_(s & 1) + (16 * mb + l15) * ML_QP + pcol) = (u32x2){cvtpk_c(qT[0], qT[1]), cvtpk_c(qT[2], qT[3])};
        *(LAS u32x2*)(lds + ML_KS_(s & 1) + (16 * mb + l15) * ML_QP + pcol) = (u32x2){cvtpk_c(kT[0], kT[1]), cvtpk_c(kT[2], kT[3])};
        *(LAS u32x2*)(lds + ML_KWT_(s & 1) + (16 * w + l15) * ML_TP + (16 * mb + 4 * g4) * 2) = (u32x2){cvtpk_c(kR[0] * wu4[0], kR[1] * wu4[1]), cvtpk_c(kR[2] * wu4[2], kR[3] * wu4[3])};
    }
#pragma unroll
    for (int mb = 0; mb < 4; ++mb) pre[mb] = *(const u32x2*)(xc + (tokn + 16 * mb + l15) * MI + h * 512 + 128 * ((s + 2) & 3) + 16 * w + 4 * g4);
}
template <int s>
__device__ __forceinline__ void ml_compute(LAS unsigned char* lds, int w, int ib, int jb0, float decay, f32x4 (&acc)[32], f32x4 (&sacc)[2], f32x4 (&hin)[4], const bf16x8v vtf0, const bf16x8v vtf1) {
    int l15, g4; { int t_ = threadIdx.x; asm volatile("" : "+v"(t_)); l15 = t_ & 15; g4 = (t_ & 63) >> 4; }
#define ML_WAIT() do { asm volatile("s_waitcnt lgkmcnt(0)" ::: "memory"); __builtin_amdgcn_sched_barrier(0); } while (0)
            { bf16x8v qf[4], kb[2];
              const bool lowq = (w <= 2), do0 = (w != 1) && (w != 7), isn = (w == 2) || (w == 3);
              const LAS unsigned char* qrow = lds + ML_QS_(s & 1) + l15 * ML_QP + (8 * g4) * 2;
              const LAS unsigned char* krow = isn ? lds + ML_NROW + (s & 1) * 256 + (8 * g4) * 2 : lds + ML_KS_(s & 1) + (16 * (w & 3) + l15) * ML_QP + (8 * g4) * 2;
#pragma unroll
              for (int i4 = 0; i4 < 4; ++i4) qf[i4] = *(const LAS bf16x8v*)(qrow + 16 * i4 * ML_QP);
              kb[0] = *(const LAS bf16x8v*)krow;
#pragma unroll
              for (int kk = 0; kk < 4; ++kk) {
                  __builtin_amdgcn_sched_barrier(0);
                  if (kk < 3) kb[(kk + 1) & 1] = *(const LAS bf16x8v*)(krow + 64 * (kk + 1));
                  const f32x4 c0 = acc[8 * s + 2 * kk], c1 = acc[8 * s + 2 * kk + 1];
                  u32x4 cbits; cbits.x = cvtpk(c0[0], c0[1]); cbits.y = cvtpk(c0[2], c0[3]); cbits.z = cvtpk(c1[0], c1[1]); cbits.w = cvtpk(c1[2], c1[3]);
                  const bf16x8v cb = __builtin_bit_cast(bf16x8v, cbits);
#pragma unroll
                  for (int i4 = 0; i4 < 4; ++i4) {
                      hin[i4] = __builtin_amdgcn_mfma_f32_16x16x32_bf16(cb, qf[i4], hin[i4], 0, 0, 0);
                      if (lowq == (i4 < 2)) { if ((i4 & 1) == 0) { if (do0) sacc[0] = __builtin_amdgcn_mfma_f32_16x16x32_bf16(qf[i4], kb[kk & 1], sacc[0], 0, 0, 0); }
                                              else sacc[1] = __builtin_amdgcn_mfma_f32_16x16x32_bf16(qf[i4], kb[kk & 1], sacc[1], 0, 0, 0); }
                      __builtin_amdgcn_sched_barrier(0);
                      if (kk < 3) qf[i4] = *(const LAS bf16x8v*)(qrow + 16 * i4 * ML_QP + 64 * (kk + 1));
                  }
              } }
            { bf16x8v ka[2][4];
              const LAS unsigned char* krow = lds + ML_KWT_(s & 1) + l15 * ML_TP + (8 * g4) * 2;
              ka[0][0] = *(const LAS bf16x8v*)krow; ka[0][1] = *(const LAS bf16x8v*)(krow + 64); ka[0][2] = *(const LAS bf16x8v*)(krow + 16 * ML_TP); ka[0][3] = *(const LAS bf16x8v*)(krow + 16 * ML_TP + 64);
#pragma unroll
              for (int gq = 0; gq < 4; ++gq) {
                  ML_WAIT();
                  if (gq < 3) { const LAS unsigned char* kr2 = krow + 32 * (gq + 1) * ML_TP;
                      ka[(gq + 1) & 1][0] = *(const LAS bf16x8v*)kr2; ka[(gq + 1) & 1][1] = *(const LAS bf16x8v*)(kr2 + 64); ka[(gq + 1) & 1][2] = *(const LAS bf16x8v*)(kr2 + 16 * ML_TP); ka[(gq + 1) & 1][3] = *(const LAS bf16x8v*)(kr2 + 16 * ML_TP + 64); }
                  __builtin_amdgcn_sched_barrier(0);
                  f32x4 c0 = acc[8 * s + 2 * gq] * decay, c1 = acc[8 * s + 2 * gq + 1] * decay;
                  c0 = __builtin_amdgcn_mfma_f32_16x16x32_bf16(ka[gq & 1][0], vtf0, c0, 0, 0, 0);
                  c1 = __builtin_amdgcn_mfma_f32_16x16x32_bf16(ka[gq & 1][2], vtf0, c1, 0, 0, 0);
                  c0 = __builtin_amdgcn_mfma_f32_16x16x32_bf16(ka[gq & 1][1], vtf1, c0, 0, 0, 0);
                  c1 = __builtin_amdgcn_mfma_f32_16x16x32_bf16(ka[gq & 1][3], vtf1, c1, 0, 0, 0);
                  acc[8 * s + 2 * gq] = c0; acc[8 * s + 2 * gq + 1] = c1;
                  if (gq == (w >> 1)) {
                      const bf16x8v ones = __builtin_bit_cast(bf16x8v, (u32x4){0x3f803f80u, 0x3f803f80u, 0x3f803f80u, 0x3f803f80u});
                      f32x4 rsum = (f32x4){0.f, 0.f, 0.f, 0.f};
                      if (w & 1) { rsum = __builtin_amdgcn_mfma_f32_16x16x32_bf16(ka[gq & 1][2], ones, rsum, 0, 0, 0); rsum = __builtin_amdgcn_mfma_f32_16x16x32_bf16(ka[gq & 1][3], ones, rsum, 0, 0, 0); }
                      else       { rsum = __builtin_amdgcn_mfma_f32_16x16x32_bf16(ka[gq & 1][0], ones, rsum, 0, 0, 0); rsum = __builtin_amdgcn_mfma_f32_16x16x32_bf16(ka[gq & 1][1], ones, rsum, 0, 0, 0); }
                      if (l15 == 0) { LAS f32x4* np_ = (LAS f32x4*)(lds + ML_N + 4 * (128 * s + 16 * w + 4 * g4)); *np_ = *np_ * decay + rsum; } }
              } }
}
__device__ __forceinline__ void ml_nupdate(LAS unsigned char* lds, int s, float decay) {
    int tid = threadIdx.x; asm volatile("" : "+v"(tid));
    LAS float* NST = (LAS float*)(lds + ML_N); LAS float* NP = (LAS float*)(lds + ML_NP) + (s & 1) * 512;
    if (tid < 128) NST[128 * s + tid] = decay * NST[128 * s + tid] + ((NP[tid] + NP[128 + tid]) + (NP[256 + tid] + NP[384 + tid]));
}
__device__ __forceinline__ void mlstm_unit_mfma(const Ctx& a, int o_, bf16* xm, const bf16* xc, const float* gates, float* SS, LAS unsigned char* lds, int unit, bool store_out) {
    int tid = threadIdx.x; asm volatile("" : "+v"(tid));
    const int w = __builtin_amdgcn_readfirstlane(tid >> 6);
    const int es = unit & 3, h = (unit >> 2) & 3, b = unit >> 4;
    LAS float* WQ = (LAS float*)(lds + ML_WQ); LAS float* WK = (LAS float*)(lds + ML_WK); LAS float* WV = (LAS float*)(lds + ML_WV);
    LAS float* NST = (LAS float*)(lds + ML_N); LAS float* RS = (LAS float*)(lds + ML_RS);
    { const float* wq = a.in(I_ML_WQ) + ((size_t)o_ * 512 + h * 128) * 16; const float* wk = a.in(I_ML_WK) + ((size_t)o_ * 512 + h * 128) * 16; const float* wv = a.in(I_ML_WV) + ((size_t)o_ * 512 + h * 128 + es * 32) * 16;
      for (int i = tid; i < 2048; i += NTHREADS) { const int ti = (i & ~15) | ((i & 3) << 2) | ((i >> 2) & 3);
          WQ[ti] = wq[i]; WK[ti] = wk[i] * 0.04419417382415922f; }
      NST[tid] = 0.f; WV[(tid & ~15) | ((tid & 3) << 2) | ((tid >> 2) & 3)] = wv[tid]; }
    f32x4 acc[32];
#pragma unroll
    for (int i = 0; i < 32; ++i) acc[i] = (f32x4){0.f, 0.f, 0.f, 0.f};
    float mst = 0.f;
    const int ib = 2 * (w >> 2), jb0 = w & 3;
    u32x2 pre[4], pre1[4], vpre[4]; float gli, glf;
    { const int l0 = tid & 63, f15 = tid & 15, fg4 = l0 >> 4; const size_t t0 = (size_t)b * SEQ + l0, tb = (size_t)b * SEQ;
#pragma unroll
      for (int mb = 0; mb < 4; ++mb) { pre[mb] = *(const u32x2*)(xc + (tb + 16 * mb + f15) * MI + h * 512 + 16 * w + 4 * fg4); pre1[mb] = *(const u32x2*)(xc + (tb + 16 * mb + f15) * MI + h * 512 + 128 + 16 * w + 4 * fg4); vpre[mb] = *(const u32x2*)(xm + (tb + 16 * mb + f15) * MI + h * 512 + es * 128 + 16 * w + 4 * fg4); }
      gli = gates[t0 * 8 + h]; glf = gates[t0 * 8 + 4 + h]; }
    __syncthreads();
    for (int ch = 0; ch < SEQ / 64; ++ch) {
        const size_t tok0 = (size_t)b * SEQ + ch * 64;
        int tid = threadIdx.x; asm volatile("" : "+v"(tid));
        const int lane = tid & 63, l15 = lane & 15, g4 = lane >> 4;
        float decay, flast, M63;
        { const float li = gli, lf = glf;
          { const size_t tn = (ch + 1 < SEQ / 64) ? tok0 + 64 + lane : tok0 + lane; gli = gates[tn * 8 + h]; glf = gates[tn * 8 + 4 + h]; }
          const float fc = wave_scan_sum(lf, lane), av = li - fc, Mv = fmaxf(mst, wave_scan_max(av, lane));
          M63 = __uint_as_float(__builtin_amdgcn_readlane(__float_as_uint(Mv), 63)); flast = __uint_as_float(__builtin_amdgcn_readlane(__float_as_uint(fc), 63));
          decay = __expf(mst - M63);
          *(LAS float*)(lds + ML_WU + 4 * (64 * w + lane)) = __expf(av - M63);
          if (w == 0) { *(LAS float*)(lds + ML_GA + 4 * lane) = av; *(LAS float*)(lds + ML_GM + 4 * lane) = Mv; *(LAS float*)(lds + ML_GW + 4 * lane) = __expf(mst - Mv); *(LAS float*)(lds + ML_GE + 4 * lane) = __expf(-(fc + Mv)); } }
        LDS_WAIT(); asm volatile("" ::: "memory");
        { const bf16x4v wvf = blockdiag_frag((const LAS float*)(lds + ML_WV), 4 * w, l15, g4);
#pragma unroll
          for (int mb = 0; mb < 4; ++mb) {
              const f32x4 vR = __builtin_amdgcn_mfma_f32_16x16x16bf16_1k(__builtin_bit_cast(bf16x4v, vpre[mb]), wvf, (f32x4){0.f, 0.f, 0.f, 0.f}, 0, 0, 0);
              *(LAS u32x2*)(lds + ML_VT + (16 * w + l15) * ML_TP + (16 * mb + 4 * g4) * 2) = (u32x2){cvtpk_c(vR[0], vR[1]), cvtpk_c(vR[2], vR[3])}; } }
        const size_t tokn = (ch + 1 < SEQ / 64) ? tok0 + 64 : tok0;
        f32x4 sacc[2] = {(f32x4){0.f, 0.f, 0.f, 0.f}, (f32x4){0.f, 0.f, 0.f, 0.f}};
        f32x4 hin[4] = {(f32x4){0.f, 0.f, 0.f, 0.f}, (f32x4){0.f, 0.f, 0.f, 0.f}, (f32x4){0.f, 0.f, 0.f, 0.f}, (f32x4){0.f, 0.f, 0.f, 0.f}};
        ml_stage<0>(lds, xc, tok0, h, w, pre);
        __syncthreads();
        const bf16x8v vtf0 = *(const LAS bf16x8v*)(lds + ML_VT + (16 * w + l15) * ML_TP + (8 * g4) * 2), vtf1 = *(const LAS bf16x8v*)(lds + ML_VT + (16 * w + l15) * ML_TP + (32 + 8 * g4) * 2);
        ml_compute<0>(lds, w, ib, jb0, decay, acc, sacc, hin, vtf0, vtf1);
        ml_stage<1>(lds, xc, tok0, h, w, pre1);
        __syncthreads();
        ml_compute<1>(lds, w, ib, jb0, decay, acc, sacc, hin, vtf0, vtf1);
        ml_stage<2>(lds, xc, tokn, h, w, pre);
        __syncthreads();
        ml_compute<2>(lds, w, ib, jb0, decay, acc, sacc, hin, vtf0, vtf1);
        ml_stage<3>(lds, xc, tokn, h, w, pre1);
        __syncthreads();
        ml_compute<3>(lds, w, ib, jb0, decay, acc, sacc, hin, vtf0, vtf1);
#pragma unroll
        for (int mb = 0; mb < 4; ++mb) vpre[mb] = *(const u32x2*)(xm + (tokn + 16 * mb + l15) * MI + h * 512 + es * 128 + 16 * w + 4 * g4);
#pragma unroll
        for (int jj = 0; jj < 2; ++jj) {
            const int ibj = ib + jj, jb = jb0, jcol = 16 * jb + l15;
            const float aj = *(const LAS float*)(lds + ML_GA + 4 * jcol);
            float p[4];
#pragma unroll
            for (int r = 0; r < 4; ++r) { const int irow = 16 * ibj + 4 * g4 + r; const float Mi = *(const LAS float*)(lds + ML_GM + 4 * irow);
                p[r] = (jb <= ibj && jcol <= irow) ? sacc[jj][r] * __expf(aj - Mi) : 0.f;
                *(LAS unsigned short*)(lds + ML_PS + irow * ML_TP + jcol * 2) = bf_rne(p[r]);
                const float rs = row16_sum(p[r]);
                if (l15 == 0) RS[jb * 64 + irow] = rs; }
        }
        if ((w == 2 || w == 3) && l15 == 0) { const int r0 = 32 * (w - 2) + 4 * g4; *(LAS f32x4*)(lds + ML_QN + 4 * r0) = sacc[0]; *(LAS f32x4*)(lds + ML_QN + 4 * (r0 + 16)) = sacc[1]; }
        __syncthreads();
        { const float qn = *(const LAS float*)(lds + ML_QN + 4 * lane);
          const float den = ((RS[lane] + RS[64 + lane]) + (RS[128 + lane] + RS[192 + lane])) + *(const LAS float*)(lds + ML_GW + 4 * lane) * qn;
          *(LAS float*)(lds + ML_RD + 4 * lane) = 1.0f / fmaxf(fabsf(den), *(const LAS float*)(lds + ML_GE + 4 * lane));
          { bf16x8v pa[2][2];
            const LAS unsigned char* prow = lds + ML_PS + l15 * ML_TP + (8 * g4) * 2;
            pa[0][0] = *(const LAS bf16x8v*)prow; pa[0][1] = *(const LAS bf16x8v*)(prow + 64);
#pragma unroll
            for (int i4 = 0; i4 < 4; ++i4) {
              ML_WAIT();
              if (i4 < 3) { pa[(i4 + 1) & 1][0] = *(const LAS bf16x8v*)(prow + 16 * (i4 + 1) * ML_TP); pa[(i4 + 1) & 1][1] = *(const LAS bf16x8v*)(prow + 16 * (i4 + 1) * ML_TP + 64); }
              const float wi = *(const LAS float*)(lds + ML_GW + 4 * (16 * i4 + l15)), rd = *(const LAS float*)(lds + ML_RD + 4 * (16 * i4 + l15));
              __builtin_amdgcn_sched_barrier(0);
              f32x4 hx = (f32x4){0.f, 0.f, 0.f, 0.f};
              hx = __builtin_amdgcn_mfma_f32_16x16x32_bf16(vtf0, pa[i4 & 1][0], hx, 0, 0, 0);
              hx = __builtin_amdgcn_mfma_f32_16x16x32_bf16(vtf1, pa[i4 & 1][1], hx, 0, 0, 0);
              const f32x4 hv = (hx + hin[i4] * wi) * rd;
              u32x2 o; o.x = cvtpk_c(hv[0], hv[1]); o.y = cvtpk_c(hv[2], hv[3]);
              if (store_out) *(u32x2*)(xm + (tok0 + 16 * i4 + l15) * MI + h * 512 + es * 128 + 16 * w + 4 * g4) = o;
              const float e0 = bflo(o.x), e1 = bfhi(o.x), e2 = bflo(o.y), e3 = bfhi(o.y);
              float sq = (e0 * e0 + e1 * e1) + (e2 * e2 + e3 * e3);
              sq += __shfl_xor(sq, 16); sq += __shfl_xor(sq, 32);
              if (g4 == 0) *(LAS float*)(lds + ML_NP + 4 * (w * 64 + 16 * i4 + l15)) = sq;
            } } }
        mst = flast + M63;
        __syncthreads();
        if (w == 0 && store_out) { const LAS float* sq = (const LAS float*)(lds + ML_NP) + lane; float sum = 0.f;
#pragma unroll
            for (int ww = 0; ww < 8; ++ww) sum += sq[64 * ww];
            SS[(tok0 + lane) * 16 + h * 4 + es] = sum; }
    }
}

constexpr int GL_WUP = 0, GL_DEC = 4096, GL_SSQ = 4352, GL_RSTD = 6400, GL_QD = 8192, GL_QP = 144, GL_KD = GL_QD + 64 * GL_QP, GL_KUT = GL_KD + 64 * GL_QP, GL_VT = GL_KUT + 64 * GL_QP, GL_PS = GL_VT + 128 * GL_QP,
              GL_OT = GL_PS + 64 * GL_QP, GL_OP = 528, GL_END = GL_OT + 64 * GL_OP;
static_assert(GL_END <= RING_BYTES, "GLA LDS map");
__device__ __forceinline__ void gla_unit_mfma(const Ctx& a, int e_, const bf16* pbuf, bf16* yb2, LAS unsigned char* lds, int unit) {
    int tid0 = threadIdx.x; asm volatile("" : "+v"(tid0));
    const int w = __builtin_amdgcn_readfirstlane(tid0 >> 6);
    const int b = unit >> 2, h = unit & 3;
    LAS float* WUP = (LAS float*)(lds + GL_WUP);
    { const float* wup = a.in(I_GLA_WUP) + (size_t)e_ * 16 * 256; for (int idx = tid0; idx < 1024; idx += NTHREADS) { const int j = idx >> 6, d = idx & 63; WUP[d * 16 + j] = wup[j * 256 + h * 64 + d]; } }
    f32x4 acc[4];
#pragma unroll
    for (int i = 0; i < 4; ++i) acc[i] = (f32x4){0.f, 0.f, 0.f, 0.f};
    const int ib = w >> 1, jb0 = 2 * (w & 1);
    float balpha[8];
    { const float* bp = a.in(I_GLA_BALPHA) + e_ * 256 + h * 64 + 8 * w;
#pragma unroll
      for (int c = 0; c < 8; ++c) balpha[c] = bp[c]; }
    f32x4 gnv[4];
    { const float* gnp = a.in(I_GLA_NORM) + e_ * 512 + h * 128 + 16 * (tid0 & 7);
#pragma unroll
      for (int c4 = 0; c4 < 4; ++c4) gnv[c4] = *(const f32x4*)(gnp + 4 * c4); }
    u32x4 nqr, nkr, na0, na1, nv0, nv1;
    { const bf16* row = pbuf + ((size_t)b * SEQ + (tid0 & 63)) * EPAD;
      nqr = *(const u32x4*)(row + PC_Q + h * 64 + 8 * w); nkr = *(const u32x4*)(row + PC_K + h * 64 + 8 * w); na0 = *(const u32x4*)(row + PC_A); na1 = *(const u32x4*)(row + PC_A + 8);
      nv0 = *(const u32x4*)(row + PC_V + h * 128 + 16 * w); nv1 = *(const u32x4*)(row + PC_V + h * 128 + 16 * w + 8); }
    __syncthreads();
    for (int ch = 0; ch < SEQ / 64; ++ch) {
        const size_t tok0 = (size_t)b * SEQ + ch * 64;
        int tid = threadIdx.x; asm volatile("" : "+v"(tid));
        const int lane = tid & 63, l15 = lane & 15, g4 = lane >> 4;
        u32x4 rg0, rg1;
        { const bf16* rrow = pbuf + (tok0 + (tid >> 3)) * EPAD + PC_R + h * 128 + 16 * (tid & 7); rg0 = *(const u32x4*)rrow; rg1 = *(const u32x4*)(rrow + 8); }
        { const u32x4 qr = nqr, kr = nkr, a0 = na0, a1 = na1, v0 = nv0, v1 = nv1;
          { const bf16* row = pbuf + (((ch + 1 < SEQ / 64) ? tok0 + 64 : tok0) + lane) * EPAD;
            nqr = *(const u32x4*)(row + PC_Q + h * 64 + 8 * w); nkr = *(const u32x4*)(row + PC_K + h * 64 + 8 * w); na0 = *(const u32x4*)(row + PC_A); na1 = *(const u32x4*)(row + PC_A + 8);
            nv0 = *(const u32x4*)(row + PC_V + h * 128 + 16 * w); nv1 = *(const u32x4*)(row + PC_V + h * 128 + 16 * w + 8); }
          float al[16]; al[0] = bflo(a0.x); al[1] = bfhi(a0.x); al[2] = bflo(a0.y); al[3] = bfhi(a0.y); al[4] = bflo(a0.z); al[5] = bfhi(a0.z); al[6] = bflo(a0.w); al[7] = bfhi(a0.w);
          al[8] = bflo(a1.x); al[9] = bfhi(a1.x); al[10] = bflo(a1.y); al[11] = bfhi(a1.y); al[12] = bflo(a1.z); al[13] = bfhi(a1.z); al[14] = bflo(a1.w); al[15] = bfhi(a1.w);
          const float qf[8] = {bflo(qr.x), bfhi(qr.x), bflo(qr.y), bfhi(qr.y), bflo(qr.z), bfhi(qr.z), bflo(qr.w), bfhi(qr.w)};
          const float kf[8] = {bflo(kr.x), bfhi(kr.x), bflo(kr.y), bfhi(kr.y), bflo(kr.z), bfhi(kr.z), bflo(kr.w), bfhi(kr.w)};
          unsigned qd[4], kd[4];
          float qprev = 0.f, kprev = 0.f;
#pragma unroll
          for (int c = 0; c < 8; ++c) {
              const int d = 8 * w + c;
              float z = balpha[c];
#pragma unroll
              for (int j4 = 0; j4 < 4; ++j4) { const f32x4 wv = *(const LAS f32x4*)(WUP + d * 16 + 4 * j4); z = fmaf(al[4 * j4], wv[0], z); z = fmaf(al[4 * j4 + 1], wv[1], z); z = fmaf(al[4 * j4 + 2], wv[2], z); z = fmaf(al[4 * j4 + 3], wv[3], z); }
              const float la = logsigm_fast(z) * (1.0f / 16.0f);
              const float gi = wave_scan_sum(la, lane);
              const float gl = __uint_as_float(__builtin_amdgcn_readlane(__float_as_uint(gi), 63));
              const float qv = qf[c] * __expf(gi) * 0.125f, kv = kf[c] * __expf(-gi), ku = kf[c] * __expf(gl - gi);
              *(LAS unsigned short*)(lds + GL_KUT + d * GL_QP + lane * 2) = bf_rne(ku);
              if (lane == 0) *(LAS float*)(lds + GL_DEC + 4 * d) = __expf(gl);
              if (c & 1) { qd[c >> 1] = cvtpk(qprev, qv); kd[c >> 1] = cvtpk(kprev, kv); } else { qprev = qv; kprev = kv; }
          }
          *(LAS u32x4*)(lds + GL_QD + lane * GL_QP + 16 * w) = (u32x4){qd[0], qd[1], qd[2], qd[3]};
          *(LAS u32x4*)(lds + GL_KD + lane * GL_QP + 16 * w) = (u32x4){kd[0], kd[1], kd[2], kd[3]};
          const unsigned vr[8] = {v0.x, v0.y, v0.z, v0.w, v1.x, v1.y, v1.z, v1.w};
#pragma unroll
          for (int c = 0; c < 8; ++c) { *(LAS unsigned short*)(lds + GL_VT + (16 * w + 2 * c) * GL_QP + lane * 2) = (unsigned short)(vr[c] & 0xffffu); *(LAS unsigned short*)(lds + GL_VT + (16 * w + 2 * c + 1) * GL_QP + lane * 2) = (unsigned short)(vr[c] >> 16); } }
        __syncthreads();
        const bf16x8v vtf0 = *(const LAS bf16x8v*)(lds + GL_VT + (16 * w + l15) * GL_QP + (8 * g4) * 2), vtf1 = *(const LAS bf16x8v*)(lds + GL_VT + (16 * w + l15) * GL_QP + (32 + 8 * g4) * 2);
        f32x4 sacc[2] = {(f32x4){0.f, 0.f, 0.f, 0.f}, (f32x4){0.f, 0.f, 0.f, 0.f}};
#pragma unroll
        for (int kk = 0; kk < 2; ++kk) {
            const bf16x8v qa = *(const LAS bf16x8v*)(lds + GL_QD + (16 * ib + l15) * GL_QP + (32 * kk + 8 * g4) * 2);
#pragma unroll
            for (int jj = 0; jj < 2; ++jj) if (jb0 + jj <= ib) {
                const bf16x8v kb = *(const LAS bf16x8v*)(lds + GL_KD + (16 * (jb0 + jj) + l15) * GL_QP + (32 * kk + 8 * g4) * 2);
                sacc[jj] = __builtin_amdgcn_mfma_f32_16x16x32_bf16(qa, kb, sacc[jj], 0, 0, 0); }
        }
        f32x4 hin[4] = {(f32x4){0.f, 0.f, 0.f, 0.f}, (f32x4){0.f, 0.f, 0.f, 0.f}, (f32x4){0.f, 0.f, 0.f, 0.f}, (f32x4){0.f, 0.f, 0.f, 0.f}};
#pragma unroll
        for (int kk = 0; kk < 2; ++kk) {
            const f32x4 c0 = acc[2 * kk], c1 = acc[2 * kk + 1];
            u32x4 cbits; cbits.x = cvtpk(c0[0], c0[1]); cbits.y = cvtpk(c0[2], c0[3]); cbits.z = cvtpk(c1[0], c1[1]); cbits.w = cvtpk(c1[2], c1[3]);
            const bf16x8v cb = __builtin_bit_cast(bf16x8v, cbits);
#pragma unroll
            for (int i4 = 0; i4 < 4; ++i4) {
                const u32x2 qlo = *(const LAS u32x2*)(lds + GL_QD + (16 * i4 + l15) * GL_QP + (32 * kk + 4 * g4) * 2), qhi = *(const LAS u32x2*)(lds + GL_QD + (16 * i4 + l15) * GL_QP + (32 * kk + 16 + 4 * g4) * 2);
                const bf16x8v qa = __builtin_bit_cast(bf16x8v, (u32x4){qlo.x, qlo.y, qhi.x, qhi.y});
                hin[i4] = __builtin_amdgcn_mfma_f32_16x16x32_bf16(qa, cb, hin[i4], 0, 0, 0); }
        }
#pragma unroll
        for (int db = 0; db < 4; ++db) {
            const f32x4 dec = *(const LAS f32x4*)(lds + GL_DEC + 4 * (16 * db + 4 * g4));
            f32x4 c = acc[db] * dec;
            const bf16x8v ka0 = *(const LAS bf16x8v*)(lds + GL_KUT + (16 * db + l15) * GL_QP + (8 * g4) * 2), ka1 = *(const LAS bf16x8v*)(lds + GL_KUT + (16 * db + l15) * GL_QP + (32 + 8 * g4) * 2);
            c = __builtin_amdgcn_mfma_f32_16x16x32_bf16(ka0, vtf0, c, 0, 0, 0);
            c = __builtin_amdgcn_mfma_f32_16x16x32_bf16(ka1, vtf1, c, 0, 0, 0);
            acc[db] = c; }
#pragma unroll
        for (int jj = 0; jj < 2; ++jj) {
            const int jb = jb0 + jj, jcol = 16 * jb + l15;
#pragma unroll
            for (int r = 0; r < 4; ++r) { const int irow = 16 * ib + 4 * g4 + r;
                const float p = (jb <= ib && jcol <= irow) ? sacc[jj][r] : 0.f;
                *(LAS unsigned short*)(lds + GL_PS + irow * GL_QP + jcol * 2) = bf_rne(p); }
        }
        __syncthreads();
#pragma unroll
        for (int i4 = 0; i4 < 4; ++i4) {
            const bf16x8v pa0 = *(const LAS bf16x8v*)(lds + GL_PS + (16 * i4 + l15) * GL_QP + (8 * g4) * 2), pa1 = *(const LAS bf16x8v*)(lds + GL_PS + (16 * i4 + l15) * GL_QP + (32 + 8 * g4) * 2);
            f32x4 hx = hin[i4];
            hx = __builtin_amdgcn_mfma_f32_16x16x32_bf16(pa0, vtf0, hx, 0, 0, 0);
            hx = __builtin_amdgcn_mfma_f32_16x16x32_bf16(pa1, vtf1, hx, 0, 0, 0);
#pragma unroll
            for (int r = 0; r < 4; ++r) { const int irow = 16 * i4 + 4 * g4 + r;
                *(LAS float*)(lds + GL_OT + irow * GL_OP + (16 * w + l15) * 4) = hx[r];
                const float sq = row16_sum(hx[r] * hx[r]);
                if (l15 == 0) *(LAS float*)(lds + GL_SSQ + 4 * (w * 64 + irow)) = sq; }
        }
        __syncthreads();
        { const int orow = tid >> 3, op = tid & 7;
          float ss = 0.f;
#pragma unroll
          for (int ww = 0; ww < 8; ++ww) ss += *(const LAS float*)(lds + GL_SSQ + 4 * (ww * 64 + orow));
          const float rstd = rsqrtf(ss * (1.0f / 128.0f) + EPS);
          const u32x4 r0 = rg0, r1 = rg1;
          const unsigned rr[8] = {r0.x, r0.y, r0.z, r0.w, r1.x, r1.y, r1.z, r1.w};
          unsigned ow[8];
#pragma unroll
          for (int c4 = 0; c4 < 4; ++c4) {
              const f32x4 o = *(const LAS f32x4*)(lds + GL_OT + orow * GL_OP + (16 * op + 4 * c4) * 4); const f32x4 gn = gnv[c4];
              const float r_0 = bflo(rr[2 * c4]), r_1 = bfhi(rr[2 * c4]), r_2 = bflo(rr[2 * c4 + 1]), r_3 = bfhi(rr[2 * c4 + 1]);
              ow[2 * c4] = cvtpk(o.x * rstd * gn.x * r_0 * sigm(r_0), o.y * rstd * gn.y * r_1 * sigm(r_1));
              ow[2 * c4 + 1] = cvtpk(o.z * rstd * gn.z * r_2 * sigm(r_2), o.w * rstd * gn.w * r_3 * sigm(r_3)); }
          bf16* outp = yb2 + (tok0 + orow) * D + 512 + h * 128 + 16 * op;
          *(u32x4*)outp = (u32x4){ow[0], ow[1], ow[2], ow[3]}; *(u32x4*)(outp + 8) = (u32x4){ow[4], ow[5], ow[6], ow[7]}; }
        __syncthreads();
    }
}

typedef float f32x16 __attribute__((ext_vector_type(16)));
constexpr int S5_XP = 272;
__device__ __forceinline__ void cmul_acc(float& orr, float& oi, float ar, float ai, float br, float bi) { orr = fmaf(ar, br, fmaf(-ai, bi, orr)); oi = fmaf(ar, bi, fmaf(ai, br, oi)); }
__device__ __forceinline__ void s5_unit_mfma(const Ctx& a, int e, bf16* pbuf, bf16* yout, int ypitch, LAS unsigned char* lds, int wgS) {
    int tid = threadIdx.x; asm volatile("" : "+v"(tid));
    const int lane = tid & 63, wave = __builtin_amdgcn_readfirstlane(tid >> 6), l31 = lane & 31, hh = lane >> 5, l15 = lane & 15, g4 = lane >> 4;
    const int g = wgS & 31, b = (wgS >> 5) * 8 + wave, eg = e * S5G + g;
    LAS unsigned char* X = lds + wave * (32 * S5_XP);
    const float dt = expf(a.in(I_S5_LOGDT)[eg]);
    float Lr[2][4], Li[2][4];
    bf16x8v bfr[4];
#pragma unroll
    for (int sset = 0; sset < 2; ++sset) {
        const int p = l31 + 32 * sset;
        const float lr = a.in(I_S5_LRE)[eg * 64 + p], li = a.in(I_S5_LIM)[eg * 64 + p];
        const float mag = expf(lr * dt), lbr = mag * cosf(li * dt), lbi = mag * sinf(li * dt);
        const float inv = 1.0f / (lr * lr + li * li);
        const float zr = ((lbr - 1.0f) * lr + lbi * li) * inv, zi = (lbi * lr - (lbr - 1.0f) * li) * inv;
        Lr[sset][0] = lbr; Li[sset][0] = lbi;
#pragma unroll
        for (int k = 1; k < 4; ++k) { Lr[sset][k] = Lr[sset][k - 1] * lbr - Li[sset][k - 1] * lbi; Li[sset][k] = Lr[sset][k - 1] * lbi + Li[sset][k - 1] * lbr; }
        const float* bre = a.in(I_S5_BRE) + ((size_t)eg * 64 + p) * 16 + 8 * hh; const float* bim = a.in(I_S5_BIM) + ((size_t)eg * 64 + p) * 16 + 8 * hh;
        unsigned wr_[4], wi_[4];
#pragma unroll
        for (int j = 0; j < 4; ++j) { const float br0 = bre[2 * j], bi0 = bim[2 * j], br1 = bre[2 * j + 1], bi1 = bim[2 * j + 1];
            wr_[j] = cvtpk(zr * br0 - zi * bi0, zr * br1 - zi * bi1); wi_[j] = cvtpk(zr * bi0 + zi * br0, zr * bi1 + zi * br1); }
        bfr[sset] = __builtin_bit_cast(bf16x8v, (u32x4){wr_[0], wr_[1], wr_[2], wr_[3]}); bfr[2 + sset] = __builtin_bit_cast(bf16x8v, (u32x4){wi_[0], wi_[1], wi_[2], wi_[3]});
    }
    bf16x8v cfr[4];
    { const float* cre = a.in(I_S5_CRE) + ((size_t)eg * 16 + l15) * 64; const float* cim = a.in(I_S5_CIM) + ((size_t)eg * 16 + l15) * 64;
#pragma unroll
      for (int ks = 0; ks < 4; ++ks) { const int c0 = 32 * ks + 8 * g4; unsigned wv[4];
#pragma unroll
          for (int j = 0; j < 4; ++j) { const int c = c0 + 2 * j; const float v0 = (c < 64) ? cre[c] : -cim[c - 64], v1 = (c < 64) ? cre[c + 1] : -cim[c + 1 - 64]; wv[j] = cvtpk(v0, v1); }
          cfr[ks] = __builtin_bit_cast(bf16x8v, (u32x4){wv[0], wv[1], wv[2], wv[3]}); } }
    const float dsk = a.in(I_S5_D)[eg * 16 + l15];
    float cr[2] = {0.f, 0.f}, ci[2] = {0.f, 0.f};
    u32x4 unext = *(const u32x4*)(pbuf + ((size_t)b * SEQ + l31) * EPAD + PC_U + g * 16 + 8 * hh);
    for (int blk = 0; blk < SEQ / 32; ++blk) {
        const size_t tok0 = (size_t)b * SEQ + blk * 32;
        const bf16x8v ufr = __builtin_bit_cast(bf16x8v, unext);
        { const size_t tn = (blk + 1 < SEQ / 32) ? tok0 + 32 : tok0; unext = *(const u32x4*)(pbuf + (tn + l31) * EPAD + PC_U + g * 16 + 8 * hh); }
        const f32x16 z16 = {0.f, 0.f, 0.f, 0.f, 0.f, 0.f, 0.f, 0.f, 0.f, 0.f, 0.f, 0.f, 0.f, 0.f, 0.f, 0.f};
        bf16 ue[2][4];
#pragma unroll
        for (int mb = 0; mb < 2; ++mb)
#pragma unroll
            for (int r = 0; r < 4; ++r) ue[mb][r] = pbuf[(tok0 + 16 * mb + 4 * g4 + r) * EPAD + PC_U + g * 16 + l15];
#pragma unroll
        for (int sset = 0; sset < 2; ++sset) {
            f32x16 xr = __builtin_amdgcn_mfma_f32_32x32x16_bf16(ufr, bfr[sset], z16, 0, 0, 0);
            f32x16 xi = __builtin_amdgcn_mfma_f32_32x32x16_bf16(ufr, bfr[2 + sset], z16, 0, 0, 0);
#pragma unroll
            for (int q = 0; q < 4; ++q) {
#pragma unroll
                for (int r = 1; r < 4; ++r) { float vr_ = xr[4 * q + r], vi_ = xi[4 * q + r]; cmul_acc(vr_, vi_, Lr[sset][0], Li[sset][0], xr[4 * q + r - 1], xi[4 * q + r - 1]); xr[4 * q + r] = vr_; xi[4 * q + r] = vi_; }
                float tr = xr[4 * q + 3], ti = xi[4 * q + 3];
                cmul_acc(tr, ti, Lr[sset][3], Li[sset][3], cr[sset], ci[sset]);
                float ur, ui, dum;
                half_pair(tr, ur, dum); half_pair(ti, ui, dum);
                const float inr = hh ? ur : cr[sset], ini = hh ? ui : ci[sset];
#pragma unroll
                for (int r = 0; r < 4; ++r) { float vr_ = xr[4 * q + r], vi_ = xi[4 * q + r]; cmul_acc(vr_, vi_, Lr[sset][r], Li[sset][r], inr, ini); xr[4 * q + r] = vr_; xi[4 * q + r] = vi_; }
                half_pair(xr[4 * q + 3], dum, cr[sset]); half_pair(xi[4 * q + 3], dum, ci[sset]);
            }
#pragma unroll
            for (int r = 0; r < 16; ++r) { const int trow = (r & 3) + 8 * (r >> 2) + 4 * hh;
                *(LAS unsigned short*)(X + trow * S5_XP + (32 * sset + l31) * 2) = bf_rne(xr[r]);
                *(LAS unsigned short*)(X + trow * S5_XP + (64 + 32 * sset + l31) * 2) = bf_rne(xi[r]); }
        }
        LDS_WAIT(); asm volatile("" ::: "memory");
#pragma unroll
        for (int mb = 0; mb < 2; ++mb) {
            f32x4 y = (f32x4){0.f, 0.f, 0.f, 0.f};
#pragma unroll
            for (int ks = 0; ks < 4; ++ks) { const bf16x8v xa = *(const LAS bf16x8v*)(X + (16 * mb + l15) * S5_XP + (32 * ks + 8 * g4) * 2); y = __builtin_amdgcn_mfma_f32_16x16x32_bf16(xa, cfr[ks], y, 0, 0, 0); }
#pragma unroll
            for (int r = 0; r < 4; ++r) { bf16* yp = yout + (tok0 + 16 * mb + 4 * g4 + r) * ypitch + g * 16 + l15;
                const float yv = y[r] + dsk * bf1(ue[mb][r]);
                *yp = bf_rne(gelu_t(yv)); }
        }
        LDS_WAIT(); asm volatile("" ::: "memory");
    }
}

__device__ __forceinline__ void ffn_fixup(const bf16* HTG, const bf16* HTU, const bf16* HBG, const float* cw, const float* cb, bf16* act, int gtid, int gthreads) {
    constexpr int C8 = FF / 8, TOTAL = (NTOK / 64) * 2 * C8;
    for (int idx = gtid; idx < TOTAL; idx += gthreads) {
        const int c8 = idx % C8, lr = (idx / C8) & 1, blk = idx / (2 * C8), ch = 8 * c8;
        const bool inner = (blk & 31) != 0;
        const u32x4 z = (u32x4){0u, 0u, 0u, 0u};
        const u32x4 g = *(const u32x4*)(HTG + ((size_t)blk * 2 + lr) * FF + ch), uu = *(const u32x4*)(HTU + ((size_t)blk * 2 + lr) * FF + ch);
        u32x4 gm1, gm2;
        if (lr == 0) { gm1 = inner ? *(const u32x4*)(HBG + ((size_t)(blk - 1) * 2 + 1) * FF + ch) : z; gm2 = inner ? *(const u32x4*)(HBG + ((size_t)(blk - 1) * 2 + 0) * FF + ch) : z; }
        else         { gm1 = *(const u32x4*)(HTG + ((size_t)blk * 2 + 0) * FF + ch);                       gm2 = inner ? *(const u32x4*)(HBG + ((size_t)(blk - 1) * 2 + 1) * FF + ch) : z; }
        const unsigned gw[4] = {g.x, g.y, g.z, g.w}, uw[4] = {uu.x, uu.y, uu.z, uu.w}, g1w[4] = {gm1.x, gm1.y, gm1.z, gm1.w}, g2w[4] = {gm2.x, gm2.y, gm2.z, gm2.w};
        unsigned ow[4];
        const f32x4 bA = *(const f32x4*)(cb + ch), bB = *(const f32x4*)(cb + ch + 4), w0A = *(const f32x4*)(cw + ch), w0B = *(const f32x4*)(cw + ch + 4),
                    w1A = *(const f32x4*)(cw + FF + ch), w1B = *(const f32x4*)(cw + FF + ch + 4), w2A = *(const f32x4*)(cw + 2 * FF + ch), w2B = *(const f32x4*)(cw + 2 * FF + ch + 4);
        const float bbv[8] = {bA[0], bA[1], bA[2], bA[3], bB[0], bB[1], bB[2], bB[3]}, w0v[8] = {w0A[0], w0A[1], w0A[2], w0A[3], w0B[0], w0B[1], w0B[2], w0B[3]},
                    w1v[8] = {w1A[0], w1A[1], w1A[2], w1A[3], w1B[0], w1B[1], w1B[2], w1B[3]}, w2v[8] = {w2A[0], w2A[1], w2A[2], w2A[3], w2B[0], w2B[1], w2B[2], w2B[3]};
#pragma unroll
        for (int p = 0; p < 4; ++p) {
            const float cv0 = bbv[2 * p] + w0v[2 * p] * bflo(g2w[p]) + w1v[2 * p] * bflo(g1w[p]) + w2v[2 * p] * bflo(gw[p]);
            const float cv1 = bbv[2 * p + 1] + w0v[2 * p + 1] * bfhi(g2w[p]) + w1v[2 * p + 1] * bfhi(g1w[p]) + w2v[2 * p + 1] * bfhi(gw[p]);
            ow[p] = pk2(gelu_t(cv0) * bflo(uw[p]), gelu_t(cv1) * bfhi(uw[p])); }
        *(u32x4*)(act + ((size_t)blk * 64 + lr) * FF + ch) = (u32x4){ow[0], ow[1], ow[2], ow[3]};
    }
}

#ifndef WGM_UP
#define WGM_UP 4
#endif
#ifndef SITE_MASK
#define SITE_MASK 0xffff
#endif
#ifndef PROBE_DUP
#define PROBE_DUP 0
#endif
#ifndef PROBE_EXTRA
#define PROBE_EXTRA 0
#endif
#define SITE(n) for (int rep_ = 0, nrep_ = opaque_int((((PROBE_DUP) >> (n)) & 1) ? 2 : 1); rep_ < nrep_; ++rep_) if constexpr ((((SITE_MASK) >> (n)) & 1) != 0)
__global__ void __launch_bounds__(NTHREADS, 2) fwd(Args args) {
    extern __shared__ __attribute__((aligned(16))) unsigned char lds_raw[];
    LAS unsigned char* lds = (LAS unsigned char*)lds_raw;
    volatile LAS unsigned* MISC = (volatile LAS unsigned*)(lds + MISC_OFF);
    const int G = gridDim.x, bx = blockIdx.x;
    const int vcu = (G % 8 == 0) ? (bx % 8) * (G / 8) + bx / 8 : bx;
    const int NGW = G * NWAVES;
#define FRESH_IDS int tid = threadIdx.x; asm volatile("" : "+v"(tid)); const int lane = tid & 63, wave = __builtin_amdgcn_readfirstlane(tid >> 6), gw = vcu * NWAVES + wave; (void)lane; (void)gw;
    unsigned char* ws = args.ws;
    unsigned* ctl = (unsigned*)(ws + WS_CTL);
    if (threadIdx.x < 256) ((LAS unsigned*)(lds + LDSCTL_OFF))[threadIdx.x] = 0u;
    if (threadIdx.x < 35) ((LAS unsigned long long*)(lds + PTAB_OFF))[threadIdx.x] = (unsigned long long)args.in[threadIdx.x];
    __syncthreads();
    Ctx a; a.tab = (const LAS unsigned long long*)(lds + PTAB_OFF); a.ws = ws;
    XcdBarrier bar; bar.bar = ctl + CW_BAR; bar.x = 0; bar.st = nullptr;
    const bool multi = (args.ph_hi - args.ph_lo) > 1;
    if (multi) bar = xcd_barrier_post(ctl + CW_BAR, MISC + 8);
    const int lo = args.ph_lo, hi = args.ph_hi;
#define IN(k) (lo <= (k) && (k) < hi)
#define SEAM(k) do { if (IN((k) + 1)) xcd_barrier(bar); } while (0)
#define SEAM2(k) do { if (IN((k) + 2)) xcd_barrier(bar); } while (0)

    unsigned long long* slotx = (unsigned long long*)(ws + WS_SLOT); float* rsx = (float*)(ws + WS_HA);
    float* xres = args.out; bf16* xs = (bf16*)(ws + WS_XS);

    if (IN(0)) { FRESH_IDS
        for (int rep = 0, nrep = opaque_int((PROBE_EXTRA & 32) ? 2 : 1); rep < nrep; ++rep) {
        for (int i = vcu * NTHREADS + tid; i < NTOK * 2; i += G * NTHREADS) ((u32x4*)slotx)[i] = (u32x4){0u, 0u, 0u, 0u};
        prepass_frag_table(a, vcu * NTHREADS + tid, G * NTHREADS);
        prologue_weights(a, lds, gw, NGW, wave, lane);
        norm_phase<0, 1>(nullptr, nullptr, a.in(I_X), xs, rsx, gw, NGW, lane); }
        SEAM(0);
    }
    const int G0 = G, bx0 = bx, vcu0 = vcu;
    for (int L = 0; L < DEPTH; ++L) {
        const int pb = 1 + 10 * L, e = L >> 1;
        int G = G0, bx = bx0, vcu = vcu0; asm volatile("" : "+s"(G), "+s"(bx), "+s"(vcu));
        const int NGW = G * NWAVES;
        if ((L & 1) == 0) {
            bf16* pbuf = (bf16*)(ws + WS_PBUF); bf16* yb2 = (bf16*)(ws + WS_YB2);
            if (IN(pb + 0)) {
                pg8::Gemm g{xs, (const bf16*)(ws + WS_W_EVIN + e * SZ_W_EVIN), NTOK, EPAD, D, D, D}; pg8::StaticOrder S; S.init(NTOK, EPAD, G, bx);
                pg8::EpiBf16P E{pbuf, EPAD, rsx};
                SITE(0) pg8::gemm_phase<pg8::EpiBf16P, pg8::StaticOrder, true, true>(lds, g, S, E);
                SEAM(pb + 0);
            }
            if (IN(pb + 2)) { FRESH_IDS
                for (int w = vcu; w < 256; w += G) {
#ifndef NO_S5
#if (PROBE_EXTRA & 64)
                    if (w < 128) { s5_unit_mfma(a, e, pbuf, yb2, D, lds, w); __syncthreads(); }
#endif
#if (PROBE_EXTRA & 128)
                    if (w >= 128) { gla_unit_mfma(a, e, pbuf, yb2, lds, w - 128); __syncthreads(); }
#endif
#ifdef MIX_SIMPLE
                    if (w < 128) s5_unit_simple(a, e, pbuf, pbuf + PC_U, EPAD, lds, w, tid, wave, lane);
#else
                    if (w < 128) s5_unit_mfma(a, e, pbuf, pbuf + PC_U, EPAD, lds, w);
#endif
#endif
#ifdef MIX_SIMPLE
                    if (w >= 128) gla_unit_simple(a, e, pbuf, yb2, lds, w - 128, tid, wave, lane);
#else
                    if (w >= 128) gla_unit_mfma(a, e, pbuf, yb2, lds, w - 128);
#endif
                    __syncthreads();
                }
                SEAM(pb + 2);
            }
            if (IN(pb + 3)) {
                pg8::Gemm g{pbuf + PC_U, (const bf16*)(ws + WS_W_GLU + e * SZ_W_GLU), NTOK, 512, 512, EPAD, 512}; pg8::StaticOrder S; S.init(NTOK, 512, G, bx);
                pg8::EpiGlu E{pbuf + PC_U, EPAD, a.in(I_S5_BGLU) + e * 512, yb2, D};
                SITE(1) pg8::gemm_phase<pg8::EpiGlu, pg8::StaticOrder, true, true>(lds, g, S, E);
                SEAM(pb + 3);
            }
            if (IN(pb + 4)) {
                pg8::Gemm g{yb2, (const bf16*)(ws + WS_W_EVOUT + e * SZ_W_EVOUT), NTOK, D, D, D, D}; pg8::StaticOrder S; S.init(NTOK, D, G, bx);
                pg8::EpiNormRes E{xs, xres, a.in(I_LN_MIX_POST) + L * D, slotx, rsx, (unsigned)(2 * L + 1), ctl + CW_BAR + XB_TMO, lds + RING_BYTES, false};
                SITE(2) pg8::gemm_phase<pg8::EpiNormRes, pg8::StaticOrder, true, true>(lds, g, S, E);
                SEAM2(pb + 4);
            }
        } else {
            bf16* xm = (bf16*)(ws + WS_XM); bf16* xc = (bf16*)(ws + WS_XC); float* gates = (float*)(ws + WS_GATES); float* SSb = (float*)(ws + WS_SS);
            const bf16* wodin = (const bf16*)(ws + WS_W_ODIN + e * SZ_W_ODIN);
            if (IN(pb + 0)) {
                pg8::Gemm g{xs, wodin, NTOK, MI, D, D, D}; pg8::StaticOrder S; S.init(NTOK, MI, G, bx);
                pg8::EpiBf16P E{xm, MI, rsx};
                SITE(3) pg8::gemm_phase<pg8::EpiBf16P, pg8::StaticOrder, true, true>(lds, g, S, E);
                SEAM(pb + 0);
            }
            if (IN(pb + 1)) { FRESH_IDS
#ifndef NO_PRE
                for (int rep = 0, nrep = opaque_int((PROBE_EXTRA & 2) ? 2 : 1); rep < nrep; ++rep) { mlstm_prepass(a, e, xm, xc, gates, lds, vcu, G, tid, wave, lane); __syncthreads(); }
#endif
                SEAM(pb + 1); }
            if (IN(pb + 2)) { FRESH_IDS
#ifndef NO_ML
#ifdef MLSTM_SIMPLE
                for (int u = vcu; u < BATCH * MH * 4; u += G) { mlstm_unit_simple(a, e, xm, xc, gates, SSb, lds, u, tid, wave, lane); __syncthreads(); }
#else
                for (int rep = 0, nrep = opaque_int((PROBE_EXTRA & 4) ? 2 : 1); rep < nrep; ++rep)
                for (int u = vcu; u < BATCH * MH * 4; u += G) { mlstm_unit_mfma(a, e, xm, xc, gates, SSb, lds, u, rep == nrep - 1); __syncthreads(); }
#endif
#endif
                SEAM(pb + 2);
            }
            if (IN(pb + 3)) {
                pg8::Gemm g{xs, wodin + (size_t)MI * D, NTOK, MI, D, D, D}; pg8::StaticOrder S; S.init(NTOK, MI, G, bx);
                pg8::EpiOGate E{xm, xc, SSb, a.in(I_ML_NORM) + e * MI, a.in(I_ML_SKIP) + e * MI, MI, EPS, rsx};
                SITE(4) pg8::gemm_phase<pg8::EpiOGate, pg8::StaticOrder, true, true>(lds, g, S, E);
                SEAM(pb + 3);
            }
            if (IN(pb + 4)) {
                pg8::Gemm g{xm, (const bf16*)(ws + WS_W_ODOUT + e * SZ_W_ODOUT), NTOK, D, MI, MI, MI}; pg8::StaticOrder S; S.init(NTOK, D, G, bx);
                pg8::EpiNormRes E{xs, xres, a.in(I_LN_MIX_POST) + L * D, slotx, rsx, (unsigned)(2 * L + 1), ctl + CW_BAR + XB_TMO, lds + RING_BYTES, false};
                SITE(5) pg8::gemm_phase<pg8::EpiNormRes, pg8::StaticOrder, true, true>(lds, g, S, E);
                SEAM2(pb + 4);
            }
        }
        bf16* act = (bf16*)(ws + WS_ACT); bf16* HTG = (bf16*)(ws + WS_HALO); bf16* HTU = (bf16*)(ws + WS_HALO + SZ_HALO); bf16* HBG = (bf16*)(ws + WS_HALO + 2 * SZ_HALO);
        const float* fcw = a.in(I_FFN_CONV_W) + (size_t)L * 3 * FF; const float* fcb = a.in(I_FFN_CONV_B) + (size_t)L * FF;
        if (IN(pb + 6)) {
            pg8::Gemm g{xs, (const bf16*)(ws + WS_W_UP + L * SZ_W_UP), NTOK, 2 * FF, D, D, D}; pg8::StaticOrder S; S.init(NTOK, 2 * FF, G, bx, WGM_UP);
            pg8::EpiFfnUp E{act, HTG, HTU, HBG, fcw, fcb, FF, rsx};
            SITE(6) pg8::gemm_phase<pg8::EpiFfnUp, pg8::StaticOrder, true, true>(lds, g, S, E);
            SEAM(pb + 6);
        }
        if (IN(pb + 7)) { FRESH_IDS
#if (PROBE_EXTRA & 16)
            ffn_fixup(HTG, HTU, HBG, fcw, fcb, act, vcu * NTHREADS + tid, G * NTHREADS);
#endif
            ffn_fixup(HTG, HTU, HBG, fcw, fcb, act, vcu * NTHREADS + tid, G * NTHREADS); SEAM(pb + 7); }
        if (IN(pb + 8)) {
            pg8::Gemm g{act, (const bf16*)(ws + WS_W_DOWN + L * SZ_W_DOWN), NTOK, D, FF, FF, FF}; pg8::StaticOrder S; S.init(NTOK, D, G, bx);
            pg8::EpiNormRes E{xs, xres, a.in(I_LN_FFN_POST) + L * D, slotx, rsx, (unsigned)(2 * L + 2), ctl + CW_BAR + XB_TMO, lds + RING_BYTES, L + 1 == DEPTH};
            SITE(7) pg8::gemm_phase<pg8::EpiNormRes, pg8::StaticOrder, true, true>(lds, g, S, E);
            SEAM2(pb + 8);
        }
    }
#undef IN
#undef SEAM
#undef SEAM2
}

extern "C" void kernel_launch(void* const* d_in, const int* in_sizes, int n_in, void* d_out, int out_size, void* d_ws, size_t ws_size, hipStream_t stream) {
    static int grid = 0;
    if (grid == 0) {
        if (n_in != 35 || in_sizes[0] != NTOK * D || out_size != NTOK * D || ws_size < WS_END) {
            fprintf(stderr, "kernel_launch: unexpected shapes: n_in %d in0 %d out %d ws %zu (need %zu)\n", n_in, n_in > 0 ? in_sizes[0] : -1, out_size, ws_size, (size_t)WS_END); grid = -1; return; }
        int dev = 0, cus = 0, per_cu = 0;
        if (hipGetDevice(&dev) != hipSuccess || hipDeviceGetAttribute(&cus, hipDeviceAttributeMultiprocessorCount, dev) != hipSuccess) { grid = -1; return; }
        if (hipFuncSetAttribute((const void*)fwd, hipFuncAttributeMaxDynamicSharedMemorySize, LDS_BYTES) != hipSuccess) { fprintf(stderr, "kernel_launch: hipFuncSetAttribute failed\n"); grid = -1; return; }
        if (hipOccupancyMaxActiveBlocksPerMultiprocessor(&per_cu, (const void*)fwd, NTHREADS, LDS_BYTES) != hipSuccess || per_cu < 1)
            fprintf(stderr, "kernel_launch: occupancy query reports %d workgroups per CU\n", per_cu);
        (void)hipGetLastError();
        grid = cus;
    }
    if (grid < 0) return;
    if (hipMemsetAsync((char*)d_ws + WS_CTL, 0, CTL_ZERO_BYTES, stream) != hipSuccess) return;
    Args a{};
    for (int i = 0; i < 35; ++i) a.in[i] = (const float*)d_in[i];
    a.out = (float*)d_out; a.ws = (unsigned char*)d_ws;
#if MK_PER_PHASE_LAUNCH
    for (int p = 0; p < NPHASE; ++p) {
        const int L = (p - 1) / 10, slot = (p - 1) % 10;
        if (p > 0 && slot == 1 && (L & 1) == 0) continue;
        a.ph_lo = p; a.ph_hi = p + 1;
        hipLaunchKernelGGL(fwd, dim3(grid), dim3(NTHREADS), LDS_BYTES, stream, a);
    }
#else
    a.ph_lo = 0; a.ph_hi = NPHASE;
    hipLaunchKernelGGL(fwd, dim3(grid), dim3(NTHREADS), LDS_BYTES, stream, a);
#endif
}
```

```cpp
#include <hip/hip_runtime.h>
#include <cstdio>
#include <cstdint>
#include <type_traits>

#ifndef MK_PER_PHASE_LAUNCH
#define MK_PER_PHASE_LAUNCH 0
#endif

template <int CTRL> __device__ __forceinline__ float dpp_mov(float x) { return __builtin_bit_cast(float, __builtin_amdgcn_mov_dpp(__builtin_bit_cast(int, x), CTRL, 0xf, 0xf, true)); }
template <int CTRL> __device__ __forceinline__ float dpp_z(float x) { return __builtin_bit_cast(float, __builtin_amdgcn_update_dpp(0, __builtin_bit_cast(int, x), CTRL, 0xf, 0xf, true)); }
template <int CTRL, int RM> __device__ __forceinline__ float dpp_o(float oldv, float x) { return __builtin_bit_cast(float, __builtin_amdgcn_update_dpp(__builtin_bit_cast(int, oldv), __builtin_bit_cast(int, x), CTRL, RM, 0xf, false)); }
namespace pg8 {
#define PG8_LAS __attribute__((address_space(3)))
typedef unsigned short bf16_t;
typedef short bf16x8 __attribute__((ext_vector_type(8)));
typedef float f32x4 __attribute__((ext_vector_type(4)));
typedef unsigned u32x4 __attribute__((ext_vector_type(4)));
typedef unsigned u32x2 __attribute__((ext_vector_type(2)));
constexpr int BM = 256, BK = 64, HALF = 128, HTB = HALF * BK * 2  , STAGE_BYTES = 8 * HTB, NXCD = 8, WGM = 8;

__host__ __device__ __forceinline__ int lds_byte(int r, int c) { const int st = (r >> 4) * 2 + (c >> 5), rr = r & 15, cc = c & 31, ob = rr * 64 + cc * 2; return st * 1024 + (ob ^ (((ob >> 9) & 1) << 5)); }
__host__ __device__ __forceinline__ void stage_rc(int b, int& R, int& C) { const int st = b / 1024, sb = b % 1024, swz = sb ^ (((sb >> 9) & 1) << 5); R = (st >> 1) * 16 + swz / 64; C = (st & 1) * 32 + (swz % 64) / 2; }
__host__ __device__ __forceinline__ int perm32(int rho) { const int n = rho >> 4, i = rho & 15; return 8 * (i >> 2) + 4 * n + (i & 3); }

struct Unit { int pm, pn; };
struct Gemm { const bf16_t* A; const bf16_t* Bt; int M, N, K, lda, ldb; };

struct StaticOrder {
    int nM, nN, nwg, G, c, wgm;
    __host__ __device__ void init(int M, int N, int G_, int c_, int wgm_ = WGM) { nM = M / BM; nN = N / BM; nwg = nM * nN; G = G_; c = c_; wgm = wgm_; }
    __host__ __device__ bool next(int i, Unit& u) const {
        const long L = (long)i * G + c; if (L >= nwg) return false;
        int wgid = (int)L; { const int q = nwg / NXCD, r = nwg % NXCD, xcd = wgid % NXCD, off = wgid / NXCD; wgid = (xcd < r ? xcd * (q + 1) : r * (q + 1) + (xcd - r) * q) + off; }
        const int nig = wgm * nN, gid = wgid / nig, fm = gid * wgm, gsz = (nM - fm) < wgm ? (nM - fm) : wgm;
        u.pm = fm + ((wgid % nig) % gsz); u.pn = (wgid % nig) / gsz; return true;
    }
    __device__ __forceinline__ void a_ready(const Unit&) const {}
    __device__ __forceinline__ void done(const Unit&) const {}
};

typedef __bf16 bf16x2n __attribute__((ext_vector_type(2)));
__device__ __forceinline__ unsigned cvt_pk_bf16(float lo, float hi) { const bf16x2n v = {(__bf16)lo, (__bf16)hi}; return __builtin_bit_cast(unsigned, v); }
__device__ __forceinline__ float bf_lo(unsigned u) { return __uint_as_float(u << 16); }
__device__ __forceinline__ float bf_hi(unsigned u) { return __uint_as_float(u & 0xffff0000u); }
__device__ __forceinline__ float sigmoidf_(float x) { return __builtin_amdgcn_rcpf(1.0f + __expf(-x)); }
__device__ __forceinline__ float gelu_tanh(float x) { const float p = fmaf(x * x, -0.10294323f, -2.3022082f); return x * __builtin_amdgcn_rcpf(1.0f + __builtin_amdgcn_exp2f(x * p)); }

__device__ __forceinline__ float rs_of(const float* rsp, size_t row) { const f32x4 p = *(const f32x4*)(rsp + 4 * row); return rsqrtf(((p[0] + p[1]) + (p[2] + p[3])) * (1.0f / 1024.0f) + 1e-6f); }
template <bool ADJ>
struct EpiBf16PT {
    static constexpr bool PERM = true, AFTER_DRAIN = false; static constexpr int WCS = ADJ ? 64 : 32, BJS = ADJ ? 32 : HALF;
    bf16_t* O; int ldc; const float* rs;
    static constexpr bool PREFETCH = true;
    static constexpr int PF_OFF = 131072, PF_BYTES = 4096;
    __device__ __forceinline__ void prefetch(const Unit& u, PG8_LAS unsigned char* lds, int par, int wid, int lane) const {
        if (wid < 4) __builtin_amdgcn_global_load_lds((const unsigned*)(rs + 4 * ((size_t)u.pm * BM + wid * 64 + lane)), (PG8_LAS unsigned*)(lds + PF_OFF + par * PF_BYTES + wid * 1024), 16, 0, 0);
    }
    __device__ __forceinline__ void run_pf(const f32x4 (&acc)[2][2][4][2], const Unit& u, int wr, int wc, int fr, int fq, PG8_LAS unsigned char* lds, int par) const {
        const PG8_LAS unsigned char* buf = lds + PF_OFF + par * PF_BYTES;
        const int row0 = u.pm * BM + wr * 64 + fr, col0 = u.pn * BM + wc * WCS + 8 * fq;
#pragma unroll
        for (int ai = 0; ai < 2; ++ai)
#pragma unroll
            for (int m = 0; m < 4; ++m) { bf16_t* rowp = O + (size_t)(row0 + ai * HALF + m * 16) * ldc + col0; const f32x4 rp_ = *(const PG8_LAS f32x4*)(buf + 16 * (wr * 64 + fr + ai * HALF + m * 16)); const float rsc = rsqrtf(((rp_[0] + rp_[1]) + (rp_[2] + rp_[3])) * (1.0f / 1024.0f) + 1e-6f);
#pragma unroll
                for (int bj = 0; bj < 2; ++bj) { const f32x4 v0 = acc[ai][bj][m][0] * rsc, v1 = acc[ai][bj][m][1] * rsc;
                    u32x4 w; w.x = cvt_pk_bf16(v0[0], v0[1]); w.y = cvt_pk_bf16(v0[2], v0[3]); w.z = cvt_pk_bf16(v1[0], v1[1]); w.w = cvt_pk_bf16(v1[2], v1[3]);
                    *(u32x4*)(rowp + bj * BJS) = w; } }
    }
};
template <bool ADJ>
struct EpiGluT {
    static constexpr bool PERM = true, AFTER_DRAIN = false; static constexpr int WCS = ADJ ? 64 : 32, BJS = ADJ ? 32 : HALF;
    const bf16_t* Y; int ldy; const float* bias; bf16_t* O; int ldc;
    __device__ __forceinline__ void operator()(const f32x4 (&acc)[2][2][4][2], const Unit& u, int wr, int wc, int fr, int fq) const {
        const int row0 = u.pm * BM + wr * 64 + fr, col0 = u.pn * BM + wc * WCS + 8 * fq;
        f32x4 bv[2][2];
#pragma unroll
        for (int bj = 0; bj < 2; ++bj)
#pragma unroll
            for (int n = 0; n < 2; ++n) bv[bj][n] = *(const f32x4*)(bias + col0 + bj * BJS + 4 * n);
#pragma unroll
        for (int ai = 0; ai < 2; ++ai)
#pragma unroll
            for (int m = 0; m < 4; ++m) { const size_t row = (size_t)(row0 + ai * HALF + m * 16);
#pragma unroll
                for (int bj = 0; bj < 2; ++bj) { const int col = col0 + bj * BJS;
                    const u32x4 yv = *(const u32x4*)(Y + row * ldy + col);
                    const f32x4 z0 = acc[ai][bj][m][0] + bv[bj][0], z1 = acc[ai][bj][m][1] + bv[bj][1];
                    float o[8];
                    o[0] = bf_lo(yv.x) * sigmoidf_(z0[0]); o[1] = bf_hi(yv.x) * sigmoidf_(z0[1]); o[2] = bf_lo(yv.y) * sigmoidf_(z0[2]); o[3] = bf_hi(yv.y) * sigmoidf_(z0[3]);
                    o[4] = bf_lo(yv.z) * sigmoidf_(z1[0]); o[5] = bf_hi(yv.z) * sigmoidf_(z1[1]); o[6] = bf_lo(yv.w) * sigmoidf_(z1[2]); o[7] = bf_hi(yv.w) * sigmoidf_(z1[3]);
                    u32x4 w; w.x = cvt_pk_bf16(o[0], o[1]); w.y = cvt_pk_bf16(o[2], o[3]); w.z = cvt_pk_bf16(o[4], o[5]); w.w = cvt_pk_bf16(o[6], o[7]);
                    *(u32x4*)(O + row * ldc + col) = w; } }
    }
};
template <bool ADJ>
struct EpiOGateT {
    static constexpr bool PERM = true, AFTER_DRAIN = false; static constexpr int WCS = ADJ ? 64 : 32, BJS = ADJ ? 32 : HALF;
    bf16_t* H; const bf16_t* XC; const float* SS; const float* gn; const float* skip; int ld; float eps; const float* rs;
    struct RowIn { u32x4 hv[2], xv[2]; };
    static constexpr bool PREFETCH = true;
    static constexpr int PF_OFF = 131072, PF_BYTES = 10240;
    __device__ __forceinline__ void prefetch(const Unit& u, PG8_LAS unsigned char* lds, int par, int wid, int lane) const {
        PG8_LAS unsigned char* buf = lds + PF_OFF + par * PF_BYTES; const int head = u.pn >> 1;
        const float* src; int off;
        if (wid < 2) { src = (wid == 0 ? gn : skip) + u.pn * BM + 4 * lane; off = wid * 1024; }
        else if (wid < 6) { src = SS + ((size_t)u.pm * BM + (wid - 2) * 64 + lane) * 16 + head * 4; off = 2048 + (wid - 2) * 1024; }
        else { src = rs + 4 * ((size_t)u.pm * BM + (wid - 6) * 64 + lane); off = 6144 + (wid - 6) * 1024; }
        __builtin_amdgcn_global_load_lds((const unsigned*)src, (PG8_LAS unsigned*)(buf + off), 16, 0, 0);
        if (wid < 2) __builtin_amdgcn_global_load_lds((const unsigned*)(rs + 4 * ((size_t)u.pm * BM + 128 + wid * 64 + lane)), (PG8_LAS unsigned*)(buf + 6144 + 2048 + wid * 1024), 16, 0, 0);
    }
    __device__ __forceinline__ void run_pf(const f32x4 (&acc)[2][2][4][2], const Unit& u, int wr, int wc, int fr_, int fq_, PG8_LAS unsigned char* lds, int par) const {
        const PG8_LAS unsigned char* buf = lds + PF_OFF + par * PF_BYTES;
        int tq = threadIdx.x; asm volatile("" : "+v"(tq));
        const int fr = tq & 15, fq = (tq >> 4) & 3; (void)fr_; (void)fq_;
        const int row0 = u.pm * BM + wr * 64 + fr, col0 = u.pn * BM + wc * WCS + 8 * fq, head = u.pn >> 1;
        f32x4 gv[2][2], sv[2][2];
#pragma unroll
        for (int bj = 0; bj < 2; ++bj)
#pragma unroll
            for (int n = 0; n < 2; ++n) { const int cl = wc * WCS + 8 * fq + bj * BJS + 4 * n; gv[bj][n] = *(const PG8_LAS f32x4*)(buf + 4 * cl); sv[bj][n] = *(const PG8_LAS f32x4*)(buf + 1024 + 4 * cl); }
        auto load_row = [&](int it, RowIn& R) { const size_t row = (size_t)(row0 + (it >> 2) * HALF + (it & 3) * 16);
#pragma unroll
            for (int bj = 0; bj < 2; ++bj) { R.hv[bj] = *(const u32x4*)(H + row * ld + col0 + bj * BJS); R.xv[bj] = *(const u32x4*)(XC + row * ld + col0 + bj * BJS); } };
        RowIn cur, nxt;
        load_row(0, cur);
#pragma unroll
        for (int it = 0; it < 8; ++it) { const int ai = it >> 2, m = it & 3;
            const size_t row = (size_t)(row0 + ai * HALF + m * 16);
            if (it < 7) load_row(it + 1, nxt);
            __builtin_amdgcn_sched_barrier(0);
            const int rl = wr * 64 + fr + ai * HALF + m * 16;
            const f32x4 ss_ = *(const PG8_LAS f32x4*)(buf + 2048 + 16 * rl), rp_ = *(const PG8_LAS f32x4*)(buf + 6144 + 16 * rl);
            const float rstd = rsqrtf(((ss_[0] + ss_[1]) + (ss_[2] + ss_[3])) * (1.0f / 512.0f) + eps);
            const float rsc = rsqrtf(((rp_[0] + rp_[1]) + (rp_[2] + rp_[3])) * (1.0f / 1024.0f) + 1e-6f);
#pragma unroll
            for (int bj = 0; bj < 2; ++bj) { const int col = col0 + bj * BJS;
                const u32x4 hv = cur.hv[bj], xv = cur.xv[bj];
                const f32x4 a0 = acc[ai][bj][m][0] * rsc, a1 = acc[ai][bj][m][1] * rsc; const f32x4 g0 = gv[bj][0] * rstd, g1 = gv[bj][1] * rstd, s0 = sv[bj][0], s1 = sv[bj][1];
                float o[8];
                o[0] = sigmoidf_(a0[0]) * (bf_lo(hv.x) * g0[0] + s0[0] * bf_lo(xv.x)); o[1] = sigmoidf_(a0[1]) * (bf_hi(hv.x) * g0[1] + s0[1] * bf_hi(xv.x));
                o[2] = sigmoidf_(a0[2]) * (bf_lo(hv.y) * g0[2] + s0[2] * bf_lo(xv.y)); o[3] = sigmoidf_(a0[3]) * (bf_hi(hv.y) * g0[3] + s0[3] * bf_hi(xv.y));
                o[4] = sigmoidf_(a1[0]) * (bf_lo(hv.z) * g1[0] + s1[0] * bf_lo(xv.z)); o[5] = sigmoidf_(a1[1]) * (bf_hi(hv.z) * g1[1] + s1[1] * bf_hi(xv.z));
                o[6] = sigmoidf_(a1[2]) * (bf_lo(hv.w) * g1[2] + s1[2] * bf_lo(xv.w)); o[7] = sigmoidf_(a1[3]) * (bf_hi(hv.w) * g1[3] + s1[3] * bf_hi(xv.w));
                u32x4 w; w.x = cvt_pk_bf16(o[0], o[1]); w.y = cvt_pk_bf16(o[2], o[3]); w.z = cvt_pk_bf16(o[4], o[5]); w.w = cvt_pk_bf16(o[6], o[7]);
                *(u32x4*)(H + row * ld + col) = w; }
            __builtin_amdgcn_sched_barrier(0);
            if (it < 7) cur = nxt; }
    }
};
struct EpiFfnUp {
    static constexpr bool PERM = true, AFTER_DRAIN = false;
    bf16_t* ACT; bf16_t* HTG; bf16_t* HTU; bf16_t* HBG; const float* cw; const float* cb; int FFd; const float* rs;
    static constexpr bool PREFETCH = true;
    static constexpr int PF_OFF = 131072, PF_BYTES = 6144;
    __device__ __forceinline__ void prefetch(const Unit& u, PG8_LAS unsigned char* lds, int par, int wid, int lane) const {
        PG8_LAS unsigned char* buf = lds + PF_OFF + par * PF_BYTES;
        if (wid < 2) { const int t = wid * 64 + lane, a_ = t >> 5, q = t & 31; const float* src = (a_ < 3 ? cw + (size_t)a_ * FFd : cb) + u.pn * HALF + 4 * q;
            __builtin_amdgcn_global_load_lds((const unsigned*)src, (PG8_LAS unsigned*)(buf + wid * 1024), 16, 0, 0); }
        else if (wid < 6) { const int r = (wid - 2) * 64 + lane; const float* src = rs + 4 * ((size_t)u.pm * BM + r);
            __builtin_amdgcn_global_load_lds((const unsigned*)src, (PG8_LAS unsigned*)(buf + 2048 + (wid - 2) * 1024), 16, 0, 0); }
    }
    __device__ __forceinline__ void run_pf(const f32x4 (&acc)[2][2][4][2], const Unit& u, int wr, int wc, int fr, int fq, PG8_LAS unsigned char* lds, int par) const {
        const PG8_LAS unsigned char* buf = lds + PF_OFF + par * PF_BYTES;
        const int ch = u.pn * HALF + wc * 32 + 8 * fq, chl = wc * 32 + 8 * fq;
        f32x4 w0[2], w1[2], w2[2], bb[2];
#pragma unroll
        for (int n = 0; n < 2; ++n) { const PG8_LAS float* p = (const PG8_LAS float*)buf + chl + 4 * n;
            w0[n] = *(const PG8_LAS f32x4*)p; w1[n] = *(const PG8_LAS f32x4*)(p + 128); w2[n] = *(const PG8_LAS f32x4*)(p + 256); bb[n] = *(const PG8_LAS f32x4*)(p + 384); }
#pragma unroll
        for (int ai = 0; ai < 2; ++ai) {
            const int blk = u.pm * 4 + ai * 2 + wr;
            float rsm[4];
#pragma unroll
            for (int m = 0; m < 4; ++m) { const f32x4 p = *(const PG8_LAS f32x4*)(buf + 2048 + 16 * (ai * HALF + wr * 64 + m * 16 + fr)); rsm[m] = rsqrtf(((p[0] + p[1]) + (p[2] + p[3])) * (1.0f / 1024.0f) + 1e-6f); }
            f32x4 gpv[2] = {(f32x4){0.f, 0.f, 0.f, 0.f}, (f32x4){0.f, 0.f, 0.f, 0.f}};
#pragma unroll
            for (int m = 0; m < 4; ++m) {
                float o[8];
#pragma unroll
                for (int n = 0; n < 2; ++n)
#pragma unroll
                    for (int j = 0; j < 4; ++j) {
                        const float g = acc[ai][0][m][n][j] * rsm[m], gp = gpv[n][j];
                        float cv = fmaf(w2[n][j], g, bb[n][j]);
                        cv = fmaf(dpp_z<0x111>(g), w1[n][j], cv); cv = fmaf(dpp_z<0x10F>(gp), w1[n][j], cv);
                        cv = fmaf(dpp_z<0x112>(g), w0[n][j], cv); cv = fmaf(dpp_z<0x10E>(gp), w0[n][j], cv);
                        o[4 * n + j] = gelu_tanh(cv) * (acc[ai][1][m][n][j] * rsm[m]);
                        gpv[n][j] = g;
                    }
                const size_t row = (size_t)(u.pm * BM + ai * HALF + wr * 64 + m * 16 + fr);
                if (m == 0 && fr < 2) {
                    const f32x4 ga = acc[ai][0][0][0] * rsm[0], gb = acc[ai][0][0][1] * rsm[0], ua = acc[ai][1][0][0] * rsm[0], ub = acc[ai][1][0][1] * rsm[0];
                    u32x4 wg, wu; wg.x = cvt_pk_bf16(ga[0], ga[1]); wg.y = cvt_pk_bf16(ga[2], ga[3]); wg.z = cvt_pk_bf16(gb[0], gb[1]); wg.w = cvt_pk_bf16(gb[2], gb[3]);
                    wu.x = cvt_pk_bf16(ua[0], ua[1]); wu.y = cvt_pk_bf16(ua[2], ua[3]); wu.z = cvt_pk_bf16(ub[0], ub[1]); wu.w = cvt_pk_bf16(ub[2], ub[3]);
                    *(u32x4*)(HTG + ((size_t)blk * 2 + fr) * FFd + ch) = wg; *(u32x4*)(HTU + ((size_t)blk * 2 + fr) * FFd + ch) = wu;
                } else {
                    u32x4 w; w.x = cvt_pk_bf16(o[0], o[1]); w.y = cvt_pk_bf16(o[2], o[3]); w.z = cvt_pk_bf16(o[4], o[5]); w.w = cvt_pk_bf16(o[6], o[7]);
                    *(u32x4*)(ACT + row * FFd + ch) = w;
                }
                if (m == 3 && fr >= 14) { const f32x4 ga = acc[ai][0][3][0] * rsm[3], gb = acc[ai][0][3][1] * rsm[3];
                    u32x4 wg; wg.x = cvt_pk_bf16(ga[0], ga[1]); wg.y = cvt_pk_bf16(ga[2], ga[3]); wg.z = cvt_pk_bf16(gb[0], gb[1]); wg.w = cvt_pk_bf16(gb[2], gb[3]);
                    *(u32x4*)(HBG + ((size_t)blk * 2 + (fr - 14)) * FFd + ch) = wg; }
                if (m & 1) __builtin_amdgcn_sched_barrier(0);
            }
        }
    }
};

template <bool ADJ>
struct EpiNormResT {
    static constexpr bool PERM = true, AFTER_DRAIN = false; static constexpr int WCS = ADJ ? 64 : 32, BJS = ADJ ? 32 : HALF;
    bf16_t* XS; float* OUT; const float* gpost; unsigned long long* slot; float* RSP; unsigned tag; unsigned* tmo; PG8_LAS unsigned char* tab; bool last;
    static constexpr bool PREFETCH = true;
    static constexpr int PF_OFF = 131072 + 17408, PF_BYTES = 1024;
    __device__ __forceinline__ void prefetch(const Unit& u, PG8_LAS unsigned char* lds, int par, int wid, int lane) const {
        if (wid == 0) __builtin_amdgcn_global_load_lds((const unsigned*)(gpost + u.pn * BM + 4 * lane), (PG8_LAS unsigned*)(lds + PF_OFF + par * PF_BYTES), 16, 0, 0);
    }
    __device__ __forceinline__ void run_pf(const f32x4 (&acc)[2][2][4][2], const Unit& u, int wr, int wc, int fr_, int fq_, PG8_LAS unsigned char* lds, int par) const {
        int tq = threadIdx.x; asm volatile("" : "+v"(tq));
        const int fr = tq & 15, fq = (tq >> 4) & 3; (void)fr_; (void)fq_;
        PG8_LAS float* P = (PG8_LAS float*)tab;
        PG8_LAS float* Sx = (PG8_LAS float*)(tab + 16384);
        const int lane = fq * 16 + fr, prow = wc * 64 + lane;
        const int col0 = u.pn * BM + wc * WCS + 8 * fq;
        u32x4 xv[2][4][2];
#pragma unroll
        for (int ai = 0; ai < 2; ++ai)
#pragma unroll
            for (int m = 0; m < 4; ++m)
#pragma unroll
                for (int bj = 0; bj < 2; ++bj) xv[ai][m][bj] = *(const u32x4*)(XS + (size_t)(u.pm * BM + ai * HALF + wr * 64 + m * 16 + fr) * 1024 + col0 + bj * BJS);
#pragma unroll
        for (int ai = 0; ai < 2; ++ai)
#pragma unroll
            for (int m = 0; m < 4; ++m) { float s = 0.f;
#pragma unroll
                for (int bj = 0; bj < 2; ++bj)
#pragma unroll
                    for (int n = 0; n < 2; ++n) { const f32x4 x = acc[ai][bj][m][n]; s += (x[0] * x[0] + x[1] * x[1]) + (x[2] * x[2] + x[3] * x[3]); }
                P[(ai * HALF + wr * 64 + m * 16 + fr) * 16 + wc * 4 + fq] = s; }
        asm volatile("s_waitcnt lgkmcnt(0)" ::: "memory"); __builtin_amdgcn_s_barrier(); asm volatile("" ::: "memory");
        if (wr == 0) {
            const f32x4 a = *(const PG8_LAS f32x4*)(P + prow * 16), b = *(const PG8_LAS f32x4*)(P + prow * 16 + 4), c = *(const PG8_LAS f32x4*)(P + prow * 16 + 8), d = *(const PG8_LAS f32x4*)(P + prow * 16 + 12);
            const f32x4 t4 = (a + b) + (c + d); const float t = (t4[0] + t4[1]) + (t4[2] + t4[3]);
            unsigned long long* sp4 = slot + (size_t)(u.pm * BM + prow) * 4;
            __hip_atomic_store(sp4 + u.pn, ((unsigned long long)tag << 32) | __float_as_uint(t), __ATOMIC_RELAXED, __HIP_MEMORY_SCOPE_AGENT);
            unsigned long long w0, w1, w2, w3; unsigned sp = 0u;
            for (;;) {
                w0 = __hip_atomic_load(sp4, __ATOMIC_RELAXED, __HIP_MEMORY_SCOPE_AGENT); w1 = __hip_atomic_load(sp4 + 1, __ATOMIC_RELAXED, __HIP_MEMORY_SCOPE_AGENT);
                w2 = __hip_atomic_load(sp4 + 2, __ATOMIC_RELAXED, __HIP_MEMORY_SCOPE_AGENT); w3 = __hip_atomic_load(sp4 + 3, __ATOMIC_RELAXED, __HIP_MEMORY_SCOPE_AGENT);
                const bool ok = (unsigned)(w0 >> 32) == tag && (unsigned)(w1 >> 32) == tag && (unsigned)(w2 >> 32) == tag && (unsigned)(w3 >> 32) == tag;
                if (__builtin_amdgcn_ballot_w64(!ok) == 0ull) break;
                __builtin_amdgcn_s_sleep(1);
                if (++sp > (1u << 19)) { if (lane == 0) __hip_atomic_fetch_add(tmo, 1u, __ATOMIC_RELAXED, __HIP_MEMORY_SCOPE_AGENT); break; }
            }
            const float p0 = __uint_as_float((unsigned)w0), p1 = __uint_as_float((unsigned)w1), p2 = __uint_as_float((unsigned)w2), p3 = __uint_as_float((unsigned)w3);
            Sx[prow] = rsqrtf(((p0 + p1) + (p2 + p3)) * (1.0f / 1024.0f) + 1e-6f);
        }
        asm volatile("s_waitcnt lgkmcnt(0)" ::: "memory"); __builtin_amdgcn_s_barrier(); asm volatile("" ::: "memory");
        f32x4 gv[2][2];
#pragma unroll
        for (int bj = 0; bj < 2; ++bj)
#pragma unroll
            for (int n = 0; n < 2; ++n) gv[bj][n] = *(const PG8_LAS f32x4*)(lds + PF_OFF + par * PF_BYTES + 4 * (wc * WCS + 8 * fq + bj * BJS + 4 * n));
#pragma unroll
        for (int ai = 0; ai < 2; ++ai)
#pragma unroll
            for (int m = 0; m < 4; ++m) { const int r = ai * HALF + wr * 64 + m * 16 + fr; const size_t off = (size_t)(u.pm * BM + r) * 1024 + col0; const float rstd = Sx[r]; float s2 = 0.f;
#pragma unroll
                for (int bj = 0; bj < 2; ++bj) { const u32x4 xw = xv[ai][m][bj];
                    const f32x4 x0 = (f32x4){bf_lo(xw.x), bf_hi(xw.x), bf_lo(xw.y), bf_hi(xw.y)} + acc[ai][bj][m][0] * rstd * gv[bj][0];
                    const f32x4 x1 = (f32x4){bf_lo(xw.z), bf_hi(xw.z), bf_lo(xw.w), bf_hi(xw.w)} + acc[ai][bj][m][1] * rstd * gv[bj][1];
                    s2 += ((x0[0] * x0[0] + x0[1] * x0[1]) + (x0[2] * x0[2] + x0[3] * x0[3])) + ((x1[0] * x1[0] + x1[1] * x1[1]) + (x1[2] * x1[2] + x1[3] * x1[3]));
                    if (last) { *(f32x4*)(OUT + off + bj * BJS) = x0; *(f32x4*)(OUT + off + bj * BJS + 4) = x1; }
                    else { u32x4 w; w.x = cvt_pk_bf16(x0[0], x0[1]); w.y = cvt_pk_bf16(x0[2], x0[3]); w.z = cvt_pk_bf16(x1[0], x1[1]); w.w = cvt_pk_bf16(x1[2], x1[3]); *(u32x4*)(XS + off + bj * BJS) = w; } }
                P[r * 16 + wc * 4 + fq] = s2; }
        asm volatile("s_waitcnt lgkmcnt(0)" ::: "memory"); __builtin_amdgcn_s_barrier(); asm volatile("" ::: "memory");
        if (wr == 0 && !last) {
            const f32x4 a = *(const PG8_LAS f32x4*)(P + prow * 16), b = *(const PG8_LAS f32x4*)(P + prow * 16 + 4), c = *(const PG8_LAS f32x4*)(P + prow * 16 + 8), d = *(const PG8_LAS f32x4*)(P + prow * 16 + 12);
            const f32x4 t4 = (a + b) + (c + d);
            RSP[(size_t)(u.pm * BM + prow) * 4 + u.pn] = (t4[0] + t4[1]) + (t4[2] + t4[3]); }
    }
};

template <class T, class = void> struct has_prefetch : std::false_type {};
template <class T> struct has_prefetch<T, std::void_t<decltype(T::PREFETCH)>> : std::true_type {};
template <class Epi, class Sched, bool ALIGN_EPI = false, bool SP2 = false, bool ADJ = false>
__device__ __forceinline__ void gemm_phase(PG8_LAS unsigned char* lds, const Gemm g, const Sched& S, const Epi& E) {
    int tid = threadIdx.x; asm volatile("" : "+v"(tid));
    const int wid = __builtin_amdgcn_readfirstlane(tid >> 6), lane = tid & 63, wr = wid >> 2, wc = wid & 3, fr = lane & 15, fq = lane >> 4;
    const int K = g.K, nt = K / BK;
    unsigned voffA[2], voffB[2];
#pragma unroll
    for (int i = 0; i < 2; ++i) { int R, C; stage_rc(tid * 16 + i * 8192, R, C); const int Rb = Epi::PERM ? ((R & ~31) + perm32(R & 31)) : R;
        const int Rb2 = ADJ ? ((R >> 5) * 64 + (Rb & 31)) : Rb;
        voffA[i] = (unsigned)(R * g.lda + C) * 2u; voffB[i] = (unsigned)(Rb2 * g.ldb + C) * 2u; }
    const size_t kstep = (size_t)(BK * 2);
    const size_t hstepA = (size_t)HALF * g.lda * 2, hstepB = (size_t)(ADJ ? 32 : HALF) * g.ldb * 2;
    const size_t tstepA = 2 * hstepA, tstepB = (size_t)BM * g.ldb * 2;
    const unsigned ldsw = (unsigned)wid * 1024u;
    const int aoff = lds_byte(wr * 64 + fr, fq * 8), boff = lds_byte(wc * 32 + fr, fq * 8);
#define PG8_SA(b, h) (((b) * 2 + (h)) * HTB)
#define PG8_SB(b, h) ((4 + (b) * 2 + (h)) * HTB)
#define PG8_STAGE(bufoff, gbase, voff) do { _Pragma("unroll") for (int _i = 0; _i < 2; ++_i) \
        __builtin_amdgcn_global_load_lds((const unsigned*)((const char*)(gbase) + (voff)[_i]), (PG8_LAS unsigned*)(lds + (bufoff) + ldsw + _i * 8192), 16, 0, 0); } while (0)
#define PG8_LDA(dst, b, h) do { _Pragma("unroll") for (int m = 0; m < 4; ++m) _Pragma("unroll") for (int k = 0; k < 2; ++k) dst[m][k] = *(const PG8_LAS bf16x8*)(lds + PG8_SA(b, h) + aoff + m * 2048 + k * 1024); } while (0)
#define PG8_LDB(dst, b, h) do { _Pragma("unroll") for (int n = 0; n < 2; ++n) _Pragma("unroll") for (int k = 0; k < 2; ++k) dst[n][k] = *(const PG8_LAS bf16x8*)(lds + PG8_SB(b, h) + boff + n * 2048 + k * 1024); } while (0)
#define PG8_MMA(ai, bj, At, Bt) do { __builtin_amdgcn_s_setprio(1); _Pragma("unroll") for (int m = 0; m < 4; ++m) _Pragma("unroll") for (int n = 0; n < 2; ++n) _Pragma("unroll") for (int k = 0; k < 2; ++k) \
        acc[ai][bj][m][n] = __builtin_amdgcn_mfma_f32_16x16x32_bf16(Bt[n][k], At[m][k], acc[ai][bj][m][n], 0, 0, 0); __builtin_amdgcn_s_setprio(0); } while (0)
#define PG8_WAIT_V(n) asm volatile("s_waitcnt vmcnt(" #n ")" ::: "memory")
#define PG8_WAIT_L(n) asm volatile("s_waitcnt lgkmcnt(" #n ")" ::: "memory")
#define PG8_BAR __builtin_amdgcn_s_barrier()
#define PG8_SCHED __builtin_amdgcn_sched_barrier(0)
    Unit cur, nxt; int ui = 0;
    if (!S.next(0, cur)) return;
    f32x4 acc[2][2][4][2];
#pragma unroll
    for (int a = 0; a < 2; ++a)
#pragma unroll
        for (int b = 0; b < 2; ++b)
#pragma unroll
            for (int m = 0; m < 4; ++m)
#pragma unroll
                for (int n = 0; n < 2; ++n) acc[a][b][m][n] = (f32x4){0.f, 0.f, 0.f, 0.f};
    bf16x8 At[4][2], B0[2][2], B1[2][2];
    const char* cA = (const char*)g.A + (size_t)cur.pm * tstepA; const char* cB = (const char*)g.Bt + (size_t)cur.pn * tstepB;
    S.a_ready(cur);
    if constexpr (has_prefetch<Epi>::value) E.prefetch(cur, lds, 0, wid, lane);
    if constexpr (SP2) {
        PG8_STAGE(PG8_SB(0, 0), cB, voffB); PG8_STAGE(PG8_SB(0, 1), cB + hstepB, voffB); PG8_STAGE(PG8_SA(0, 0), cA, voffA); PG8_STAGE(PG8_SA(0, 1), cA + hstepA, voffA);
        if (wr == 1) PG8_BAR;
        PG8_WAIT_V(2); PG8_BAR;
        PG8_STAGE(PG8_SB(1, 0), cB + kstep, voffB); PG8_STAGE(PG8_SA(1, 0), cA + kstep, voffA); PG8_STAGE(PG8_SB(1, 1), cB + hstepB + kstep, voffB);
        PG8_WAIT_V(6); PG8_BAR;
    } else {
        PG8_STAGE(PG8_SB(0, 0), cB, voffB); PG8_STAGE(PG8_SA(0, 0), cA, voffA); PG8_STAGE(PG8_SB(0, 1), cB + hstepB, voffB); PG8_STAGE(PG8_SA(0, 1), cA + hstepA, voffA);
        if (wr == 1) PG8_BAR;
        PG8_WAIT_V(4); PG8_BAR;
        PG8_STAGE(PG8_SB(1, 0), cB + kstep, voffB); PG8_STAGE(PG8_SA(1, 0), cA + kstep, voffA); PG8_STAGE(PG8_SB(1, 1), cB + hstepB + kstep, voffB);
        PG8_WAIT_V(6); PG8_BAR;
    }
    for (;;) {
        const bool has_next = S.next(ui + 1, nxt);
        const char* nA = has_next ? (const char*)g.A + (size_t)nxt.pm * tstepA : cA; const char* nB = has_next ? (const char*)g.Bt + (size_t)nxt.pn * tstepB : cB;
        for (int t = 0; t < nt; t += 2) {
            const bool last = (t == nt - 2);
            const char* a1 = cA + (size_t)(t + 1) * kstep;
            const char* a2 = last ? nA : cA + (size_t)(t + 2) * kstep; const char* b2 = last ? nB : cB + (size_t)(t + 2) * kstep;
            const char* a3 = a2 + kstep; const char* b3 = b2 + kstep;
            if (last && has_next) S.a_ready(nxt);
            if constexpr (SP2) {
            PG8_LDB(B0, 0, 0); PG8_LDB(B1, 0, 1); PG8_SCHED; PG8_LDA(At, 0, 0); PG8_STAGE(PG8_SA(1, 1), a1 + hstepA, voffA);
            PG8_WAIT_V(8); PG8_WAIT_L(0); PG8_BAR; PG8_MMA(0, 0, At, B0); PG8_MMA(0, 1, At, B1); PG8_BAR; PG8_SCHED;
            PG8_LDA(At, 0, 1); PG8_STAGE(PG8_SB(0, 0), b2, voffB); PG8_STAGE(PG8_SB(0, 1), b2 + hstepB, voffB); PG8_STAGE(PG8_SA(0, 0), a2, voffA);
            PG8_WAIT_V(8); PG8_WAIT_L(0); PG8_BAR; PG8_MMA(1, 0, At, B0); PG8_MMA(1, 1, At, B1); PG8_BAR; PG8_SCHED;
            PG8_LDB(B0, 1, 0); PG8_LDB(B1, 1, 1); PG8_SCHED; PG8_LDA(At, 1, 0); PG8_STAGE(PG8_SA(0, 1), a2 + hstepA, voffA);
            PG8_WAIT_V(8); PG8_WAIT_L(0); PG8_BAR; PG8_MMA(0, 0, At, B0); PG8_MMA(0, 1, At, B1); PG8_BAR; PG8_SCHED;
            PG8_LDA(At, 1, 1); PG8_STAGE(PG8_SB(1, 0), b3, voffB); PG8_STAGE(PG8_SB(1, 1), b3 + hstepB, voffB); PG8_STAGE(PG8_SA(1, 0), a3, voffA);
            PG8_WAIT_V(8); PG8_WAIT_L(0); PG8_BAR; PG8_MMA(1, 0, At, B0); PG8_MMA(1, 1, At, B1); PG8_BAR; PG8_SCHED;
            } else {
            PG8_LDB(B0, 0, 0); PG8_SCHED; PG8_LDA(At, 0, 0); PG8_STAGE(PG8_SA(1, 1), a1 + hstepA, voffA);
            PG8_WAIT_L(8); PG8_BAR; PG8_WAIT_L(0); PG8_MMA(0, 0, At, B0); PG8_BAR; PG8_SCHED;
            PG8_LDB(B1, 0, 1); PG8_STAGE(PG8_SB(0, 0), b2, voffB);
            PG8_BAR; PG8_WAIT_L(0); PG8_MMA(0, 1, At, B1); PG8_BAR;
            PG8_LDA(At, 0, 1); PG8_STAGE(PG8_SA(0, 0), a2, voffA);
            PG8_BAR; PG8_WAIT_L(0); PG8_MMA(1, 0, At, B0); PG8_BAR; PG8_SCHED;
            PG8_STAGE(PG8_SB(0, 1), b2 + hstepB, voffB);
            PG8_WAIT_V(6); PG8_BAR; PG8_MMA(1, 1, At, B1); PG8_BAR;
            PG8_LDB(B0, 1, 0); PG8_SCHED; PG8_LDA(At, 1, 0); PG8_STAGE(PG8_SA(0, 1), a2 + hstepA, voffA);
            PG8_WAIT_L(8); PG8_BAR; PG8_WAIT_L(0); PG8_MMA(0, 0, At, B0); PG8_BAR; PG8_SCHED;
            PG8_LDB(B1, 1, 1); PG8_STAGE(PG8_SB(1, 0), b3, voffB);
            PG8_BAR; PG8_WAIT_L(0); PG8_MMA(0, 1, At, B1); PG8_BAR;
            PG8_LDA(At, 1, 1); PG8_STAGE(PG8_SA(1, 0), a3, voffA);
            PG8_BAR; PG8_WAIT_L(0); PG8_MMA(1, 0, At, B0); PG8_BAR; PG8_SCHED;
            PG8_STAGE(PG8_SB(1, 1), b3 + hstepB, voffB);
            PG8_WAIT_V(6); PG8_BAR; PG8_MMA(1, 1, At, B1); PG8_BAR;
            }
        }
        if constexpr (ALIGN_EPI) { if (wr == 0) PG8_BAR; }
        if constexpr (has_prefetch<Epi>::value) { E.run_pf(acc, cur, wr, wc, fr, fq, lds, ui & 1); S.done(cur); if (has_next) E.prefetch(nxt, lds, (ui + 1) & 1, wid, lane); }
        else if constexpr (!Epi::AFTER_DRAIN) { E(acc, cur, wr, wc, fr, fq); S.done(cur); }
        if (!has_next) break;
#pragma unroll
        for (int a = 0; a < 2; ++a)
#pragma unroll
            for (int b = 0; b < 2; ++b)
#pragma unroll
                for (int m = 0; m < 4; ++m)
#pragma unroll
                    for (int n = 0; n < 2; ++n) { typedef unsigned long long u64x2_ __attribute__((ext_vector_type(2))); unsigned long long z0, z1;
                        asm volatile("v_mov_b64 %0, 0\n\tv_mov_b64 %1, 0" : "=v"(z0), "=v"(z1)); acc[a][b][m][n] = __builtin_bit_cast(f32x4, (u64x2_){z0, z1}); }
        cur = nxt; cA = nA; cB = nB; ++ui;
        if constexpr (ALIGN_EPI) { if (wr == 1) PG8_BAR; }
    }
    PG8_WAIT_V(0);
    if constexpr (!ALIGN_EPI) { if (wr == 0) PG8_BAR; }
    PG8_BAR;
    if constexpr (Epi::AFTER_DRAIN) { E.fused(acc, cur, wr, wc, fr, fq, lds, wid, lane); S.done(cur); }
#undef PG8_SA
#undef PG8_SB
#undef PG8_STAGE
#undef PG8_LDA
#undef PG8_LDB
#undef PG8_MMA
#undef PG8_WAIT_V
#undef PG8_WAIT_L
#undef PG8_BAR
#undef PG8_SCHED
}
}

constexpr int D = 1024, BATCH = 32, SEQ = 2048, NTOK = BATCH * SEQ, DEPTH = 4;
constexpr int S5G = 32, S5P = 64, S5GS = 16;
constexpr int GH = 4, GDK = 64, GDV = 128;
constexpr int EPROJ = 2064, EPAD = 2304;
constexpr int PC_U = 0, PC_Q = 512, PC_K = 768, PC_V = 1024, PC_R = 1536, PC_A = 2048;
constexpr int MI = 2048, MH = 4, MDH = 512;
constexpr int FF = 2816;
constexpr float EPS = 1e-6f;
constexpr int NWAVES = 8, NTHREADS = 512;
constexpr int NPHASE = 1 + 10 * DEPTH;

constexpr size_t MiB = 1u << 20;
constexpr size_t WS_CTL = 0, CTL_ZERO_BYTES = 1 * MiB;
constexpr size_t WS_W_EVIN = 2 * MiB, SZ_W_EVIN = (size_t)EPAD * D * 2;
constexpr size_t WS_W_GLU = 11 * MiB, SZ_W_GLU = (size_t)512 * 512 * 2;
constexpr size_t WS_W_EVOUT = 12 * MiB, SZ_W_EVOUT = (size_t)D * D * 2;
constexpr size_t WS_W_ODIN = 16 * MiB, SZ_W_ODIN = (size_t)2 * MI * D * 2;
constexpr size_t WS_W_ODOUT = 32 * MiB, SZ_W_ODOUT = (size_t)D * MI * 2;
constexpr size_t WS_W_UP = 40 * MiB, SZ_W_UP = (size_t)2 * FF * D * 2;
constexpr size_t WS_W_DOWN = 84 * MiB, SZ_W_DOWN = (size_t)D * FF * 2;
constexpr size_t WS_HA = 112 * MiB;
constexpr size_t WS_SLOT = WS_HA + 2 * MiB;
constexpr size_t WS_GFR = WS_HA + 8 * MiB;
constexpr size_t WS_MIX = 240 * MiB;
constexpr size_t WS_BIG = 368 * MiB;
constexpr size_t WS_PBUF = WS_BIG;
constexpr size_t WS_YB2 = WS_BIG + 288 * MiB;
constexpr size_t WS_XM = WS_BIG;
constexpr size_t WS_XC = WS_BIG + 256 * MiB;
constexpr size_t WS_GATES = WS_BIG + 512 * MiB;
constexpr size_t WS_SS = WS_BIG + 514 * MiB;
constexpr size_t WS_ACT = WS_BIG;
constexpr size_t WS_HALO = WS_BIG + 352 * MiB, SZ_HALO = (size_t)(NTOK / 64) * 2 * FF * 4;
constexpr size_t WS_XS = WS_BIG + 520 * MiB;
constexpr size_t WS_END = WS_XS + 128 * MiB;
static_assert(WS_W_DOWN + 4 * SZ_W_DOWN <= WS_HA && WS_HALO + 3 * SZ_HALO <= WS_END && WS_SS + (size_t)NTOK * 16 * 4 <= WS_END, "d_ws map");
constexpr int CW_PAN = 16384;
constexpr int CW_BAR = 4096;

constexpr int RING_BYTES = 131072, LDS_BYTES = 163840, LDSCTL_OFF = LDS_BYTES - 2048, MISC_OFF = LDSCTL_OFF + 320, PTAB_OFF = LDSCTL_OFF + 1024;

#define GAS __attribute__((address_space(1)))
#define LAS __attribute__((address_space(3)))
typedef unsigned short bf16;
typedef float f32x4 __attribute__((ext_vector_type(4)));
typedef unsigned u32x4 __attribute__((ext_vector_type(4)));
typedef unsigned u32x2 __attribute__((ext_vector_type(2)));
#define LDS_WAIT() asm volatile("s_waitcnt lgkmcnt(0)" ::: "memory")
__device__ __forceinline__ unsigned f2bf(float f) { unsigned u = __builtin_bit_cast(unsigned, f); return (u + 0x7fffu + ((u >> 16) & 1u)) >> 16; }
__device__ __forceinline__ unsigned pk2(float lo, float hi) { return pg8::cvt_pk_bf16(lo, hi); }
__device__ __forceinline__ float bflo(unsigned u) { return __uint_as_float(u << 16); }
__device__ __forceinline__ float bfhi(unsigned u) { return __uint_as_float(u & 0xffff0000u); }
__device__ __forceinline__ float bf1(bf16 b) { return __uint_as_float(((unsigned)b) << 16); }
__device__ __forceinline__ unsigned short bf_rne(float x) { return __builtin_bit_cast(unsigned short, (__bf16)x); }
__device__ __forceinline__ void half_pair(float x, float& from_lo, float& from_hi) { const auto sw = __builtin_amdgcn_permlane32_swap(__float_as_uint(x), __float_as_uint(x), false, false); from_lo = __uint_as_float(sw[0]); from_hi = __uint_as_float(sw[1]); }
__device__ __forceinline__ float logsigm_fast(float x) { return fminf(x, 0.f) - 0.69314718f * __builtin_amdgcn_logf(1.0f + __builtin_amdgcn_exp2f(-1.44269504f * fabsf(x))); }
__device__ __forceinline__ float row16_sum(float x) { x += dpp_mov<0xB1>(x); x += dpp_mov<0x4E>(x); x += dpp_mov<0x141>(x); x += dpp_mov<0x128>(x); return x; }
__device__ __forceinline__ float wave_scan_sum(float v, int) {
    v += dpp_z<0x111>(v); v += dpp_z<0x112>(v); v += dpp_z<0x114>(v); v += dpp_z<0x118>(v);
    v += dpp_o<0x142, 0xa>(0.f, v); v += dpp_o<0x143, 0xc>(0.f, v); return v; }
__device__ __forceinline__ float wave_scan_max(float v, int) {
    v = fmaxf(v, dpp_o<0x111, 0xf>(v, v)); v = fmaxf(v, dpp_o<0x112, 0xf>(v, v)); v = fmaxf(v, dpp_o<0x114, 0xf>(v, v)); v = fmaxf(v, dpp_o<0x118, 0xf>(v, v));
    v = fmaxf(v, dpp_o<0x142, 0xa>(v, v)); v = fmaxf(v, dpp_o<0x143, 0xc>(v, v)); return v; }
__device__ __forceinline__ float wave_sum(float v) { v = wave_scan_sum(v, 0); return __uint_as_float(__builtin_amdgcn_readlane(__float_as_uint(v), 63)); }
__device__ __forceinline__ int opaque_int(int v) { asm volatile("" : "+s"(v)); return v; }
__device__ __forceinline__ float sigm(float x) { return __builtin_amdgcn_rcpf(1.0f + __expf(-x)); }
__device__ __forceinline__ float logsigm(float x) { return fminf(x, 0.f) - log1pf(expf(-fabsf(x))); }
__device__ __forceinline__ float gelu_t(float x) { const float t = 1.5957691216057308f * (x + 0.044715f * x * x * x); return x * __builtin_amdgcn_rcpf(1.0f + __expf(-t)); }

#define XB_TMO      128
#define XB_XCNT(j)  (256  + 64 * (j))
#define XB_XSUB(j)  (1280 + 64 * (j))
#define XB_XGEN(j)  (2304 + 64 * (j))
#define XB_TOP      3328
#define XB_TOPGEN   3392
#define XCD_BAR_WORDS 3456
#define XB_SPIN_CAP (1u << 20)
__device__ __forceinline__ unsigned xb_ld(unsigned* p)              { return __hip_atomic_load(p, __ATOMIC_RELAXED, __HIP_MEMORY_SCOPE_AGENT); }
__device__ __forceinline__ unsigned xb_add(unsigned* p, unsigned v) { return __hip_atomic_fetch_add(p, v, __ATOMIC_RELAXED, __HIP_MEMORY_SCOPE_AGENT); }
__device__ __forceinline__ unsigned xb_xcc_id() { return (unsigned)__builtin_amdgcn_s_getreg((3 << 11) | 20) & 0xFu; }
#define XB_SPIN(cond, bar) do { unsigned _sp = 0; while (cond) { __builtin_amdgcn_s_sleep(1); \
    if ((++_sp & 255u) == 0u) { if (xb_ld(&(bar)[XB_TMO])) break; if (_sp > XB_SPIN_CAP) { atomicAdd(&(bar)[XB_TMO], 1u); break; } } } } while (0)
struct XcdBarrier { unsigned* bar; unsigned x; volatile LAS unsigned* st; };
__device__ __forceinline__ XcdBarrier xcd_barrier_post(unsigned* bar, volatile LAS unsigned* st) {
    XcdBarrier b; b.bar = bar; b.x = xb_xcc_id(); b.st = st;
    if (threadIdx.x == 0) (void)xb_add(&bar[XB_XCNT(b.x)], 1u);
    return b;
}
__device__ __forceinline__ void xcd_barrier_complete(unsigned* bar, unsigned x, unsigned& nloc, unsigned& nx) {
    const unsigned G = gridDim.x * gridDim.y * gridDim.z;
    unsigned sum, cnt, mine, sp = 0u;
    for (;;) {
        sum = 0u; cnt = 0u; mine = 0u;
#pragma unroll
        for (unsigned j = 0; j < 16; ++j) { const unsigned c = xb_ld(&bar[XB_XCNT(j)]); sum += c; cnt += (c > 0u) ? 1u : 0u; mine = (j == x) ? c : mine; }
        if (sum == G) break;
        __builtin_amdgcn_s_sleep(1);
        if ((++sp & 255u) == 0u) { if (xb_ld(&bar[XB_TMO])) break; if (sp > XB_SPIN_CAP) { atomicAdd(&bar[XB_TMO], 1u); break; } }
    }
    nloc = mine > 0u ? mine : 1u; nx = cnt > 0u ? cnt : 1u;
}
__device__ __forceinline__ void xcd_barrier(const XcdBarrier& b) {
    asm volatile("s_waitcnt vmcnt(0)" ::: "memory");
    __syncthreads();
    if (threadIdx.x == 0) {
        unsigned* bar = b.bar;
        __builtin_amdgcn_s_waitcnt(0);
        unsigned nloc = b.st[0], nx = b.st[1];
        if (nloc == 0u) { xcd_barrier_complete(bar, b.x, nloc, nx); b.st[0] = nloc; b.st[1] = nx; }
        const unsigned old = xb_add(&bar[XB_XSUB(b.x)], 1u);
        const unsigned gen = old / nloc;
        if (old + 1u == (gen + 1u) * nloc) {
            __builtin_amdgcn_fence(__ATOMIC_RELEASE, "agent");
            asm volatile("s_waitcnt vmcnt(0)" ::: "memory");
            const unsigned og = xb_add(&bar[XB_TOP], 1u);
            const unsigned tg = og / nx;
            if (og + 1u == (tg + 1u) * nx) xb_add(&bar[XB_TOPGEN], 1u);
            else XB_SPIN(xb_ld(&bar[XB_TOPGEN]) == tg, bar);
            __builtin_amdgcn_fence(__ATOMIC_ACQUIRE, "agent");
            xb_add(&bar[XB_XGEN(b.x)], 1u);
            asm volatile("s_waitcnt vmcnt(0)" ::: "memory");
        } else {
            XB_SPIN(xb_ld(&bar[XB_XGEN(b.x)]) == gen, bar);
            __builtin_amdgcn_fence(__ATOMIC_ACQUIRE, "agent");
            asm volatile("s_waitcnt vmcnt(0)" ::: "memory");
        }
    }
    __syncthreads();
}

struct Args { const float* in[35]; float* out; unsigned char* ws; int ph_lo, ph_hi; };
struct Ctx { const LAS unsigned long long* tab; unsigned char* ws;
    __device__ __forceinline__ const float* in(int i) const { const unsigned long long v = tab[i];
        const unsigned lo = __builtin_amdgcn_readfirstlane((unsigned)v), hi = __builtin_amdgcn_readfirstlane((unsigned)(v >> 32));
        return (const float*)(((unsigned long long)hi << 32) | lo); } };
enum { I_X = 0, I_LN_MIX_PRE, I_LN_MIX_POST, I_LN_FFN_PRE, I_LN_FFN_POST, I_EV_W_IN, I_S5_LRE, I_S5_LIM, I_S5_BRE, I_S5_BIM, I_S5_CRE, I_S5_CIM, I_S5_D, I_S5_LOGDT, I_S5_WGLU, I_S5_BGLU,
       I_GLA_WUP, I_GLA_BALPHA, I_GLA_NORM, I_EV_W_OUT, I_OD_W_IN, I_ML_CONV_W, I_ML_CONV_B, I_ML_WQ, I_ML_WK, I_ML_WV, I_ML_WGATE, I_ML_BGATE, I_ML_NORM, I_ML_SKIP, I_OD_W_OUT,
       I_FFN_W_UP, I_FFN_CONV_W, I_FFN_CONV_B, I_FFN_W_DOWN };

__device__ __forceinline__ void transpose_item(const float* W, int K, int ldw, int sc0, int nvalid, bf16* WT, int n0, int k0, LAS float* scr, int lane, const float* gk = nullptr) {
    { const int c4 = lane & 7, rsub = lane >> 3;
      f32x4 v[8]; float gsc[8];
#pragma unroll
      for (int i = 0; i < 8; ++i) { const int kk = 8 * i + rsub; gsc[i] = gk ? gk[k0 + kk] : 1.0f;
          v[i] = (4 * c4 < nvalid) ? *(const f32x4*)(W + (size_t)(k0 + kk) * ldw + sc0 + 4 * c4) : (f32x4){0.f, 0.f, 0.f, 0.f}; }
#pragma unroll
      for (int i = 0; i < 8; ++i) { const int kk = 8 * i + rsub; LAS float* d = scr + kk * 33 + 4 * c4; const f32x4 t = v[i] * gsc[i]; d[0] = t[0]; d[1] = t[1]; d[2] = t[2]; d[3] = t[3]; } }
    LDS_WAIT(); asm volatile("" ::: "memory");
    const int c8 = lane & 7;
#pragma unroll
    for (int j = 0; j < 4; ++j) { const int n = (lane >> 3) + 8 * j; const LAS float* s = scr + (8 * c8) * 33 + n;
        u32x4 o; o.x = pk2(s[0 * 33], s[1 * 33]); o.y = pk2(s[2 * 33], s[3 * 33]); o.z = pk2(s[4 * 33], s[5 * 33]); o.w = pk2(s[6 * 33], s[7 * 33]);
        *(u32x4*)(WT + (size_t)(n0 + n) * K + k0 + 8 * c8) = o; }
    LDS_WAIT(); asm volatile("" ::: "memory");
}
__device__ __forceinline__ void prologue_weights(const Ctx& a, LAS unsigned char* lds, int gw, int NGW, int wave, int lane) {
    LAS float* scr = (LAS float*)(lds + wave * 16384);
    unsigned char* ws = a.ws;
    constexpr int I_EVIN = (D / 64) * (EPAD / 32), I_GLU = (512 / 64) * (512 / 32), I_EVOUT = (D / 64) * (D / 32), I_ODIN = (D / 64) * (2 * MI / 32), I_ODOUT = (MI / 64) * (D / 32),
                  I_UP = (D / 64) * (2 * FF / 32), I_DOWN = (FF / 64) * (D / 32);
    constexpr int NITEMS = 2 * (I_EVIN + I_GLU + I_EVOUT + I_ODIN + I_ODOUT) + 4 * (I_UP + I_DOWN);
    for (int it = gw; it < NITEMS; it += NGW) {
        int r = it;
        if (r < 2 * I_EVIN) { const int e = r / I_EVIN; r %= I_EVIN; const int nb = r % (EPAD / 32), kb = r / (EPAD / 32), n0 = nb * 32; int nv = EPROJ - n0; nv = nv < 0 ? 0 : (nv > 32 ? 32 : nv);
            transpose_item(a.in(I_EV_W_IN) + (size_t)e * D * EPROJ, D, EPROJ, n0, nv, (bf16*)(ws + WS_W_EVIN + e * SZ_W_EVIN), n0, kb * 64, scr, lane, a.in(I_LN_MIX_PRE) + (2 * e) * D); continue; } r -= 2 * I_EVIN;
        if (r < 2 * I_GLU) { const int e = r / I_GLU; r %= I_GLU; const int nb = r % 16, kb = r / 16;
            transpose_item(a.in(I_S5_WGLU) + (size_t)e * 512 * 512, 512, 512, nb * 32, 32, (bf16*)(ws + WS_W_GLU + e * SZ_W_GLU), nb * 32, kb * 64, scr, lane); continue; } r -= 2 * I_GLU;
        if (r < 2 * I_EVOUT) { const int e = r / I_EVOUT; r %= I_EVOUT; const int nb = r % 32, kb = r / 32;
            transpose_item(a.in(I_EV_W_OUT) + (size_t)e * D * D, D, D, nb * 32, 32, (bf16*)(ws + WS_W_EVOUT + e * SZ_W_EVOUT), nb * 32, kb * 64, scr, lane); continue; } r -= 2 * I_EVOUT;
        if (r < 2 * I_ODIN) { const int e = r / I_ODIN; r %= I_ODIN; const int nb = r % 128, kb = r / 128;
            transpose_item(a.in(I_OD_W_IN) + (size_t)e * D * 2 * MI, D, 2 * MI, nb * 32, 32, (bf16*)(ws + WS_W_ODIN + e * SZ_W_ODIN), nb * 32, kb * 64, scr, lane, a.in(I_LN_MIX_PRE) + (2 * e + 1) * D); continue; } r -= 2 * I_ODIN;
        if (r < 2 * I_ODOUT) { const int e = r / I_ODOUT; r %= I_ODOUT; const int nb = r % 32, kb = r / 32;
            transpose_item(a.in(I_OD_W_OUT) + (size_t)e * MI * D, MI, D, nb * 32, 32, (bf16*)(ws + WS_W_ODOUT + e * SZ_W_ODOUT), nb * 32, kb * 64, scr, lane); continue; } r -= 2 * I_ODOUT;
        if (r < 4 * I_UP) { const int l = r / I_UP; r %= I_UP; const int nb = r % 176, kb = r / 176, n0 = nb * 32;
            const int pn = n0 >> 8, half = (n0 >> 7) & 1, c = n0 & 127, sc0 = half * FF + pn * 128 + c;
            transpose_item(a.in(I_FFN_W_UP) + (size_t)l * D * 2 * FF, D, 2 * FF, sc0, 32, (bf16*)(ws + WS_W_UP + l * SZ_W_UP), n0, kb * 64, scr, lane, a.in(I_LN_FFN_PRE) + l * D); continue; } r -= 4 * I_UP;
        { const int l = r / I_DOWN; r %= I_DOWN; const int nb = r % 32, kb = r / 32;
            transpose_item(a.in(I_FFN_W_DOWN) + (size_t)l * FF * D, FF, D, nb * 32, 32, (bf16*)(ws + WS_W_DOWN + l * SZ_W_DOWN), nb * 32, kb * 64, scr, lane); }
    }
}

template <int XIN, int XOUT>
__device__ __forceinline__ void norm_phase(const bf16* mix, const float* gpost, const void* xin, void* xout, float* rs_out, int gw, int NGW, int lane) {
    f32x4 nv[4]; u32x2 nb[4], nm[4];
    f32x4 gp4[4];
#pragma unroll
    for (int j = 0; j < 4; ++j) gp4[j] = mix ? *((const f32x4*)gpost + lane + 64 * j) : (f32x4){0.f, 0.f, 0.f, 0.f};
    auto load_row = [&](int row) {
        if (XIN == 0) { const f32x4* xr = (const f32x4*)((const float*)xin + (size_t)row * D) + lane;
#pragma unroll
            for (int j = 0; j < 4; ++j) nv[j] = xr[64 * j]; }
        else { const u32x2* xr = (const u32x2*)((const bf16*)xin + (size_t)row * D) + lane;
#pragma unroll
            for (int j = 0; j < 4; ++j) nb[j] = xr[64 * j]; }
        if (mix) { const u32x2* mr = (const u32x2*)(mix + (size_t)row * D) + lane;
#pragma unroll
            for (int j = 0; j < 4; ++j) nm[j] = mr[64 * j]; } };
    load_row(gw < NTOK ? gw : 0);
    for (int row = gw; row < NTOK; row += NGW) {
        f32x4 v[4]; u32x2 mraw[4];
#pragma unroll
        for (int j = 0; j < 4; ++j) { v[j] = (XIN == 0) ? nv[j] : (f32x4){bflo(nb[j].x), bfhi(nb[j].x), bflo(nb[j].y), bfhi(nb[j].y)}; mraw[j] = nm[j]; }
        load_row((row + NGW < NTOK) ? row + NGW : row);
        if (mix) {
            f32x4 mv[4]; float s = 0.f;
#pragma unroll
            for (int j = 0; j < 4; ++j) { const u32x2 t = mraw[j]; mv[j] = (f32x4){bflo(t.x), bfhi(t.x), bflo(t.y), bfhi(t.y)}; s += (mv[j].x * mv[j].x + mv[j].y * mv[j].y) + (mv[j].z * mv[j].z + mv[j].w * mv[j].w); }
            const float rstd = rsqrtf(wave_sum(s) * (1.f / D) + EPS);
#pragma unroll
            for (int j = 0; j < 4; ++j) v[j] = v[j] + mv[j] * rstd * gp4[j];
        }
        if (XOUT == 0) { f32x4* xo = (f32x4*)((float*)xout + (size_t)row * D) + lane;
#pragma unroll
            for (int j = 0; j < 4; ++j) xo[64 * j] = v[j]; }
        else { u32x2* xo = (u32x2*)((bf16*)xout + (size_t)row * D) + lane;
#pragma unroll
            for (int j = 0; j < 4; ++j) { u32x2 o; o.x = pk2(v[j].x, v[j].y); o.y = pk2(v[j].z, v[j].w); xo[64 * j] = o; } }
        if (rs_out) {
            float s2 = 0.f;
#pragma unroll
            for (int j = 0; j < 4; ++j) s2 += (v[j].x * v[j].x + v[j].y * v[j].y) + (v[j].z * v[j].z + v[j].w * v[j].w);
            const float t2 = wave_sum(s2);
            if (lane == 0) *(f32x4*)(rs_out + 4 * (size_t)row) = (f32x4){t2, 0.f, 0.f, 0.f};
        }
    }
}

__device__ __forceinline__ void s5_unit_simple(const Ctx& a, int e, bf16* pbuf, bf16* yout, int ypitch, LAS unsigned char* lds, int wgS, int tid, int wave, int lane) {
    const int g = wgS & 31, b = (wgS >> 5) * 8 + wave, eg = e * S5G + g;
    LAS float* Cc = (LAS float*)lds;
    LAS float* X = (LAS float*)(lds + 16 * 132 * 4) + wave * (16 * 132);
    { const float* cre = a.in(I_S5_CRE) + (size_t)eg * 16 * 64; const float* cim = a.in(I_S5_CIM) + (size_t)eg * 16 * 64;
      for (int idx = tid; idx < 2048; idx += NTHREADS) { const int i = idx >> 7, c = idx & 127; Cc[i * 132 + c] = (c < 64) ? cre[i * 64 + c] : -cim[i * 64 + c - 64]; } }
    const int p = lane;
    const float dt = expf(a.in(I_S5_LOGDT)[eg]);
    const float lr = a.in(I_S5_LRE)[eg * 64 + p], li = a.in(I_S5_LIM)[eg * 64 + p];
    const float mag = expf(lr * dt), lbr = mag * cosf(li * dt), lbi = mag * sinf(li * dt);
    const float inv = 1.0f / (lr * lr + li * li);
    const float zr = ((lbr - 1.0f) * lr + lbi * li) * inv, zi = (lbi * lr - (lbr - 1.0f) * li) * inv;
    float bbr[16], bbi[16];
    { const float* bre = a.in(I_S5_BRE) + ((size_t)eg * 64 + p) * 16; const float* bim = a.in(I_S5_BIM) + ((size_t)eg * 64 + p) * 16;
#pragma unroll
      for (int i = 0; i < 16; ++i) { const float br = bre[i], bi = bim[i]; bbr[i] = zr * br - zi * bi; bbi[i] = zr * bi + zi * br; } }
    const int tt2 = lane >> 2, i0 = (lane & 3) * 4;
    const f32x4 dsk = *(const f32x4*)(a.in(I_S5_D) + eg * 16 + i0);
    __syncthreads();
    float xr = 0.f, xi = 0.f;
    for (int blk = 0; blk < SEQ / 64; ++blk) {
        const size_t tok0 = (size_t)b * SEQ + blk * 64;
        float uf[16];
        { const u32x4* up = (const u32x4*)(pbuf + (tok0 + lane) * EPAD + PC_U + g * 16); const u32x4 u0 = up[0], u1 = up[1];
          uf[0] = bflo(u0.x); uf[1] = bfhi(u0.x); uf[2] = bflo(u0.y); uf[3] = bfhi(u0.y); uf[4] = bflo(u0.z); uf[5] = bfhi(u0.z); uf[6] = bflo(u0.w); uf[7] = bfhi(u0.w);
          uf[8] = bflo(u1.x); uf[9] = bfhi(u1.x); uf[10] = bflo(u1.y); uf[11] = bfhi(u1.y); uf[12] = bflo(u1.z); uf[13] = bfhi(u1.z); uf[14] = bflo(u1.w); uf[15] = bfhi(u1.w); }
        for (int sb = 0; sb < 4; ++sb) {
            for (int tt = 0; tt < 16; ++tt) {
                const int t = sb * 16 + tt;
                float br = 0.f, bi = 0.f;
#pragma unroll
                for (int i = 0; i < 16; ++i) { const float s = __uint_as_float(__builtin_amdgcn_readlane(__float_as_uint(uf[i]), t)); br = fmaf(bbr[i], s, br); bi = fmaf(bbi[i], s, bi); }
                const float nxr = lbr * xr - lbi * xi + br, nxi = lbr * xi + lbi * xr + bi;
                xr = nxr; xi = nxi;
                X[tt * 132 + p] = xr; X[tt * 132 + 64 + p] = xi;
            }
            LDS_WAIT(); asm volatile("" ::: "memory");
            float y0 = 0.f, y1 = 0.f, y2 = 0.f, y3 = 0.f;
#pragma unroll 8
            for (int c4 = 0; c4 < 32; ++c4) {
                const f32x4 xv = *(const LAS f32x4*)(X + tt2 * 132 + 4 * c4);
                const f32x4 c0 = *(const LAS f32x4*)(Cc + (i0 + 0) * 132 + 4 * c4), c1 = *(const LAS f32x4*)(Cc + (i0 + 1) * 132 + 4 * c4);
                const f32x4 c2 = *(const LAS f32x4*)(Cc + (i0 + 2) * 132 + 4 * c4), c3 = *(const LAS f32x4*)(Cc + (i0 + 3) * 132 + 4 * c4);
                y0 += (xv.x * c0.x + xv.y * c0.y) + (xv.z * c0.z + xv.w * c0.w); y1 += (xv.x * c1.x + xv.y * c1.y) + (xv.z * c1.z + xv.w * c1.w);
                y2 += (xv.x * c2.x + xv.y * c2.y) + (xv.z * c2.z + xv.w * c2.w); y3 += (xv.x * c3.x + xv.y * c3.y) + (xv.z * c3.z + xv.w * c3.w);
            }
            { const bf16* up2 = pbuf + (tok0 + sb * 16 + tt2) * EPAD + PC_U + g * 16 + i0; const u32x2 uu = *(const u32x2*)up2; bf16* yp = yout + (tok0 + sb * 16 + tt2) * ypitch + g * 16 + i0;
              y0 += dsk.x * bflo(uu.x); y1 += dsk.y * bfhi(uu.x); y2 += dsk.z * bflo(uu.y); y3 += dsk.w * bfhi(uu.y);
              u32x2 o; o.x = pk2(gelu_t(y0), gelu_t(y1)); o.y = pk2(gelu_t(y2), gelu_t(y3)); *(u32x2*)yp = o; }
            LDS_WAIT(); asm volatile("" ::: "memory");
        }
    }
}

__device__ __forceinline__ void gla_unit_simple(const Ctx& a, int e_, const bf16* pbuf, bf16* yb2, LAS unsigned char* lds, int unit, int tid, int wave, int lane) {
    const int b = unit >> 2, h = unit & 3;
    LAS float* WUP = (LAS float*)lds;
    LAS float* Qs = WUP + 16 * 64;
    LAS float* Ks = Qs + 16 * 64;
    LAS float* As = Ks + 16 * 64;
    LAS float* Vs = As + 16 * 64;
    LAS float* Rs = Vs + 16 * 128;
    LAS float* OP = Rs + 16 * 128;
    { const float* wup = a.in(I_GLA_WUP) + (size_t)e_ * 16 * 256; for (int idx = tid; idx < 1024; idx += NTHREADS) { const int j = idx >> 6, d = idx & 63; WUP[idx] = wup[j * 256 + h * 64 + d]; } }
    const int e = tid & 127, dq = tid >> 7;
    const int st = tid >> 5, sl = tid & 31;
    const float ba0 = a.in(I_GLA_BALPHA)[e_ * 256 + h * 64 + 2 * sl], ba1 = a.in(I_GLA_BALPHA)[e_ * 256 + h * 64 + 2 * sl + 1];
    const int ft = tid >> 5, fe = (tid & 31) * 4;
    const f32x4 gnv = *(const f32x4*)(a.in(I_GLA_NORM) + e_ * 512 + h * 128 + fe);
    float S[16];
#pragma unroll
    for (int i = 0; i < 16; ++i) S[i] = 0.f;
    __syncthreads();
    for (int blk = 0; blk < SEQ / 16; ++blk) {
        const size_t tok0 = (size_t)b * SEQ + blk * 16;
        { const bf16* row = pbuf + (tok0 + st) * EPAD;
          const unsigned qq = *(const unsigned*)(row + PC_Q + h * 64 + 2 * sl), kk = *(const unsigned*)(row + PC_K + h * 64 + 2 * sl);
          const u32x2 vv = *(const u32x2*)(row + PC_V + h * 128 + 4 * sl), rr = *(const u32x2*)(row + PC_R + h * 128 + 4 * sl);
          const u32x4 a0 = *(const u32x4*)(row + PC_A), a1 = *(const u32x4*)(row + PC_A + 8);
          float al[16]; al[0] = bflo(a0.x); al[1] = bfhi(a0.x); al[2] = bflo(a0.y); al[3] = bfhi(a0.y); al[4] = bflo(a0.z); al[5] = bfhi(a0.z); al[6] = bflo(a0.w); al[7] = bfhi(a0.w);
          al[8] = bflo(a1.x); al[9] = bfhi(a1.x); al[10] = bflo(a1.y); al[11] = bfhi(a1.y); al[12] = bflo(a1.z); al[13] = bfhi(a1.z); al[14] = bflo(a1.w); al[15] = bfhi(a1.w);
          float z0 = ba0, z1 = ba1;
#pragma unroll
          for (int j = 0; j < 16; ++j) { z0 = fmaf(al[j], WUP[j * 64 + 2 * sl], z0); z1 = fmaf(al[j], WUP[j * 64 + 2 * sl + 1], z1); }
          Qs[st * 64 + 2 * sl] = bflo(qq) * 0.125f; Qs[st * 64 + 2 * sl + 1] = bfhi(qq) * 0.125f;
          Ks[st * 64 + 2 * sl] = bflo(kk); Ks[st * 64 + 2 * sl + 1] = bfhi(kk);
          As[st * 64 + 2 * sl] = expf(logsigm(z0) * (1.0f / 16.0f)); As[st * 64 + 2 * sl + 1] = expf(logsigm(z1) * (1.0f / 16.0f));
          *(LAS f32x4*)(Vs + st * 128 + 4 * sl) = (f32x4){bflo(vv.x), bfhi(vv.x), bflo(vv.y), bfhi(vv.y)};
          *(LAS f32x4*)(Rs + st * 128 + 4 * sl) = (f32x4){bflo(rr.x), bfhi(rr.x), bflo(rr.y), bfhi(rr.y)}; }
        __syncthreads();
        for (int t = 0; t < 16; ++t) {
            const float v = Vs[t * 128 + e]; float o = 0.f;
#pragma unroll
            for (int d4 = 0; d4 < 4; ++d4) {
                const f32x4 av = *(const LAS f32x4*)(As + t * 64 + dq * 16 + 4 * d4), kv = *(const LAS f32x4*)(Ks + t * 64 + dq * 16 + 4 * d4), qv = *(const LAS f32x4*)(Qs + t * 64 + dq * 16 + 4 * d4);
                S[4 * d4 + 0] = av.x * S[4 * d4 + 0] + kv.x * v; o = fmaf(qv.x, S[4 * d4 + 0], o);
                S[4 * d4 + 1] = av.y * S[4 * d4 + 1] + kv.y * v; o = fmaf(qv.y, S[4 * d4 + 1], o);
                S[4 * d4 + 2] = av.z * S[4 * d4 + 2] + kv.z * v; o = fmaf(qv.z, S[4 * d4 + 2], o);
                S[4 * d4 + 3] = av.w * S[4 * d4 + 3] + kv.w * v; o = fmaf(qv.w, S[4 * d4 + 3], o);
            }
            OP[(dq * 16 + t) * 128 + e] = o;
        }
        __syncthreads();
        { f32x4 o = *(const LAS f32x4*)(OP + (0 * 16 + ft) * 128 + fe);
          o = o + *(const LAS f32x4*)(OP + (1 * 16 + ft) * 128 + fe); o = o + *(const LAS f32x4*)(OP + (2 * 16 + ft) * 128 + fe); o = o + *(const LAS f32x4*)(OP + (3 * 16 + ft) * 128 + fe);
          float s = (o.x * o.x + o.y * o.y) + (o.z * o.z + o.w * o.w);
#pragma unroll
          for (int off = 1; off < 32; off <<= 1) s += __shfl_xor(s, off);
          const float rstd = rsqrtf(s * (1.0f / 128.0f) + EPS);
          const f32x4 r = *(const LAS f32x4*)(Rs + ft * 128 + fe);
          const f32x4 res = o * rstd * gnv * (f32x4){r.x * sigm(r.x), r.y * sigm(r.y), r.z * sigm(r.z), r.w * sigm(r.w)};
          u32x2 w; w.x = pk2(res.x, res.y); w.y = pk2(res.z, res.w);
          *(u32x2*)(yb2 + (tok0 + ft) * D + 512 + h * 128 + fe) = w; }
        __syncthreads();
    }
}

typedef short pp_bf16x8 __attribute__((ext_vector_type(8)));
__device__ __forceinline__ void prepass_frag_table(const Ctx& a, int gtid, int gthreads) {
    u32x4* gt = (u32x4*)(a.ws + WS_GFR);
    for (int i = gtid; i < 2 * 8 * 8 * 64; i += gthreads) {
        const int lane = i & 63, s8 = (i >> 6) & 7, w = (i >> 9) & 7, o_ = i >> 12;
        const int gn = lane & 7, q = lane >> 4; const float gon = ((lane & 15) < 8) ? 1.0f : 0.0f;
        const float* WG = a.in(I_ML_WGATE) + (size_t)o_ * 3 * MI * 8;
        unsigned wc_[4], wm_[4];
#pragma unroll
        for (int bb = 0; bb < 2; ++bb) {
            const int blk = 64 * w + 8 * s8 + 2 * q + bb;
            float g0[4], g1[4], g2[4];
#pragma unroll
            for (int d = 0; d < 4; ++d) { g0[d] = WG[((size_t)0 * MI + 4 * blk + d) * 8 + gn] * gon; g1[d] = WG[((size_t)1 * MI + 4 * blk + d) * 8 + gn] * gon; g2[d] = WG[((size_t)2 * MI + 4 * blk + d) * 8 + gn] * gon; }
            float vc[4], vm[4];
#pragma unroll
            for (int c = 0; c < 4; ++c) {
                const f32x4 wq = *(const f32x4*)(a.in(I_ML_WQ) + ((size_t)o_ * 512 + blk) * 16 + 4 * c), wk = *(const f32x4*)(a.in(I_ML_WK) + ((size_t)o_ * 512 + blk) * 16 + 4 * c),
                            wv = *(const f32x4*)(a.in(I_ML_WV) + ((size_t)o_ * 512 + blk) * 16 + 4 * c);
                float sc = 0.f, sm = 0.f;
#pragma unroll
                for (int d = 0; d < 4; ++d) { sc = fmaf(wq[d], g0[d], sc); sc = fmaf(wk[d], g1[d], sc); sm = fmaf(wv[d], g2[d], sm); }
                vc[c] = sc; vm[c] = sm; }
            wc_[2 * bb] = pk2(vc[0], vc[1]); wc_[2 * bb + 1] = pk2(vc[2], vc[3]); wm_[2 * bb] = pk2(vm[0], vm[1]); wm_[2 * bb + 1] = pk2(vm[2], vm[3]);
        }
        gt[((size_t)(o_ * 8 + w) * 16 + s8) * 64 + lane] = (u32x4){wc_[0], wc_[1], wc_[2], wc_[3]};
        gt[((size_t)(o_ * 8 + w) * 16 + 8 + s8) * 64 + lane] = (u32x4){wm_[0], wm_[1], wm_[2], wm_[3]};
    }
}
constexpr int PP_TP = 1040;
__device__ __forceinline__ void mlstm_prepass(const Ctx& a, int o_, const bf16* xm, bf16* xc, float* gates, LAS unsigned char* lds, int wg, int nwg, int tid, int wave, int lane) {
    LAS float* P = (LAS float*)lds;
    LAS unsigned char* T = lds + 16384 + wave * (16 * PP_TP);
    const int n = tid;
    f32x4 cw[4], cb;
#pragma unroll
    for (int k = 0; k < 4; ++k) cw[k] = *(const f32x4*)(a.in(I_ML_CONV_W) + ((size_t)o_ * 4 + k) * MI + 4 * n);
    cb = *(const f32x4*)(a.in(I_ML_CONV_B) + (size_t)o_ * MI + 4 * n);
    pp_bf16x8 gfr[16];
    { const u32x4* gt = (const u32x4*)(a.ws + WS_GFR) + ((size_t)(o_ * 8 + wave) * 16) * 64 + lane;
#pragma unroll
      for (int s = 0; s < 16; ++s) gfr[s] = __builtin_bit_cast(pp_bf16x8, gt[64 * s]); }
    for (int chunk = wg; chunk < NTOK / 256; chunk += nwg) {
        const size_t tokc = (size_t)chunk * 256;
        const int tpos0 = (int)(tokc % SEQ);
        f32x4 x0 = (f32x4){0.f, 0.f, 0.f, 0.f}, x1 = x0, x2 = x0;
        if (tpos0 > 0) {
            const u32x2 r0 = *(const u32x2*)(xm + (tokc - 3) * MI + 4 * n), r1 = *(const u32x2*)(xm + (tokc - 2) * MI + 4 * n), r2 = *(const u32x2*)(xm + (tokc - 1) * MI + 4 * n);
            x0 = (f32x4){bflo(r0.x), bfhi(r0.x), bflo(r0.y), bfhi(r0.y)}; x1 = (f32x4){bflo(r1.x), bfhi(r1.x), bflo(r1.y), bfhi(r1.y)}; x2 = (f32x4){bflo(r2.x), bfhi(r2.x), bflo(r2.y), bfhi(r2.y)};
        }
        u32x2 nxt[8];
#pragma unroll
        for (int j = 0; j < 8; ++j) nxt[j] = *(const u32x2*)(xm + (tokc + j) * MI + 4 * n);
        for (int sub = 0; sub < 4; ++sub) {
            for (int grp = 0; grp < 8; ++grp) {
                u32x2 cur[8];
#pragma unroll
                for (int j = 0; j < 8; ++j) cur[j] = nxt[j];
                { const size_t tn = tokc + sub * 64 + grp * 8 + 8; const size_t tnc = (tn + 8 <= tokc + 256) ? tn : tokc;
#pragma unroll
                  for (int j = 0; j < 8; ++j) nxt[j] = *(const u32x2*)(xm + (tnc + j) * MI + 4 * n); }
#pragma unroll
                for (int j8 = 0; j8 < 8; ++j8) {
                    const size_t tok = tokc + sub * 64 + grp * 8 + j8;
                    const u32x2 r3 = cur[j8];
                    const f32x4 x3 = (f32x4){bflo(r3.x), bfhi(r3.x), bflo(r3.y), bfhi(r3.y)};
                    f32x4 cv = cb + cw[0] * x0 + cw[1] * x1 + cw[2] * x2 + cw[3] * x3;
                    const f32x4 xcv = (f32x4){cv.x * sigm(cv.x), cv.y * sigm(cv.y), cv.z * sigm(cv.z), cv.w * sigm(cv.w)};
                    u32x2 w; w.x = pk2(xcv.x, xcv.y); w.y = pk2(xcv.z, xcv.w);
                    *(u32x2*)(xc + tok * MI + 4 * n) = w;
                    LAS unsigned char* trow = T + ((grp & 1) * 8 + j8) * PP_TP + 8 * lane;
                    *(LAS u32x2*)trow = w; *(LAS u32x2*)(trow + 512) = r3;
                    x0 = x1; x1 = x2; x2 = x3;
                }
                if (grp & 1) {
                    asm volatile("s_waitcnt lgkmcnt(0)" ::: "memory");
                    f32x4 d0 = (f32x4){0.f, 0.f, 0.f, 0.f}, d1 = d0;
                    const LAS unsigned char* arow = T + (lane & 15) * PP_TP + (lane >> 4) * 16;
#pragma unroll
                    for (int s = 0; s < 16; s += 2) {
                        const pp_bf16x8 a0 = *(const LAS pp_bf16x8*)(arow + (s >> 3) * 512 + (s & 7) * 64), a1 = *(const LAS pp_bf16x8*)(arow + ((s + 1) >> 3) * 512 + ((s + 1) & 7) * 64);
                        d0 = __builtin_amdgcn_mfma_f32_16x16x32_bf16(a0, gfr[s], d0, 0, 0, 0); d1 = __builtin_amdgcn_mfma_f32_16x16x32_bf16(a1, gfr[s + 1], d1, 0, 0, 0); }
                    d0 = d0 + d1;
                    if ((lane & 15) < 8) {
#pragma unroll
                        for (int r = 0; r < 4; ++r) P[(wave * 64 + (grp >> 1) * 16 + 4 * (lane >> 4) + r) * 8 + (lane & 15)] = d0[r]; }
                    asm volatile("" ::: "memory");
                }
            }
            __syncthreads();
            { const int tl = tid >> 3, g8 = tid & 7; float s = a.in(I_ML_BGATE)[o_ * 8 + g8];
#pragma unroll
              for (int w = 0; w < 8; ++w) s += P[(w * 64 + tl) * 8 + g8];
              if (g8 >= 4) s = logsigm(s);
              gates[(tokc + sub * 64 + tl) * 8 + g8] = s; }
            __syncthreads();
        }
    }
}

__device__ __forceinline__ void mlstm_unit_simple(const Ctx& a, int o_, bf16* xm, const bf16* xc, const float* gates, float* SS, LAS unsigned char* lds, int unit, int tid, int wave, int lane) {
    const int es = unit & 3, h = (unit >> 2) & 3, b = unit >> 4;
    LAS float* Qs = (LAS float*)lds;
    LAS float* Ks = Qs + 8 * 512;
    LAS float* Vs = Ks + 8 * 512;
    LAS float* HP = Vs + 8 * 128;
    LAS float* NQ = HP + 4 * 8 * 128;
    LAS float* GI = NQ + 64;
    LAS float* GF = GI + 8;
    LAS float* EM = GF + 8;
    const float kscale = 0.04419417382415922f;
    float C[128];
#pragma unroll
    for (int i = 0; i < 128; ++i) C[i] = 0.f;
    float nst = 0.f, mst = 0.f;
    for (int blk = 0; blk < SEQ / 8; ++blk) {
        const size_t tok0 = (size_t)b * SEQ + blk * 8;
        { int t2 = threadIdx.x; asm volatile("" : "+v"(t2));
          const int stt = t2 >> 6, sl = t2 & 63, nv = h * 128 + es * 32 + (sl >> 1), dv = 2 * (sl & 1);
          const size_t tok = tok0 + stt;
          int zoff = 0; asm volatile("" : "+v"(zoff));
          f32x4 wq0[4], wk0[4], wq1[4], wk1[4];
#pragma unroll
          for (int c = 0; c < 4; ++c) {
              wq0[c] = *(const f32x4*)(a.in(I_ML_WQ) + zoff + (((size_t)o_ * 512 + h * 128 + sl) * 4 + c) * 4); wk0[c] = *(const f32x4*)(a.in(I_ML_WK) + zoff + (((size_t)o_ * 512 + h * 128 + sl) * 4 + c) * 4);
              wq1[c] = *(const f32x4*)(a.in(I_ML_WQ) + zoff + (((size_t)o_ * 512 + h * 128 + sl + 64) * 4 + c) * 4); wk1[c] = *(const f32x4*)(a.in(I_ML_WK) + zoff + (((size_t)o_ * 512 + h * 128 + sl + 64) * 4 + c) * 4);
          }
          const u32x2 c0 = *(const u32x2*)(xc + tok * MI + h * 512 + 4 * sl), c1 = *(const u32x2*)(xc + tok * MI + h * 512 + 4 * (sl + 64));
          const f32x4 a0 = (f32x4){bflo(c0.x), bfhi(c0.x), bflo(c0.y), bfhi(c0.y)}, a1 = (f32x4){bflo(c1.x), bfhi(c1.x), bflo(c1.y), bfhi(c1.y)};
          *(LAS f32x4*)(Qs + stt * 512 + 4 * sl) = wq0[0] * a0.x + wq0[1] * a0.y + wq0[2] * a0.z + wq0[3] * a0.w;
          *(LAS f32x4*)(Ks + stt * 512 + 4 * sl) = (wk0[0] * a0.x + wk0[1] * a0.y + wk0[2] * a0.z + wk0[3] * a0.w) * kscale;
          *(LAS f32x4*)(Qs + stt * 512 + 4 * (sl + 64)) = wq1[0] * a1.x + wq1[1] * a1.y + wq1[2] * a1.z + wq1[3] * a1.w;
          *(LAS f32x4*)(Ks + stt * 512 + 4 * (sl + 64)) = (wk1[0] * a1.x + wk1[1] * a1.y + wk1[2] * a1.z + wk1[3] * a1.w) * kscale;
          f32x4 wvb[4];
#pragma unroll
          for (int c = 0; c < 4; ++c) wvb[c] = *(const f32x4*)(a.in(I_ML_WV) + zoff + (((size_t)o_ * 512 + nv) * 4 + c) * 4);
          const u32x2 xr = *(const u32x2*)(xm + tok * MI + 4 * nv);
          const f32x4 xv = (f32x4){bflo(xr.x), bfhi(xr.x), bflo(xr.y), bfhi(xr.y)};
          const f32x4 vv = wvb[0] * xv.x + wvb[1] * xv.y + wvb[2] * xv.z + wvb[3] * xv.w;
          Vs[stt * 128 + 2 * sl] = (dv == 0) ? vv.x : vv.z; Vs[stt * 128 + 2 * sl + 1] = (dv == 0) ? vv.y : vv.w;
          if (t2 < 8) { GI[t2] = gates[(tok0 + t2) * 8 + h]; GF[t2] = gates[(tok0 + t2) * 8 + 4 + h]; } }
        __syncthreads();
        int t3 = threadIdx.x; asm volatile("" : "+v"(t3));
        const int el = t3 & 127, dq = t3 >> 7;
#pragma unroll 1
        for (int t = 0; t < 8; ++t) {
            const float li = GI[t], lf = GF[t];
            const float mnew = fmaxf(lf + mst, li);
            const float fp = __expf(lf + mst - mnew), ip = __expf(li - mnew);
            mst = mnew;
            if (t3 == 0) EM[t] = __expf(-mnew);
            const float ipv = ip * Vs[t * 128 + el];
            float hp = 0.f;
#pragma unroll
            for (int d4 = 0; d4 < 32; ++d4) {
                if ((d4 & 7) == 0) __builtin_amdgcn_sched_barrier(0);
                const f32x4 kv = *(const LAS f32x4*)(Ks + t * 512 + dq * 128 + 4 * d4), qv = *(const LAS f32x4*)(Qs + t * 512 + dq * 128 + 4 * d4);
                C[4 * d4 + 0] = fmaf(fp, C[4 * d4 + 0], ipv * kv.x); hp = fmaf(C[4 * d4 + 0], qv.x, hp);
                C[4 * d4 + 1] = fmaf(fp, C[4 * d4 + 1], ipv * kv.y); hp = fmaf(C[4 * d4 + 1], qv.y, hp);
                C[4 * d4 + 2] = fmaf(fp, C[4 * d4 + 2], ipv * kv.z); hp = fmaf(C[4 * d4 + 2], qv.z, hp);
                C[4 * d4 + 3] = fmaf(fp, C[4 * d4 + 3], ipv * kv.w); hp = fmaf(C[4 * d4 + 3], qv.w, hp);
            }
            HP[(dq * 8 + t) * 128 + el] = hp;
            nst = fmaf(fp, nst, ip * Ks[t * 512 + t3]);
            const float nq = wave_sum(nst * Qs[t * 512 + t3]);
            if ((t3 & 63) == 0) NQ[(t3 >> 6) * 8 + t] = nq;
        }
        __syncthreads();
        { int t4 = threadIdx.x; asm volatile("" : "+v"(t4));
          const int ft = t4 >> 6, fe = (t4 & 63) * 2;
          float den = 0.f;
#pragma unroll
          for (int w = 0; w < 8; ++w) den += NQ[w * 8 + ft];
          const float dn = fmaxf(fabsf(den), EM[ft]);
          float h0 = HP[(0 * 8 + ft) * 128 + fe] + HP[(1 * 8 + ft) * 128 + fe] + HP[(2 * 8 + ft) * 128 + fe] + HP[(3 * 8 + ft) * 128 + fe];
          float h1 = HP[(0 * 8 + ft) * 128 + fe + 1] + HP[(1 * 8 + ft) * 128 + fe + 1] + HP[(2 * 8 + ft) * 128 + fe + 1] + HP[(3 * 8 + ft) * 128 + fe + 1];
          h0 /= dn; h1 /= dn;
          *(unsigned*)(xm + (tok0 + ft) * MI + h * 512 + es * 128 + fe) = pk2(h0, h1);
          const float ssq = wave_sum(h0 * h0 + h1 * h1);
          if ((t4 & 63) == 0) SS[(tok0 + ft) * 16 + h * 4 + es] = ssq; }
        __syncthreads();
    }
}

typedef short bf16x8v __attribute__((ext_vector_type(8)));
typedef short bf16x4v __attribute__((ext_vector_type(4)));
constexpr int ML_WQ = 0, ML_WK = 8192, ML_WV = 16384, ML_N = 18432, ML_QN = 22528, ML_RS = 22784, ML_NROW = 23808  , ML_GA = 25856, ML_GM = 26112, ML_GW = 26368, ML_GE = 26624, ML_RD = 26880, ML_QNL = 27136,
              ML_NP = 29184  , ML_WU = 33280  , ML_B0 = 35328;
constexpr int ML_P2 = 0  , ML_G2 = 9216  ;
constexpr int ML_QP = 272, ML_TP = 144, ML_BSTR = 2 * 64 * ML_QP + 128 * ML_TP, ML_VT = ML_B0 + 2 * ML_BSTR, ML_PS = ML_B0, ML_OT = ML_B0 + ML_BSTR, ML_END = ML_VT + 128 * ML_TP;
#define ML_QS_(b) (ML_B0 + (b) * ML_BSTR)
#define ML_KS_(b) (ML_B0 + (b) * ML_BSTR + 64 * ML_QP)
#define ML_KWT_(b) (ML_B0 + (b) * ML_BSTR + 2 * 64 * ML_QP)
static_assert(ML_END <= LDSCTL_OFF, "mLSTM LDS map");
__device__ __forceinline__ unsigned cvtpk(float lo, float hi) { return pg8::cvt_pk_bf16(lo, hi); }

typedef __bf16 bf16x2c __attribute__((ext_vector_type(2)));
__device__ __forceinline__ unsigned cvtpk_c(float lo, float hi) { const bf16x2c v = {(__bf16)lo, (__bf16)hi}; return __builtin_bit_cast(unsigned, v); }
__device__ __forceinline__ bf16x4v blockdiag_frag(const LAS float* T, int blk0, int l15, int g4) {
    const f32x4 w4 = *(const LAS f32x4*)(T + ((blk0 + g4) * 4 + (l15 & 3)) * 4);
    u32x2 p; p.x = cvtpk(w4[0], w4[1]); p.y = cvtpk(w4[2], w4[3]);
    if (g4 != (l15 >> 2)) { p.x = 0u; p.y = 0u; }
    return __builtin_bit_cast(bf16x4v, p);
}
template <int s>
__device__ __forceinline__ void ml_stage(LAS unsigned char* lds, const bf16* xc, size_t tokn, int h, int w, u32x2 (&pre)[4], const bf16x4v wqf, const bf16x4v wkf) {
    int l15, g4; { int t_ = threadIdx.x; asm volatile("" : "+v"(t_)); l15 = t_ & 15; g4 = (t_ & 63) >> 4;
      if (t_ < 128) { const int q_ = (t_ & 31) >> 2; *(LAS unsigned short*)(lds + ML_NROW + (s & 1) * 256 + 2 * ((t_ & ~31) + (((q_ & 3) * 2 + (q_ >> 2)) << 2) + (t_ & 3))) = bf_rne(*(const LAS float*)(lds + ML_N + 4 * (128 * s + t_))); } }
    const f32x4 z4 = (f32x4){0.f, 0.f, 0.f, 0.f};
    const int pcol = (w >> 1) * 64 + (2 * g4 + (w & 1)) * 8;
#pragma unroll
    for (int mb = 0; mb < 4; ++mb) {
        const bf16x4v xf = __builtin_bit_cast(bf16x4v, pre[mb]);
        const f32x4 qT = __builtin_amdgcn_mfma_f32_16x16x16bf16_1k(wqf, xf, z4, 0, 0, 0);
        const f32x4 kT = __builtin_amdgcn_mfma_f32_16x16x16bf16_1k(wkf, xf, z4, 0, 0, 0);
        const f32x4 kR = __builtin_amdgcn_mfma_f32_16x16x16bf16_1k(xf, wkf, z4, 0, 0, 0);
        const f32x4 wu4 = *(const LAS f32x4*)(lds + ML_WU + 4 * (64 * w + 16 * mb + 4 * g4));
        *(LAS u32x2*)(lds + ML_QS_(s & 1) + (16 * mb + l15) * ML_QP + pcol) = (u32x2){cvtpk_c(qT[0], qT[1]), cvtpk_c(qT[2], qT[3])};
        *(LAS u32x2*)(lds + ML_KS_(s & 1) + (16 * mb + l15) * ML_QP + pcol) = (u32x2){cvtpk_c(kT[0], kT[1]), cvtpk_c(kT[2], kT[3])};
        *(LAS u32x2*)(lds + ML_KWT_(s & 1) + (16 * w + l15) * ML_TP + (16 * mb + 4 * g4) * 2) = (u32x2){cvtpk_c(kR[0] * wu4[0], kR[1] * wu4[1]), cvtpk_c(kR[2] * wu4[2], kR[3] * wu4[3])};
    }
#pragma unroll
    for (int mb = 0; mb < 4; ++mb) pre[mb] = *(const u32x2*)(xc + (tokn + 16 * mb + l15) * MI + h * 512 + 128 * ((s + 2) & 3) + 16 * w + 4 * g4);
}
template <int s>
__device__ __forceinline__ void ml_compute(LAS unsigned char* lds, int w, int ib, int jb0, float decay, f32x4 (&acc)[32], f32x4 (&sacc)[2], f32x4 (&hin)[4], const bf16x8v vtf0, const bf16x8v vtf1) {
    int l15, g4; { int t_ = threadIdx.x; asm volatile("" : "+v"(t_)); l15 = t_ & 15; g4 = (t_ & 63) >> 4; }
#define ML_WAIT() do { asm volatile("s_waitcnt lgkmcnt(0)" ::: "memory"); __builtin_amdgcn_sched_barrier(0); } while (0)
            { bf16x8v qf[4], kb[2];
              const bool isn = (w == 2) || (w == 3);
              const int rot = (w <= 2) ? 0 : 2;
              const LAS unsigned char* qrow = lds + ML_QS_(s & 1) + l15 * ML_QP + (8 * g4) * 2;
              int qo[4];
#pragma unroll
              for (int t = 0; t < 4; ++t) qo[t] = 16 * ((t + rot) & 3) * ML_QP;
              const LAS unsigned char* krow = isn ? lds + ML_NROW + (s & 1) * 256 + (8 * g4) * 2 : lds + ML_KS_(s & 1) + (16 * (w & 3) + l15) * ML_QP + (8 * g4) * 2;
#pragma unroll
              for (int i4 = 0; i4 < 4; ++i4) qf[i4] = *(const LAS bf16x8v*)(qrow + qo[i4]);
              kb[0] = *(const LAS bf16x8v*)krow;
#pragma unroll
              for (int kk = 0; kk < 4; ++kk) {
                  __builtin_amdgcn_sched_barrier(0);
                  if (kk < 3) kb[(kk + 1) & 1] = *(const LAS bf16x8v*)(krow + 64 * (kk + 1));
                  const f32x4 c0 = acc[8 * s + 2 * kk], c1 = acc[8 * s + 2 * kk + 1];
                  u32x4 cbits; cbits.x = cvtpk(c0[0], c0[1]); cbits.y = cvtpk(c0[2], c0[3]); cbits.z = cvtpk(c1[0], c1[1]); cbits.w = cvtpk(c1[2], c1[3]);
                  const bf16x8v cb = __builtin_bit_cast(bf16x8v, cbits);
#pragma unroll
                  for (int i4 = 0; i4 < 4; ++i4) {
                      hin[i4] = __builtin_amdgcn_mfma_f32_16x16x32_bf16(cb, qf[i4], hin[i4], 0, 0, 0);
                      if (i4 < 2) sacc[i4] = __builtin_amdgcn_mfma_f32_16x16x32_bf16(qf[i4], kb[kk & 1], sacc[i4], 0, 0, 0);
                      __builtin_amdgcn_sched_barrier(0);
                      if (kk < 3) qf[i4] = *(const LAS bf16x8v*)(qrow + qo[i4] + 64 * (kk + 1));
                  }
              } }
            { bf16x8v ka[2][4];
              const LAS unsigned char* krow = lds + ML_KWT_(s & 1) + l15 * ML_TP + (8 * g4) * 2;
              ka[0][0] = *(const LAS bf16x8v*)krow; ka[0][1] = *(const LAS bf16x8v*)(krow + 64); ka[0][2] = *(const LAS bf16x8v*)(krow + 16 * ML_TP); ka[0][3] = *(const LAS bf16x8v*)(krow + 16 * ML_TP + 64);
#pragma unroll
              for (int gq = 0; gq < 4; ++gq) {
                  __builtin_amdgcn_sched_barrier(0);
                  if (gq < 3) { const LAS unsigned char* kr2 = krow + 32 * (gq + 1) * ML_TP;
                      ka[(gq + 1) & 1][0] = *(const LAS bf16x8v*)kr2; ka[(gq + 1) & 1][1] = *(const LAS bf16x8v*)(kr2 + 64); ka[(gq + 1) & 1][2] = *(const LAS bf16x8v*)(kr2 + 16 * ML_TP); ka[(gq + 1) & 1][3] = *(const LAS bf16x8v*)(kr2 + 16 * ML_TP + 64); }
                  __builtin_amdgcn_sched_barrier(0);
                  f32x4 c0 = acc[8 * s + 2 * gq] * decay, c1 = acc[8 * s + 2 * gq + 1] * decay;
                  c0 = __builtin_amdgcn_mfma_f32_16x16x32_bf16(ka[gq & 1][0], vtf0, c0, 0, 0, 0);
                  c1 = __builtin_amdgcn_mfma_f32_16x16x32_bf16(ka[gq & 1][2], vtf0, c1, 0, 0, 0);
                  c0 = __builtin_amdgcn_mfma_f32_16x16x32_bf16(ka[gq & 1][1], vtf1, c0, 0, 0, 0);
                  c1 = __builtin_amdgcn_mfma_f32_16x16x32_bf16(ka[gq & 1][3], vtf1, c1, 0, 0, 0);
                  acc[8 * s + 2 * gq] = c0; acc[8 * s + 2 * gq + 1] = c1;
                  if (gq == (w >> 1)) {
                      const bf16x8v ones = __builtin_bit_cast(bf16x8v, (u32x4){0x3f803f80u, 0x3f803f80u, 0x3f803f80u, 0x3f803f80u});
                      f32x4 rsum = (f32x4){0.f, 0.f, 0.f, 0.f};
                      if (w & 1) { rsum = __builtin_amdgcn_mfma_f32_16x16x32_bf16(ka[gq & 1][2], ones, rsum, 0, 0, 0); rsum = __builtin_amdgcn_mfma_f32_16x16x32_bf16(ka[gq & 1][3], ones, rsum, 0, 0, 0); }
                      else       { rsum = __builtin_amdgcn_mfma_f32_16x16x32_bf16(ka[gq & 1][0], ones, rsum, 0, 0, 0); rsum = __builtin_amdgcn_mfma_f32_16x16x32_bf16(ka[gq & 1][1], ones, rsum, 0, 0, 0); }
                      if (l15 == 0) { LAS f32x4* np_ = (LAS f32x4*)(lds + ML_N + 4 * (128 * s + 16 * w + 4 * g4)); *np_ = *np_ * decay + rsum; } }
              } }
}
__device__ __forceinline__ void ml_nupdate(LAS unsigned char* lds, int s, float decay) {
    int tid = threadIdx.x; asm volatile("" : "+v"(tid));
    LAS float* NST = (LAS float*)(lds + ML_N); LAS float* NP = (LAS float*)(lds + ML_NP) + (s & 1) * 512;
    if (tid < 128) NST[128 * s + tid] = decay * NST[128 * s + tid] + ((NP[tid] + NP[128 + tid]) + (NP[256 + tid] + NP[384 + tid]));
}
__device__ __forceinline__ void mlstm_unit_mfma(const Ctx& a, int o_, bf16* xm, const bf16* xc, const float* gates, float* SS, LAS unsigned char* lds, int unit, bool store_out) {
    int tid = threadIdx.x; asm volatile("" : "+v"(tid));
    const int w = __builtin_amdgcn_readfirstlane(tid >> 6);
    const int es = unit & 3, h = (unit >> 2) & 3, b = unit >> 4;
    LAS float* WQ = (LAS float*)(lds + ML_WQ); LAS float* WK = (LAS float*)(lds + ML_WK); LAS float* WV = (LAS float*)(lds + ML_WV);
    LAS float* NST = (LAS float*)(lds + ML_N); LAS float* RS = (LAS float*)(lds + ML_RS);
    { const float* wq = a.in(I_ML_WQ) + ((size_t)o_ * 512 + h * 128) * 16; const float* wk = a.in(I_ML_WK) + ((size_t)o_ * 512 + h * 128) * 16; const float* wv = a.in(I_ML_WV) + ((size_t)o_ * 512 + h * 128 + es * 32) * 16;
      for (int i = tid; i < 2048; i += NTHREADS) { const int ti = (i & ~15) | ((i & 3) << 2) | ((i >> 2) & 3);
          WQ[ti] = wq[i]; WK[ti] = wk[i] * 0.04419417382415922f; }
      NST[tid] = 0.f; WV[(tid & ~15) | ((tid & 3) << 2) | ((tid >> 2) & 3)] = wv[tid]; }
    f32x4 acc[32];
#pragma unroll
    for (int i = 0; i < 32; ++i) acc[i] = (f32x4){0.f, 0.f, 0.f, 0.f};
    float mst = 0.f;
    const int ib = 2 * (w >> 2), jb0 = w & 3;
    u32x2 pre[4], pre1[4], vpre[4]; float gli, glf;
    { const int l0 = tid & 63, f15 = tid & 15, fg4 = l0 >> 4; const size_t t0 = (size_t)b * SEQ + l0, tb = (size_t)b * SEQ;
#pragma unroll
      for (int mb = 0; mb < 4; ++mb) { pre[mb] = *(const u32x2*)(xc + (tb + 16 * mb + f15) * MI + h * 512 + 16 * w + 4 * fg4); pre1[mb] = *(const u32x2*)(xc + (tb + 16 * mb + f15) * MI + h * 512 + 128 + 16 * w + 4 * fg4); vpre[mb] = *(const u32x2*)(xm + (tb + 16 * mb + f15) * MI + h * 512 + es * 128 + 16 * w + 4 * fg4); }
      gli = gates[t0 * 8 + h]; glf = gates[t0 * 8 + 4 + h]; }
    __syncthreads();
    bf16x4v wqs[4], wks[4];
    { const int fl15 = tid & 15, fg4 = (tid & 63) >> 4;
#pragma unroll
      for (int s = 0; s < 4; ++s) { wqs[s] = blockdiag_frag((const LAS float*)(lds + ML_WQ), 32 * s + 4 * w, fl15, fg4); wks[s] = blockdiag_frag((const LAS float*)(lds + ML_WK), 32 * s + 4 * w, fl15, fg4); } }
    const bf16x4v wvf = blockdiag_frag((const LAS float*)(lds + ML_WV), 4 * w, tid & 15, (tid & 63) >> 4);
    __syncthreads();
    for (int ch = 0; ch < SEQ / 64; ++ch) {
        const size_t tok0 = (size_t)b * SEQ + ch * 64;
        int tid = threadIdx.x; asm volatile("" : "+v"(tid));
        const int lane = tid & 63, l15 = lane & 15, g4 = lane >> 4;
        const int gp = ML_G2 + (ch & 1) * 1024;
        float decay, flast, M63;
        { const float li = gli, lf = glf;
          { const size_t tn = (ch + 1 < SEQ / 64) ? tok0 + 64 + lane : tok0 + lane; gli = gates[tn * 8 + h]; glf = gates[tn * 8 + 4 + h]; }
          const float fc = wave_scan_sum(lf, lane), av = li - fc, Mv = fmaxf(mst, wave_scan_max(av, lane));
          M63 = __uint_as_float(__builtin_amdgcn_readlane(__float_as_uint(Mv), 63)); flast = __uint_as_float(__builtin_amdgcn_readlane(__float_as_uint(fc), 63));
          decay = __expf(mst - M63);
          *(LAS float*)(lds + ML_WU + 4 * (64 * w + lane)) = __expf(av - M63);
          if (w == 0) { *(LAS float*)(lds + gp + 4 * lane) = av; *(LAS float*)(lds + gp + 256 + 4 * lane) = Mv; *(LAS float*)(lds + gp + 512 + 4 * lane) = __expf(mst - Mv); *(LAS float*)(lds + gp + 768 + 4 * lane) = __expf(-(fc + Mv)); } }
        LDS_WAIT(); asm volatile("" ::: "memory");
        {
#pragma unroll
          for (int mb = 0; mb < 4; ++mb) {
              const f32x4 vR = __builtin_amdgcn_mfma_f32_16x16x16bf16_1k(__builtin_bit_cast(bf16x4v, vpre[mb]), wvf, (f32x4){0.f, 0.f, 0.f, 0.f}, 0, 0, 0);
              *(LAS u32x2*)(lds + ML_VT + (16 * w + l15) * ML_TP + (16 * mb + 4 * g4) * 2) = (u32x2){cvtpk_c(vR[0], vR[1]), cvtpk_c(vR[2], vR[3])}; } }
        const size_t tokn = (ch + 1 < SEQ / 64) ? tok0 + 64 : tok0;
        f32x4 sacc[2] = {(f32x4){0.f, 0.f, 0.f, 0.f}, (f32x4){0.f, 0.f, 0.f, 0.f}};
        f32x4 hin[4] = {(f32x4){0.f, 0.f, 0.f, 0.f}, (f32x4){0.f, 0.f, 0.f, 0.f}, (f32x4){0.f, 0.f, 0.f, 0.f}, (f32x4){0.f, 0.f, 0.f, 0.f}};
        ml_stage<0>(lds, xc, tok0, h, w, pre, wqs[0], wks[0]);
        __syncthreads();
        if (ch > 0 && w == 0 && store_out) { const LAS float* sq = (const LAS float*)(lds + ML_NP) + ((ch - 1) & 1) * 512 + lane; float sum = 0.f;
#pragma unroll
            for (int ww = 0; ww < 8; ++ww) sum += sq[64 * ww];
            SS[(tok0 - 64 + lane) * 16 + h * 4 + es] = sum; }
        const bf16x8v vtf0 = *(const LAS bf16x8v*)(lds + ML_VT + (16 * w + l15) * ML_TP + (8 * g4) * 2), vtf1 = *(const LAS bf16x8v*)(lds + ML_VT + (16 * w + l15) * ML_TP + (32 + 8 * g4) * 2);
        ml_compute<0>(lds, w, ib, jb0, decay, acc, sacc, hin, vtf0, vtf1);
        ml_stage<1>(lds, xc, tok0, h, w, pre1, wqs[1], wks[1]);
        __syncthreads();
        ml_compute<1>(lds, w, ib, jb0, decay, acc, sacc, hin, vtf0, vtf1);
        ml_stage<2>(lds, xc, tokn, h, w, pre, wqs[2], wks[2]);
        __syncthreads();
        ml_compute<2>(lds, w, ib, jb0, decay, acc, sacc, hin, vtf0, vtf1);
        ml_stage<3>(lds, xc, tokn, h, w, pre1, wqs[3], wks[3]);
        __syncthreads();
        ml_compute<3>(lds, w, ib, jb0, decay, acc, sacc, hin, vtf0, vtf1);
#pragma unroll
        for (int mb = 0; mb < 4; ++mb) vpre[mb] = *(const u32x2*)(xm + (tokn + 16 * mb + l15) * MI + h * 512 + es * 128 + 16 * w + 4 * g4);
#pragma unroll
        for (int jj = 0; jj < 2; ++jj) {
            const int ibj = ib + jj, jb = jb0, jcol = 16 * jb + l15;
            const float aj = *(const LAS float*)(lds + gp + 4 * jcol);
            float p[4];
            const f32x4 Mi4 = *(const LAS f32x4*)(lds + gp + 256 + 4 * (16 * ibj + 4 * g4));
#pragma unroll
            for (int r = 0; r < 4; ++r) { const int irow = 16 * ibj + 4 * g4 + r; const float Mi = Mi4[r];
                p[r] = (jb <= ibj && jcol <= irow) ? sacc[jj][r] * __expf(aj - Mi) : 0.f;
                *(LAS unsigned short*)(lds + ML_P2 + irow * ML_TP + jcol * 2) = bf_rne(p[r]);
                const float rs = row16_sum(p[r]);
                if (l15 == 0) RS[jb * 64 + irow] = rs; }
        }
        if ((w == 2 || w == 3) && l15 == 0) { const int r0 = 32 * (w - 2) + 4 * g4; *(LAS f32x4*)(lds + ML_QN + 4 * r0) = sacc[0]; *(LAS f32x4*)(lds + ML_QN + 4 * (r0 + 16)) = sacc[1]; }
        __syncthreads();
        { const float qn = *(const LAS float*)(lds + ML_QN + 4 * lane);
          const float den = ((RS[lane] + RS[64 + lane]) + (RS[128 + lane] + RS[192 + lane])) + *(const LAS float*)(lds + gp + 512 + 4 * lane) * qn;
          *(LAS float*)(lds + ML_RD + 4 * lane) = 1.0f / fmaxf(fabsf(den), *(const LAS float*)(lds + gp + 768 + 4 * lane));
          { bf16x8v pa[2][2];
            const int rot = (w <= 2) ? 0 : 2;
            const LAS unsigned char* prow = lds + ML_P2 + l15 * ML_TP + (8 * g4) * 2;
            pa[0][0] = *(const LAS bf16x8v*)(prow + 16 * rot * ML_TP); pa[0][1] = *(const LAS bf16x8v*)(prow + 16 * rot * ML_TP + 64);
#pragma unroll
            for (int t4 = 0; t4 < 4; ++t4) {
              const int i4 = (t4 + rot) & 3, i4n = (t4 + 1 + rot) & 3;
              __builtin_amdgcn_sched_barrier(0);
              if (t4 < 3) { pa[(t4 + 1) & 1][0] = *(const LAS bf16x8v*)(prow + 16 * i4n * ML_TP); pa[(t4 + 1) & 1][1] = *(const LAS bf16x8v*)(prow + 16 * i4n * ML_TP + 64); }
              const float wi = *(const LAS float*)(lds + gp + 512 + 4 * (16 * i4 + l15)), rd = *(const LAS float*)(lds + ML_RD + 4 * (16 * i4 + l15));
              __builtin_amdgcn_sched_barrier(0);
              f32x4 hx = (f32x4){0.f, 0.f, 0.f, 0.f};
              hx = __builtin_amdgcn_mfma_f32_16x16x32_bf16(vtf0, pa[t4 & 1][0], hx, 0, 0, 0);
              hx = __builtin_amdgcn_mfma_f32_16x16x32_bf16(vtf1, pa[t4 & 1][1], hx, 0, 0, 0);
              const f32x4 hv = (hx + hin[t4] * wi) * rd;
              u32x2 o; o.x = cvtpk_c(hv[0], hv[1]); o.y = cvtpk_c(hv[2], hv[3]);
              if (store_out) *(u32x2*)(xm + (tok0 + 16 * i4 + l15) * MI + h * 512 + es * 128 + 16 * w + 4 * g4) = o;
              const float e0 = bflo(o.x), e1 = bfhi(o.x), e2 = bflo(o.y), e3 = bfhi(o.y);
              float sq = (e0 * e0 + e1 * e1) + (e2 * e2 + e3 * e3);
              sq += __shfl_xor(sq, 16); sq += __shfl_xor(sq, 32);
              if (g4 == 0) *(LAS float*)(lds + ML_NP + 4 * (((ch & 1) * 8 + w) * 64 + 16 * i4 + l15)) = sq;
            } } }
        mst = flast + M63;
    }
    __syncthreads();
    { int t5 = threadIdx.x; asm volatile("" : "+v"(t5));
      if (t5 < 64 && store_out) { const LAS float* sq = (const LAS float*)(lds + ML_NP) + ((SEQ / 64 - 1) & 1) * 512 + t5; float sum = 0.f;
#pragma unroll
          for (int ww = 0; ww < 8; ++ww) sum += sq[64 * ww];
          SS[((size_t)b * SEQ + SEQ - 64 + t5) * 16 + h * 4 + es] = sum; } }
}

constexpr int GL_WUP = 0, GL_DEC = 4096, GL_SSQ = 4352, GL_RSTD = 6400, GL_QD = 8192, GL_QP = 144, GL_KD = GL_QD + 64 * GL_QP, GL_KUT = GL_KD + 64 * GL_QP, GL_VT = GL_KUT + 64 * GL_QP, GL_PS = GL_VT + 128 * GL_QP,
              GL_OT = GL_PS + 64 * GL_QP, GL_OP = 528, GL_END = GL_OT + 64 * GL_OP;
static_assert(GL_END <= RING_BYTES, "GLA LDS map");
constexpr int GL_IN = 98304, GL_IP = 848, GL_NPIECE = 50;
static_assert(GL_IN >= GL_END && GL_IN + 64 * GL_IP <= LDSCTL_OFF, "GLA input tile");
__device__ __forceinline__ void gla_unit_mfma(const Ctx& a, int e_, const bf16* pbuf, bf16* yb2, LAS unsigned char* lds, int unit) {
    int tid0 = threadIdx.x; asm volatile("" : "+v"(tid0));
    const int w = __builtin_amdgcn_readfirstlane(tid0 >> 6);
    const int b = unit >> 2, h = unit & 3;
    LAS float* WUP = (LAS float*)(lds + GL_WUP);
    { const float* wup = a.in(I_GLA_WUP) + (size_t)e_ * 16 * 256; for (int idx = tid0; idx < 1024; idx += NTHREADS) { const int j = idx >> 6, d = idx & 63; WUP[d * 16 + j] = wup[j * 256 + h * 64 + d]; } }
    f32x4 acc[4];
#pragma unroll
    for (int i = 0; i < 4; ++i) acc[i] = (f32x4){0.f, 0.f, 0.f, 0.f};
    const int ib = w >> 1, jb0 = 2 * (w & 1);
    float balpha[8];
    { const float* bp = a.in(I_GLA_BALPHA) + e_ * 256 + h * 64 + 8 * w;
#pragma unroll
      for (int c = 0; c < 8; ++c) balpha[c] = bp[c]; }
    f32x4 gnv[4];
    { const float* gnp = a.in(I_GLA_NORM) + e_ * 512 + h * 128 + 16 * (tid0 & 7);
#pragma unroll
      for (int c4 = 0; c4 < 4; ++c4) gnv[c4] = *(const f32x4*)(gnp + 4 * c4); }
    unsigned psrc[7], pdst[7];
#pragma unroll
    for (int i = 0; i < 7; ++i) { const int p = tid0 + 512 * i, tk = (p < 64 * GL_NPIECE ? p : 0) / GL_NPIECE, j = (p < 64 * GL_NPIECE ? p : 0) % GL_NPIECE;
        const int so = j < 8 ? PC_Q + h * 64 + 8 * j : j < 16 ? PC_K + h * 64 + 8 * (j - 8) : j < 18 ? PC_A + 8 * (j - 16) : j < 34 ? PC_V + h * 128 + 8 * (j - 18) : PC_R + h * 128 + 8 * (j - 34);
        const int dof = j < 8 ? 16 * j : j < 16 ? 128 + 16 * (j - 8) : j < 18 ? 256 + 16 * (j - 16) : j < 34 ? 288 + 16 * (j - 18) : 544 + 16 * (j - 34);
        psrc[i] = (unsigned)(tk * EPAD + so); pdst[i] = (unsigned)(GL_IN + tk * GL_IP + dof); }
    const bool p6 = tid0 + 512 * 6 < 64 * GL_NPIECE;
    u32x4 pf[7];
    { const bf16* cb_ = pbuf + (size_t)b * SEQ * EPAD;
#pragma unroll
      for (int i = 0; i < 7; ++i) if (i < 6 || p6) pf[i] = *(const u32x4*)(cb_ + psrc[i]);
#pragma unroll
      for (int i = 0; i < 7; ++i) if (i < 6 || p6) *(LAS u32x4*)(lds + pdst[i]) = pf[i]; }
    __syncthreads();
    for (int ch = 0; ch < SEQ / 64; ++ch) {
        const size_t tok0 = (size_t)b * SEQ + ch * 64;
        int tid = threadIdx.x; asm volatile("" : "+v"(tid));
        const int lane = tid & 63, l15 = lane & 15, g4 = lane >> 4;
        { const bf16* cb_ = pbuf + ((ch + 1 < SEQ / 64) ? tok0 + 64 : tok0) * EPAD;
#pragma unroll
          for (int i = 0; i < 7; ++i) if (i < 6 || p6) pf[i] = *(const u32x4*)(cb_ + psrc[i]); }
        u32x4 rg0, rg1;
        { const LAS unsigned char* rrow = lds + GL_IN + (tid >> 3) * GL_IP + 544 + 32 * (tid & 7); rg0 = *(const LAS u32x4*)rrow; rg1 = *(const LAS u32x4*)(rrow + 16); }
        { const LAS unsigned char* trow = lds + GL_IN + lane * GL_IP;
          const u32x4 qr = *(const LAS u32x4*)(trow + 16 * w), kr = *(const LAS u32x4*)(trow + 128 + 16 * w), a0 = *(const LAS u32x4*)(trow + 256), a1 = *(const LAS u32x4*)(trow + 272);
          float al[16]; al[0] = bflo(a0.x); al[1] = bfhi(a0.x); al[2] = bflo(a0.y); al[3] = bfhi(a0.y); al[4] = bflo(a0.z); al[5] = bfhi(a0.z); al[6] = bflo(a0.w); al[7] = bfhi(a0.w);
          al[8] = bflo(a1.x); al[9] = bfhi(a1.x); al[10] = bflo(a1.y); al[11] = bfhi(a1.y); al[12] = bflo(a1.z); al[13] = bfhi(a1.z); al[14] = bflo(a1.w); al[15] = bfhi(a1.w);
          const float qf[8] = {bflo(qr.x), bfhi(qr.x), bflo(qr.y), bfhi(qr.y), bflo(qr.z), bfhi(qr.z), bflo(qr.w), bfhi(qr.w)};
          const float kf[8] = {bflo(kr.x), bfhi(kr.x), bflo(kr.y), bfhi(kr.y), bflo(kr.z), bfhi(kr.z), bflo(kr.w), bfhi(kr.w)};
          unsigned qd[4], kd[4];
          float qprev = 0.f, kprev = 0.f;
#pragma unroll
          for (int c = 0; c < 8; ++c) {
              const int d = 8 * w + c;
              float z = balpha[c];
#pragma unroll
              for (int j4 = 0; j4 < 4; ++j4) { const f32x4 wv = *(const LAS f32x4*)(WUP + d * 16 + 4 * j4); z = fmaf(al[4 * j4], wv[0], z); z = fmaf(al[4 * j4 + 1], wv[1], z); z = fmaf(al[4 * j4 + 2], wv[2], z); z = fmaf(al[4 * j4 + 3], wv[3], z); }
              const float la = logsigm_fast(z) * (1.0f / 16.0f);
              const float gi = wave_scan_sum(la, lane);
              const float gl = __uint_as_float(__builtin_amdgcn_readlane(__float_as_uint(gi), 63));
              const float qv = qf[c] * __expf(gi) * 0.125f, kv = kf[c] * __expf(-gi), ku = kf[c] * __expf(gl - gi);
              *(LAS unsigned short*)(lds + GL_KUT + d * GL_QP + lane * 2) = bf_rne(ku);
              if (lane == 0) *(LAS float*)(lds + GL_DEC + 4 * d) = __expf(gl);
              if (c & 1) { qd[c >> 1] = cvtpk(qprev, qv); kd[c >> 1] = cvtpk(kprev, kv); } else { qprev = qv; kprev = kv; }
          }
          *(LAS u32x4*)(lds + GL_QD + lane * GL_QP + 16 * w) = (u32x4){qd[0], qd[1], qd[2], qd[3]};
          *(LAS u32x4*)(lds + GL_KD + lane * GL_QP + 16 * w) = (u32x4){kd[0], kd[1], kd[2], kd[3]};
        }
        __syncthreads();
        bf16x8v vtf0, vtf1;
        { typedef short v4i16_t __attribute__((ext_vector_type(4)));
          LAS unsigned char* vb = lds + GL_IN + (8 * g4 + (l15 >> 2)) * GL_IP + 288 + 32 * w + 8 * (l15 & 3);
          const v4i16_t l0 = __builtin_amdgcn_ds_read_tr16_b64_v4i16((LAS v4i16_t*)vb), h0 = __builtin_amdgcn_ds_read_tr16_b64_v4i16((LAS v4i16_t*)(vb + 4 * GL_IP)),
                        l1 = __builtin_amdgcn_ds_read_tr16_b64_v4i16((LAS v4i16_t*)(vb + 32 * GL_IP)), h1 = __builtin_amdgcn_ds_read_tr16_b64_v4i16((LAS v4i16_t*)(vb + 36 * GL_IP));
          vtf0 = (bf16x8v){l0[0], l0[1], l0[2], l0[3], h0[0], h0[1], h0[2], h0[3]}; vtf1 = (bf16x8v){l1[0], l1[1], l1[2], l1[3], h1[0], h1[1], h1[2], h1[3]}; }
        f32x4 sacc[2] = {(f32x4){0.f, 0.f, 0.f, 0.f}, (f32x4){0.f, 0.f, 0.f, 0.f}};
#pragma unroll
        for (int kk = 0; kk < 2; ++kk) {
            const bf16x8v qa = *(const LAS bf16x8v*)(lds + GL_QD + (16 * ib + l15) * GL_QP + (32 * kk + 8 * g4) * 2);
#pragma unroll
            for (int jj = 0; jj < 2; ++jj) if (jb0 + jj <= ib) {
                const bf16x8v kb = *(const LAS bf16x8v*)(lds + GL_KD + (16 * (jb0 + jj) + l15) * GL_QP + (32 * kk + 8 * g4) * 2);
                sacc[jj] = __builtin_amdgcn_mfma_f32_16x16x32_bf16(qa, kb, sacc[jj], 0, 0, 0); }
        }
        f32x4 hin[4] = {(f32x4){0.f, 0.f, 0.f, 0.f}, (f32x4){0.f, 0.f, 0.f, 0.f}, (f32x4){0.f, 0.f, 0.f, 0.f}, (f32x4){0.f, 0.f, 0.f, 0.f}};
#pragma unroll
        for (int kk = 0; kk < 2; ++kk) {
            const f32x4 c0 = acc[2 * kk], c1 = acc[2 * kk + 1];
            u32x4 cbits; cbits.x = cvtpk(c0[0], c0[1]); cbits.y = cvtpk(c0[2], c0[3]); cbits.z = cvtpk(c1[0], c1[1]); cbits.w = cvtpk(c1[2], c1[3]);
            const bf16x8v cb = __builtin_bit_cast(bf16x8v, cbits);
#pragma unroll
            for (int i4 = 0; i4 < 4; ++i4) {
                const u32x2 qlo = *(const LAS u32x2*)(lds + GL_QD + (16 * i4 + l15) * GL_QP + (32 * kk + 4 * g4) * 2), qhi = *(const LAS u32x2*)(lds + GL_QD + (16 * i4 + l15) * GL_QP + (32 * kk + 16 + 4 * g4) * 2);
                const bf16x8v qa = __builtin_bit_cast(bf16x8v, (u32x4){qlo.x, qlo.y, qhi.x, qhi.y});
                hin[i4] = __builtin_amdgcn_mfma_f32_16x16x32_bf16(qa, cb, hin[i4], 0, 0, 0); }
        }
#pragma unroll
        for (int db = 0; db < 4; ++db) {
            const f32x4 dec = *(const LAS f32x4*)(lds + GL_DEC + 4 * (16 * db + 4 * g4));
            f32x4 c = acc[db] * dec;
            const bf16x8v ka0 = *(const LAS bf16x8v*)(lds + GL_KUT + (16 * db + l15) * GL_QP + (8 * g4) * 2), ka1 = *(const LAS bf16x8v*)(lds + GL_KUT + (16 * db + l15) * GL_QP + (32 + 8 * g4) * 2);
            c = __builtin_amdgcn_mfma_f32_16x16x32_bf16(ka0, vtf0, c, 0, 0, 0);
            c = __builtin_amdgcn_mfma_f32_16x16x32_bf16(ka1, vtf1, c, 0, 0, 0);
            acc[db] = c; }
#pragma unroll
        for (int jj = 0; jj < 2; ++jj) {
            const int jb = jb0 + jj, jcol = 16 * jb + l15;
#pragma unroll
            for (int r = 0; r < 4; ++r) { const int irow = 16 * ib + 4 * g4 + r;
                const float p = (jb <= ib && jcol <= irow) ? sacc[jj][r] : 0.f;
                *(LAS unsigned short*)(lds + GL_PS + irow * GL_QP + jcol * 2) = bf_rne(p); }
        }
        __syncthreads();
#pragma unroll
        for (int i4 = 0; i4 < 4; ++i4) {
            const bf16x8v pa0 = *(const LAS bf16x8v*)(lds + GL_PS + (16 * i4 + l15) * GL_QP + (8 * g4) * 2), pa1 = *(const LAS bf16x8v*)(lds + GL_PS + (16 * i4 + l15) * GL_QP + (32 + 8 * g4) * 2);
            f32x4 hx = hin[i4];
            hx = __builtin_amdgcn_mfma_f32_16x16x32_bf16(pa0, vtf0, hx, 0, 0, 0);
            hx = __builtin_amdgcn_mfma_f32_16x16x32_bf16(pa1, vtf1, hx, 0, 0, 0);
            f32x4 sq4;
#pragma unroll
            for (int r = 0; r < 4; ++r) { const int irow = 16 * i4 + 4 * g4 + r;
                *(LAS float*)(lds + GL_OT + irow * GL_OP + (16 * w + l15) * 4) = hx[r];
                sq4[r] = row16_sum(hx[r] * hx[r]); }
            if (l15 == 0) *(LAS f32x4*)(lds + GL_SSQ + 4 * (w * 64 + 16 * i4 + 4 * g4)) = sq4;
        }
        __syncthreads();
        { const int orow = tid >> 3, op = tid & 7;
          float ss = 0.f;
#pragma unroll
          for (int ww = 0; ww < 8; ++ww) ss += *(const LAS float*)(lds + GL_SSQ + 4 * (ww * 64 + orow));
          const float rstd = rsqrtf(ss * (1.0f / 128.0f) + EPS);
          const u32x4 r0 = rg0, r1 = rg1;
          const unsigned rr[8] = {r0.x, r0.y, r0.z, r0.w, r1.x, r1.y, r1.z, r1.w};
          unsigned ow[8];
#pragma unroll
          for (int c4 = 0; c4 < 4; ++c4) {
              const f32x4 o = *(const LAS f32x4*)(lds + GL_OT + orow * GL_OP + (16 * op + 4 * c4) * 4); const f32x4 gn = gnv[c4];
              const float r_0 = bflo(rr[2 * c4]), r_1 = bfhi(rr[2 * c4]), r_2 = bflo(rr[2 * c4 + 1]), r_3 = bfhi(rr[2 * c4 + 1]);
              ow[2 * c4] = cvtpk(o.x * rstd * gn.x * r_0 * sigm(r_0), o.y * rstd * gn.y * r_1 * sigm(r_1));
              ow[2 * c4 + 1] = cvtpk(o.z * rstd * gn.z * r_2 * sigm(r_2), o.w * rstd * gn.w * r_3 * sigm(r_3)); }
          bf16* outp = yb2 + (tok0 + orow) * D + 512 + h * 128 + 16 * op;
          *(u32x4*)outp = (u32x4){ow[0], ow[1], ow[2], ow[3]}; *(u32x4*)(outp + 8) = (u32x4){ow[4], ow[5], ow[6], ow[7]}; }
#pragma unroll
        for (int i = 0; i < 7; ++i) if (i < 6 || p6) *(LAS u32x4*)(lds + pdst[i]) = pf[i];
        __syncthreads();
    }
}

typedef float f32x16 __attribute__((ext_vector_type(16)));
constexpr int S5_XP = 272;
__device__ __forceinline__ void cmul_acc(float& orr, float& oi, float ar, float ai, float br, float bi) { orr = fmaf(ar, br, fmaf(-ai, bi, orr)); oi = fmaf(ar, bi, fmaf(ai, br, oi)); }
__device__ __forceinline__ void s5_unit_mfma(const Ctx& a, int e, bf16* pbuf, bf16* yout, int ypitch, LAS unsigned char* lds, int wgS) {
    int tid = threadIdx.x; asm volatile("" : "+v"(tid));
    const int lane = tid & 63, wave = __builtin_amdgcn_readfirstlane(tid >> 6), l31 = lane & 31, hh = lane >> 5, l15 = lane & 15, g4 = lane >> 4;
    const int g = wgS & 31, b = (wgS >> 5) * 8 + wave, eg = e * S5G + g;
    LAS unsigned char* X = lds + wave * (32 * S5_XP);
    const float dt = expf(a.in(I_S5_LOGDT)[eg]);
    float Lr[2][4], Li[2][4];
    bf16x8v bfr[4];
#pragma unroll
    for (int sset = 0; sset < 2; ++sset) {
        const int p = l31 + 32 * sset;
        const float lr = a.in(I_S5_LRE)[eg * 64 + p], li = a.in(I_S5_LIM)[eg * 64 + p];
        const float mag = expf(lr * dt), lbr = mag * cosf(li * dt), lbi = mag * sinf(li * dt);
        const float inv = 1.0f / (lr * lr + li * li);
        const float zr = ((lbr - 1.0f) * lr + lbi * li) * inv, zi = (lbi * lr - (lbr - 1.0f) * li) * inv;
        Lr[sset][0] = lbr; Li[sset][0] = lbi;
#pragma unroll
        for (int k = 1; k < 4; ++k) { Lr[sset][k] = Lr[sset][k - 1] * lbr - Li[sset][k - 1] * lbi; Li[sset][k] = Lr[sset][k - 1] * lbi + Li[sset][k - 1] * lbr; }
        const float* bre = a.in(I_S5_BRE) + ((size_t)eg * 64 + p) * 16 + 8 * hh; const float* bim = a.in(I_S5_BIM) + ((size_t)eg * 64 + p) * 16 + 8 * hh;
        unsigned wr_[4], wi_[4];
#pragma unroll
        for (int j = 0; j < 4; ++j) { const float br0 = bre[2 * j], bi0 = bim[2 * j], br1 = bre[2 * j + 1], bi1 = bim[2 * j + 1];
            wr_[j] = cvtpk(zr * br0 - zi * bi0, zr * br1 - zi * bi1); wi_[j] = cvtpk(zr * bi0 + zi * br0, zr * bi1 + zi * br1); }
        bfr[sset] = __builtin_bit_cast(bf16x8v, (u32x4){wr_[0], wr_[1], wr_[2], wr_[3]}); bfr[2 + sset] = __builtin_bit_cast(bf16x8v, (u32x4){wi_[0], wi_[1], wi_[2], wi_[3]});
    }
    bf16x8v cfr[4];
    { const float* cre = a.in(I_S5_CRE) + ((size_t)eg * 16 + l15) * 64; const float* cim = a.in(I_S5_CIM) + ((size_t)eg * 16 + l15) * 64;
#pragma unroll
      for (int ks = 0; ks < 4; ++ks) { const int c0 = 32 * ks + 8 * g4; unsigned wv[4];
#pragma unroll
          for (int j = 0; j < 4; ++j) { const int st = (c0 >> 1) + j; wv[j] = cvtpk(cre[st], -cim[st]); }
          cfr[ks] = __builtin_bit_cast(bf16x8v, (u32x4){wv[0], wv[1], wv[2], wv[3]}); } }
    const f32x4 dsk4 = *(const f32x4*)(a.in(I_S5_D) + eg * 16 + 4 * g4);
    float cr[2] = {0.f, 0.f}, ci[2] = {0.f, 0.f};
    u32x4 unext = *(const u32x4*)(pbuf + ((size_t)b * SEQ + l31) * EPAD + PC_U + g * 16 + 8 * hh);
    for (int blk = 0; blk < SEQ / 32; ++blk) {
        const size_t tok0 = (size_t)b * SEQ + blk * 32;
        const bf16x8v ufr = __builtin_bit_cast(bf16x8v, unext);
        { const size_t tn = (blk + 1 < SEQ / 32) ? tok0 + 32 : tok0; unext = *(const u32x4*)(pbuf + (tn + l31) * EPAD + PC_U + g * 16 + 8 * hh); }
        const f32x16 z16 = {0.f, 0.f, 0.f, 0.f, 0.f, 0.f, 0.f, 0.f, 0.f, 0.f, 0.f, 0.f, 0.f, 0.f, 0.f, 0.f};
        u32x2 ue[2];
#pragma unroll
        for (int mb = 0; mb < 2; ++mb) ue[mb] = *(const u32x2*)(pbuf + (tok0 + 16 * mb + l15) * EPAD + PC_U + g * 16 + 4 * g4);
#pragma unroll
        for (int sset = 0; sset < 2; ++sset) {
            f32x16 xr = __builtin_amdgcn_mfma_f32_32x32x16_bf16(ufr, bfr[sset], z16, 0, 0, 0);
            f32x16 xi = __builtin_amdgcn_mfma_f32_32x32x16_bf16(ufr, bfr[2 + sset], z16, 0, 0, 0);
#pragma unroll
            for (int q = 0; q < 4; ++q) {
#pragma unroll
                for (int r = 1; r < 4; ++r) { float vr_ = xr[4 * q + r], vi_ = xi[4 * q + r]; cmul_acc(vr_, vi_, Lr[sset][0], Li[sset][0], xr[4 * q + r - 1], xi[4 * q + r - 1]); xr[4 * q + r] = vr_; xi[4 * q + r] = vi_; }
                float tr = xr[4 * q + 3], ti = xi[4 * q + 3];
                cmul_acc(tr, ti, Lr[sset][3], Li[sset][3], cr[sset], ci[sset]);
                float ur, ui, dum;
                half_pair(tr, ur, dum); half_pair(ti, ui, dum);
                const float inr = hh ? ur : cr[sset], ini = hh ? ui : ci[sset];
#pragma unroll
                for (int r = 0; r < 4; ++r) { float vr_ = xr[4 * q + r], vi_ = xi[4 * q + r]; cmul_acc(vr_, vi_, Lr[sset][r], Li[sset][r], inr, ini); xr[4 * q + r] = vr_; xi[4 * q + r] = vi_; }
                half_pair(xr[4 * q + 3], dum, cr[sset]); half_pair(xi[4 * q + 3], dum, ci[sset]);
            }
#pragma unroll
            for (int r = 0; r < 16; ++r) { const int trow = (r & 3) + 8 * (r >> 2) + 4 * hh;
                *(LAS unsigned*)(X + trow * S5_XP + (32 * sset + l31) * 4) = cvtpk(xr[r], xi[r]); }
        }
        LDS_WAIT(); asm volatile("" ::: "memory");
#pragma unroll
        for (int mb = 0; mb < 2; ++mb) {
            f32x4 y = (f32x4){0.f, 0.f, 0.f, 0.f};
#pragma unroll
            for (int ks = 0; ks < 4; ++ks) { const bf16x8v xa = *(const LAS bf16x8v*)(X + (16 * mb + l15) * S5_XP + (32 * ks + 8 * g4) * 2); y = __builtin_amdgcn_mfma_f32_16x16x32_bf16(cfr[ks], xa, y, 0, 0, 0); }
            const f32x4 uv = (f32x4){bflo(ue[mb].x), bfhi(ue[mb].x), bflo(ue[mb].y), bfhi(ue[mb].y)};
            const f32x4 yv = y + dsk4 * uv;
            u32x2 o; o.x = cvtpk(gelu_t(yv[0]), gelu_t(yv[1])); o.y = cvtpk(gelu_t(yv[2]), gelu_t(yv[3]));
            *(u32x2*)(yout + (tok0 + 16 * mb + l15) * ypitch + g * 16 + 4 * g4) = o;
        }
        LDS_WAIT(); asm volatile("" ::: "memory");
    }
}

__device__ __forceinline__ void ffn_fixup(const bf16* HTG, const bf16* HTU, const bf16* HBG, const float* cw, const float* cb, bf16* act, int gtid, int gthreads) {
    constexpr int C8 = FF / 8, TOTAL = (NTOK / 64) * 2 * C8;
    for (int idx = gtid; idx < TOTAL; idx += gthreads) {
        const int c8 = idx % C8, lr = (idx / C8) & 1, blk = idx / (2 * C8), ch = 8 * c8;
        const bool inner = (blk & 31) != 0;
        const u32x4 z = (u32x4){0u, 0u, 0u, 0u};
        const u32x4 g = *(const u32x4*)(HTG + ((size_t)blk * 2 + lr) * FF + ch), uu = *(const u32x4*)(HTU + ((size_t)blk * 2 + lr) * FF + ch);
        u32x4 gm1, gm2;
        if (lr == 0) { gm1 = inner ? *(const u32x4*)(HBG + ((size_t)(blk - 1) * 2 + 1) * FF + ch) : z; gm2 = inner ? *(const u32x4*)(HBG + ((size_t)(blk - 1) * 2 + 0) * FF + ch) : z; }
        else         { gm1 = *(const u32x4*)(HTG + ((size_t)blk * 2 + 0) * FF + ch);                       gm2 = inner ? *(const u32x4*)(HBG + ((size_t)(blk - 1) * 2 + 1) * FF + ch) : z; }
        const unsigned gw[4] = {g.x, g.y, g.z, g.w}, uw[4] = {uu.x, uu.y, uu.z, uu.w}, g1w[4] = {gm1.x, gm1.y, gm1.z, gm1.w}, g2w[4] = {gm2.x, gm2.y, gm2.z, gm2.w};
        unsigned ow[4];
        const f32x4 bA = *(const f32x4*)(cb + ch), bB = *(const f32x4*)(cb + ch + 4), w0A = *(const f32x4*)(cw + ch), w0B = *(const f32x4*)(cw + ch + 4),
                    w1A = *(const f32x4*)(cw + FF + ch), w1B = *(const f32x4*)(cw + FF + ch + 4), w2A = *(const f32x4*)(cw + 2 * FF + ch), w2B = *(const f32x4*)(cw + 2 * FF + ch + 4);
        const float bbv[8] = {bA[0], bA[1], bA[2], bA[3], bB[0], bB[1], bB[2], bB[3]}, w0v[8] = {w0A[0], w0A[1], w0A[2], w0A[3], w0B[0], w0B[1], w0B[2], w0B[3]},
                    w1v[8] = {w1A[0], w1A[1], w1A[2], w1A[3], w1B[0], w1B[1], w1B[2], w1B[3]}, w2v[8] = {w2A[0], w2A[1], w2A[2], w2A[3], w2B[0], w2B[1], w2B[2], w2B[3]};
#pragma unroll
        for (int p = 0; p < 4; ++p) {
            const float cv0 = bbv[2 * p] + w0v[2 * p] * bflo(g2w[p]) + w1v[2 * p] * bflo(g1w[p]) + w2v[2 * p] * bflo(gw[p]);
            const float cv1 = bbv[2 * p + 1] + w0v[2 * p + 1] * bfhi(g2w[p]) + w1v[2 * p + 1] * bfhi(g1w[p]) + w2v[2 * p + 1] * bfhi(gw[p]);
            ow[p] = pk2(gelu_t(cv0) * bflo(uw[p]), gelu_t(cv1) * bfhi(uw[p])); }
        *(u32x4*)(act + ((size_t)blk * 64 + lr) * FF + ch) = (u32x4){ow[0], ow[1], ow[2], ow[3]};
    }
}

#ifndef WGM_UP
#define WGM_UP 4
#endif
#ifndef SITE_MASK
#define SITE_MASK 0xffff
#endif
#ifndef PROBE_DUP
#define PROBE_DUP 0
#endif
#ifndef PROBE_EXTRA
#define PROBE_EXTRA 0
#endif
#define SITE(n) for (int rep_ = 0, nrep_ = opaque_int((((PROBE_DUP) >> (n)) & 1) ? 2 : 1); rep_ < nrep_; ++rep_) if constexpr ((((SITE_MASK) >> (n)) & 1) != 0)
__global__ void __launch_bounds__(NTHREADS, 2) fwd(Args args) {
    extern __shared__ __attribute__((aligned(16))) unsigned char lds_raw[];
    LAS unsigned char* lds = (LAS unsigned char*)lds_raw;
    volatile LAS unsigned* MISC = (volatile LAS unsigned*)(lds + MISC_OFF);
    const int G = gridDim.x, bx = blockIdx.x;
    const int vcu = (G % 8 == 0) ? (bx % 8) * (G / 8) + bx / 8 : bx;
    const int NGW = G * NWAVES;
#define FRESH_IDS int tid = threadIdx.x; asm volatile("" : "+v"(tid)); const int lane = tid & 63, wave = __builtin_amdgcn_readfirstlane(tid >> 6), gw = vcu * NWAVES + wave; (void)lane; (void)gw;
    unsigned char* ws = args.ws;
    unsigned* ctl = (unsigned*)(ws + WS_CTL);
    if (threadIdx.x < 256) ((LAS unsigned*)(lds + LDSCTL_OFF))[threadIdx.x] = 0u;
    if (threadIdx.x < 35) ((LAS unsigned long long*)(lds + PTAB_OFF))[threadIdx.x] = (unsigned long long)args.in[threadIdx.x];
    __syncthreads();
    Ctx a; a.tab = (const LAS unsigned long long*)(lds + PTAB_OFF); a.ws = ws;
    XcdBarrier bar; bar.bar = ctl + CW_BAR; bar.x = 0; bar.st = nullptr;
    const bool multi = (args.ph_hi - args.ph_lo) > 1;
    if (multi) bar = xcd_barrier_post(ctl + CW_BAR, MISC + 8);
    const int lo = args.ph_lo, hi = args.ph_hi;
#define IN(k) (lo <= (k) && (k) < hi)
#define SEAM(k) do { if (IN((k) + 1)) xcd_barrier(bar); } while (0)
#define SEAM2(k) do { if (IN((k) + 2)) xcd_barrier(bar); } while (0)

    unsigned long long* slotx = (unsigned long long*)(ws + WS_SLOT); float* rsx = (float*)(ws + WS_HA);
    float* xres = args.out; bf16* xs = (bf16*)(ws + WS_XS);

    if (IN(0)) { FRESH_IDS
        for (int rep = 0, nrep = opaque_int((PROBE_EXTRA & 32) ? 2 : 1); rep < nrep; ++rep) {
        for (int i = vcu * NTHREADS + tid; i < NTOK * 2; i += G * NTHREADS) ((u32x4*)slotx)[i] = (u32x4){0u, 0u, 0u, 0u};
        prepass_frag_table(a, vcu * NTHREADS + tid, G * NTHREADS);
        prologue_weights(a, lds, gw, NGW, wave, lane);
        norm_phase<0, 1>(nullptr, nullptr, a.in(I_X), xs, rsx, gw, NGW, lane); }
        SEAM(0);
    }
    const int G0 = G, bx0 = bx, vcu0 = vcu;
    for (int L = 0; L < DEPTH; ++L) {
        const int pb = 1 + 10 * L, e = L >> 1;
        int G = G0, bx = bx0, vcu = vcu0; asm volatile("" : "+s"(G), "+s"(bx), "+s"(vcu));
        const int NGW = G * NWAVES;
        if ((L & 1) == 0) {
            bf16* pbuf = (bf16*)(ws + WS_PBUF); bf16* yb2 = (bf16*)(ws + WS_YB2);
            if (IN(pb + 0)) {
                pg8::Gemm g{xs, (const bf16*)(ws + WS_W_EVIN + e * SZ_W_EVIN), NTOK, EPAD, D, D, D}; pg8::StaticOrder S; S.init(NTOK, EPAD, G, bx);
                pg8::EpiBf16PT<true> E{pbuf, EPAD, rsx};
                SITE(0) pg8::gemm_phase<pg8::EpiBf16PT<true>, pg8::StaticOrder, true, true, true>(lds, g, S, E);
                SEAM(pb + 0);
            }
            if (IN(pb + 2)) { FRESH_IDS
                for (int w = vcu; w < 256; w += G) {
#ifndef NO_S5
#if (PROBE_EXTRA & 64)
                    if (w < 128) { s5_unit_mfma(a, e, pbuf, yb2, D, lds, w); __syncthreads(); }
#endif
#if (PROBE_EXTRA & 128)
                    if (w >= 128) { gla_unit_mfma(a, e, pbuf, yb2, lds, w - 128); __syncthreads(); }
#endif
#ifdef MIX_SIMPLE
                    if (w < 128) s5_unit_simple(a, e, pbuf, pbuf + PC_U, EPAD, lds, w, tid, wave, lane);
#else
                    if (w < 128) s5_unit_mfma(a, e, pbuf, pbuf + PC_U, EPAD, lds, w);
#endif
#endif
#ifdef MIX_SIMPLE
                    if (w >= 128) gla_unit_simple(a, e, pbuf, yb2, lds, w - 128, tid, wave, lane);
#else
                    if (w >= 128) gla_unit_mfma(a, e, pbuf, yb2, lds, w - 128);
#endif
                    __syncthreads();
                }
                SEAM(pb + 2);
            }
            if (IN(pb + 3)) {
                pg8::Gemm g{pbuf + PC_U, (const bf16*)(ws + WS_W_GLU + e * SZ_W_GLU), NTOK, 512, 512, EPAD, 512}; pg8::StaticOrder S; S.init(NTOK, 512, G, bx);
                pg8::EpiGluT<true> E{pbuf + PC_U, EPAD, a.in(I_S5_BGLU) + e * 512, yb2, D};
                SITE(1) pg8::gemm_phase<pg8::EpiGluT<true>, pg8::StaticOrder, true, true, true>(lds, g, S, E);
                SEAM(pb + 3);
            }
            if (IN(pb + 4)) {
                pg8::Gemm g{yb2, (const bf16*)(ws + WS_W_EVOUT + e * SZ_W_EVOUT), NTOK, D, D, D, D}; pg8::StaticOrder S; S.init(NTOK, D, G, bx);
                pg8::EpiNormResT<true> E{xs, xres, a.in(I_LN_MIX_POST) + L * D, slotx, rsx, (unsigned)(2 * L + 1), ctl + CW_BAR + XB_TMO, lds + RING_BYTES, false};
                SITE(2) pg8::gemm_phase<pg8::EpiNormResT<true>, pg8::StaticOrder, true, true, true>(lds, g, S, E);
                SEAM2(pb + 4);
            }
        } else {
            bf16* xm = (bf16*)(ws + WS_XM); bf16* xc = (bf16*)(ws + WS_XC); float* gates = (float*)(ws + WS_GATES); float* SSb = (float*)(ws + WS_SS);
            const bf16* wodin = (const bf16*)(ws + WS_W_ODIN + e * SZ_W_ODIN);
            if (IN(pb + 0)) {
                pg8::Gemm g{xs, wodin, NTOK, MI, D, D, D}; pg8::StaticOrder S; S.init(NTOK, MI, G, bx);
                pg8::EpiBf16PT<true> E{xm, MI, rsx};
                SITE(3) pg8::gemm_phase<pg8::EpiBf16PT<true>, pg8::StaticOrder, true, true, true>(lds, g, S, E);
                SEAM(pb + 0);
            }
            if (IN(pb + 1)) { FRESH_IDS
#ifndef NO_PRE
                for (int rep = 0, nrep = opaque_int((PROBE_EXTRA & 2) ? 2 : 1); rep < nrep; ++rep) { mlstm_prepass(a, e, xm, xc, gates, lds, vcu, G, tid, wave, lane); __syncthreads(); }
#endif
                SEAM(pb + 1); }
            if (IN(pb + 2)) { FRESH_IDS
#ifndef NO_ML
#ifdef MLSTM_SIMPLE
                for (int u = vcu; u < BATCH * MH * 4; u += G) { mlstm_unit_simple(a, e, xm, xc, gates, SSb, lds, u, tid, wave, lane); __syncthreads(); }
#else
                for (int rep = 0, nrep = opaque_int((PROBE_EXTRA & 4) ? 2 : 1); rep < nrep; ++rep)
                for (int u = vcu; u < BATCH * MH * 4; u += G) { mlstm_unit_mfma(a, e, xm, xc, gates, SSb, lds, u, rep == nrep - 1); __syncthreads(); }
#endif
#endif
                SEAM(pb + 2);
            }
            if (IN(pb + 3)) {
                pg8::Gemm g{xs, wodin + (size_t)MI * D, NTOK, MI, D, D, D}; pg8::StaticOrder S; S.init(NTOK, MI, G, bx);
                pg8::EpiOGateT<true> E{xm, xc, SSb, a.in(I_ML_NORM) + e * MI, a.in(I_ML_SKIP) + e * MI, MI, EPS, rsx};
                SITE(4) pg8::gemm_phase<pg8::EpiOGateT<true>, pg8::StaticOrder, true, true, true>(lds, g, S, E);
                SEAM(pb + 3);
            }
            if (IN(pb + 4)) {
                pg8::Gemm g{xm, (const bf16*)(ws + WS_W_ODOUT + e * SZ_W_ODOUT), NTOK, D, MI, MI, MI}; pg8::StaticOrder S; S.init(NTOK, D, G, bx);
                pg8::EpiNormResT<true> E{xs, xres, a.in(I_LN_MIX_POST) + L * D, slotx, rsx, (unsigned)(2 * L + 1), ctl + CW_BAR + XB_TMO, lds + RING_BYTES, false};
                SITE(5) pg8::gemm_phase<pg8::EpiNormResT<true>, pg8::StaticOrder, true, true, true>(lds, g, S, E);
                SEAM2(pb + 4);
            }
        }
        bf16* act = (bf16*)(ws + WS_ACT); bf16* HTG = (bf16*)(ws + WS_HALO); bf16* HTU = (bf16*)(ws + WS_HALO + SZ_HALO); bf16* HBG = (bf16*)(ws + WS_HALO + 2 * SZ_HALO);
        const float* fcw = a.in(I_FFN_CONV_W) + (size_t)L * 3 * FF; const float* fcb = a.in(I_FFN_CONV_B) + (size_t)L * FF;
        if (IN(pb + 6)) {
            pg8::Gemm g{xs, (const bf16*)(ws + WS_W_UP + L * SZ_W_UP), NTOK, 2 * FF, D, D, D}; pg8::StaticOrder S; S.init(NTOK, 2 * FF, G, bx, WGM_UP);
            pg8::EpiFfnUp E{act, HTG, HTU, HBG, fcw, fcb, FF, rsx};
            SITE(6) pg8::gemm_phase<pg8::EpiFfnUp, pg8::StaticOrder, true, true>(lds, g, S, E);
            SEAM(pb + 6);
        }
        if (IN(pb + 7)) { FRESH_IDS
#if (PROBE_EXTRA & 16)
            ffn_fixup(HTG, HTU, HBG, fcw, fcb, act, vcu * NTHREADS + tid, G * NTHREADS);
#endif
            ffn_fixup(HTG, HTU, HBG, fcw, fcb, act, vcu * NTHREADS + tid, G * NTHREADS); SEAM(pb + 7); }
        if (IN(pb + 8)) {
            pg8::Gemm g{act, (const bf16*)(ws + WS_W_DOWN + L * SZ_W_DOWN), NTOK, D, FF, FF, FF}; pg8::StaticOrder S; S.init(NTOK, D, G, bx);
            pg8::EpiNormResT<true> E{xs, xres, a.in(I_LN_FFN_POST) + L * D, slotx, rsx, (unsigned)(2 * L + 2), ctl + CW_BAR + XB_TMO, lds + RING_BYTES, L + 1 == DEPTH};
            SITE(7) pg8::gemm_phase<pg8::EpiNormResT<true>, pg8::StaticOrder, true, true, true>(lds, g, S, E);
            SEAM2(pb + 8);
        }
    }
#undef IN
#undef SEAM
#undef SEAM2
}

extern "C" void kernel_launch(void* const* d_in, const int* in_sizes, int n_in, void* d_out, int out_size, void* d_ws, size_t ws_size, hipStream_t stream) {
    static int grid = 0;
    if (grid == 0) {
        if (n_in != 35 || in_sizes[0] != NTOK * D || out_size != NTOK * D || ws_size < WS_END) {
            fprintf(stderr, "kernel_launch: unexpected shapes: n_in %d in0 %d out %d ws %zu (need %zu)\n", n_in, n_in > 0 ? in_sizes[0] : -1, out_size, ws_size, (size_t)WS_END); grid = -1; return; }
        int dev = 0, cus = 0, per_cu = 0;
        if (hipGetDevice(&dev) != hipSuccess || hipDeviceGetAttribute(&cus, hipDeviceAttributeMultiprocessorCount, dev) != hipSuccess) { grid = -1; return; }
        if (hipFuncSetAttribute((const void*)fwd, hipFuncAttributeMaxDynamicSharedMemorySize, LDS_BYTES) != hipSuccess) { fprintf(stderr, "kernel_launch: hipFuncSetAttribute failed\n"); grid = -1; return; }
        if (hipOccupancyMaxActiveBlocksPerMultiprocessor(&per_cu, (const void*)fwd, NTHREADS, LDS_BYTES) != hipSuccess || per_cu < 1)
            fprintf(stderr, "kernel_launch: occupancy query reports %d workgroups per CU\n", per_cu);
        (void)hipGetLastError();
        grid = cus;
    }
    if (grid < 0) return;
    if (hipMemsetAsync((char*)d_ws + WS_CTL, 0, CTL_ZERO_BYTES, stream) != hipSuccess) return;
    Args a{};
    for (int i = 0; i < 35; ++i) a.in[i] = (const float*)d_in[i];
    a.out = (float*)d_out; a.ws = (unsigned char*)d_ws;
#if MK_PER_PHASE_LAUNCH
    for (int p = 0; p < NPHASE; ++p) {
        const int L = (p - 1) / 10, slot = (p - 1) % 10;
        if (p > 0 && slot == 1 && (L & 1) == 0) continue;
        a.ph_lo = p; a.ph_hi = p + 1;
        hipLaunchKernelGGL(fwd, dim3(grid), dim3(NTHREADS), LDS_BYTES, stream, a);
    }
#else
    a.ph_lo = 0; a.ph_hi = NPHASE;
    hipLaunchKernelGGL(fwd, dim3(grid), dim3(NTHREADS), LDS_BYTES, stream, a);
#endif
}
```
